# Optimizing an MI355X kernel written in HIP

```python
import jax, jax.numpy as jnp
from jax import lax
import numpy as np

D_MODEL = 1024
BATCH = 8
SEQ = 2048
DEPTH = 1
DEC_BATCH = 128
DEC_SEQ = 8
PAST_LEN = 16384
PAGE_SIZE = 128

RET_HEADS = 4
RET_DK = 128
RET_DV = 128
RET_W = RET_HEADS * RET_DV
GDN_HEADS = 4
GDN_DK = 128
GDN_DV = 128
GDN_W = GDN_HEADS * GDN_DV
MIX_W = RET_W + GDN_W
GDN_CONV_CH = 2 * GDN_HEADS * GDN_DK + GDN_HEADS * GDN_DV
CONV_W = 4
CHUNK = 64
D_FF = 4 * D_MODEL
ROPE_BASE = 10000.0
EPS = 1e-6
IN_SIZES = (RET_HEADS * RET_DK, RET_HEADS * RET_DK, RET_W, RET_W, GDN_CONV_CH, GDN_W, GDN_HEADS, GDN_HEADS)
IN_W = 2 * RET_HEADS * RET_DK + 2 * RET_W + GDN_CONV_CH + GDN_W + 2 * GDN_HEADS

kernel_name = "hybrid_retention_gated_delta_step"


def _rmsnorm(x, w):
    x32 = x.astype(jnp.float32)
    y = x32 * lax.rsqrt(jnp.mean(x32 * x32, axis=-1, keepdims=True) + EPS)
    return (y * w.astype(jnp.float32)).astype(x.dtype)


def _l2norm(x):
    return x * lax.rsqrt(jnp.sum(x * x, axis=-1, keepdims=True) + EPS)


def _rope(x, pos):
    d = x.shape[-1]
    inv_freq = ROPE_BASE ** (-jnp.arange(0, d, 2, dtype=jnp.float32) / d)
    ang = pos[:, None] * inv_freq[None, :]
    cos = jnp.cos(ang)[None, :, None, :]
    sin = jnp.sin(ang)[None, :, None, :]
    x1, x2 = x[..., : d // 2], x[..., d // 2:]
    return jnp.concatenate([x1 * cos - x2 * sin, x1 * sin + x2 * cos], axis=-1)


def _to_chunks(a, C):
    L = a.shape[2]
    N = -(-L // C)
    pad = N * C - L
    a = jnp.pad(a, [(0, 0), (0, 0), (0, pad)] + [(0, 0)] * (a.ndim - 3))
    a = a.reshape(a.shape[:2] + (N, C) + a.shape[3:])
    return jnp.moveaxis(a, 2, 0)


def _from_chunks(o, L):
    o = jnp.moveaxis(o, 0, 2)
    B, H, N, C, d = o.shape
    return o.reshape(B, H, N * C, d)[:, :, :L]


def _retention(q, k, v, logd, S0):
    L = q.shape[2]
    C = min(CHUNK, L)
    causal = jnp.tril(jnp.ones((C, C), dtype=bool))

    def step(S, inp):
        qi, ki, vi, gi = inp
        cum = jnp.cumsum(gi, axis=-1)
        dmat = jnp.exp(jnp.where(causal, cum[..., :, None] - cum[..., None, :], -jnp.inf))
        scores = jnp.einsum('bhid,bhjd->bhij', qi, ki) * dmat
        o = (jnp.einsum('bhcd,bhde->bhce', qi * jnp.exp(cum)[..., None], S)
             + jnp.einsum('bhij,bhje->bhie', scores, vi))
        tail = jnp.exp(cum[..., -1:] - cum)
        S = (jnp.exp(cum[..., -1])[..., None, None] * S
             + jnp.einsum('bhcd,bhce->bhde', ki * tail[..., None], vi))
        return S, o

    S, o = lax.scan(step, S0, (_to_chunks(q, C), _to_chunks(k, C), _to_chunks(v, C), _to_chunks(logd, C)))
    return _from_chunks(o, L), S


def _gated_delta(q, k, v, g, beta, S0):
    L = q.shape[2]
    C = min(CHUNK, L)
    causal = jnp.tril(jnp.ones((C, C), dtype=bool))
    strict = jnp.tril(jnp.ones((C, C), dtype=bool), -1)
    eye = jnp.eye(C, dtype=jnp.float32)
    dk = q.shape[-1]

    def step(S, inp):
        qi, ki, vi, gi, bi = inp
        cum = jnp.cumsum(gi, axis=-1)
        dmat = jnp.exp(jnp.where(causal, cum[..., :, None] - cum[..., None, :], -jnp.inf))
        kk = jnp.einsum('bhid,bhjd->bhij', ki, ki)
        A = jnp.where(strict, bi[..., :, None] * kk * dmat, 0.0)
        rhs = jnp.concatenate([ki * (bi * jnp.exp(cum))[..., None], vi * bi[..., None]], axis=-1)
        sol = lax.linalg.triangular_solve(eye + A, rhs, left_side=True, lower=True, unit_diagonal=True)
        w, u = sol[..., :dk], sol[..., dk:]
        v_new = u - jnp.einsum('bhcd,bhde->bhce', w, S)
        scores = jnp.einsum('bhid,bhjd->bhij', qi, ki) * dmat
        o = (jnp.einsum('bhcd,bhde->bhce', qi * jnp.exp(cum)[..., None], S)
             + jnp.einsum('bhij,bhje->bhie', scores, v_new))
        tail = jnp.exp(cum[..., -1:] - cum)
        S = (jnp.exp(cum[..., -1])[..., None, None] * S
             + jnp.einsum('bhcd,bhce->bhde', ki * tail[..., None], v_new))
        return S, o

    xs = (_to_chunks(q, C), _to_chunks(k, C), _to_chunks(v, C), _to_chunks(g, C), _to_chunks(beta, C))
    S, o = lax.scan(step, S0, xs)
    return _from_chunks(o, L), S


def _hybrid_mixer(xn, pos_offset, s_ret, s_gdn, s_conv, w_in, conv_w, A_log, dt_bias,
                  ret_norm_w, gdn_norm_w, w_out):
    f32 = jnp.float32
    B, L, _ = xn.shape
    proj = jnp.einsum('bld,de->ble', xn, w_in).astype(f32)
    offs = np.cumsum(IN_SIZES)[:-1].tolist()
    q_r, k_r, v_r, gate_r, qkv_g, z_g, a_g, b_g = jnp.split(proj, offs, axis=-1)

    pos = jnp.arange(L, dtype=f32) + jnp.asarray(pos_offset, f32)
    q_r = _rope(q_r.reshape(B, L, RET_HEADS, RET_DK), pos)
    k_r = _rope(k_r.reshape(B, L, RET_HEADS, RET_DK), pos) * (RET_DK ** -0.5)
    v_r = v_r.reshape(B, L, RET_HEADS, RET_DV)
    log_gamma = jnp.log(1.0 - 2.0 ** (-5.0 - jnp.arange(RET_HEADS, dtype=f32)))
    logd = jnp.broadcast_to(log_gamma[None, :, None], (B, RET_HEADS, L))
    o_r, S_r = _retention(q_r.transpose(0, 2, 1, 3), k_r.transpose(0, 2, 1, 3),
                          v_r.transpose(0, 2, 1, 3), logd, s_ret.astype(f32))
    o_r = _rmsnorm(o_r.transpose(0, 2, 1, 3), ret_norm_w).reshape(B, L, RET_W) * jax.nn.silu(gate_r)

    full = jnp.concatenate([s_conv.astype(f32), qkv_g], axis=1)
    cw = conv_w.astype(f32)
    conv = full[:, 0:L] * cw[0]
    for t in range(1, CONV_W):
        conv = conv + full[:, t:t + L] * cw[t]
    conv = jax.nn.silu(conv)
    new_conv = full[:, -(CONV_W - 1):]
    nqk = GDN_HEADS * GDN_DK
    q_g = _l2norm(conv[..., :nqk].reshape(B, L, GDN_HEADS, GDN_DK)) * (GDN_DK ** -0.5)
    k_g = _l2norm(conv[..., nqk:2 * nqk].reshape(B, L, GDN_HEADS, GDN_DK))
    v_g = conv[..., 2 * nqk:].reshape(B, L, GDN_HEADS, GDN_DV)
    g = -jnp.exp(A_log.astype(f32)) * jax.nn.softplus(a_g + dt_bias.astype(f32))
    beta = jax.nn.sigmoid(b_g)
    o_g, S_g = _gated_delta(q_g.transpose(0, 2, 1, 3), k_g.transpose(0, 2, 1, 3),
                            v_g.transpose(0, 2, 1, 3), g.transpose(0, 2, 1),
                            beta.transpose(0, 2, 1), s_gdn.astype(f32))
    o_g = _rmsnorm(o_g.transpose(0, 2, 1, 3), gdn_norm_w).reshape(B, L, GDN_W) * jax.nn.silu(z_g)

    mix = jnp.concatenate([o_r, o_g], axis=-1).astype(w_out.dtype)
    y = jnp.einsum('ble,ed->bld', mix, w_out).astype(xn.dtype)
    return y, S_r, S_g, new_conv


def _layer(x, pos_offset, s_ret, s_gdn, s_conv, pre_mix_w, w_in, conv_w, A_log, dt_bias,
           ret_norm_w, gdn_norm_w, w_out, post_mix_w, pre_mlp_w, w_up, w_down, post_mlp_w):
    h = _rmsnorm(x, pre_mix_w)
    m, S_r, S_g, new_conv = _hybrid_mixer(h, pos_offset, s_ret, s_gdn, s_conv, w_in, conv_w, A_log,
                                          dt_bias, ret_norm_w, gdn_norm_w, w_out)
    x = x + _rmsnorm(m, post_mix_w)
    h = _rmsnorm(x, pre_mlp_w)
    f = jnp.square(jax.nn.relu(jnp.einsum('bld,df->blf', h, w_up)))
    f = jnp.einsum('blf,fd->bld', f, w_down)
    x = x + _rmsnorm(f, post_mlp_w)
    return x, S_r, S_g, new_conv


def setup_inputs(seed: int = 0) -> dict:
    key = jax.random.key(seed)
    ks = jax.random.split(key, 20)
    f32 = jnp.float32
    nrm = lambda k, s, sc: jax.random.normal(k, s, f32) * sc
    gain = lambda k, s: 1.0 + 0.02 * jax.random.normal(k, s, f32)
    dt = jnp.exp(jax.random.uniform(ks[17], (DEPTH, GDN_HEADS), f32, np.log(1e-3), np.log(1e-1)))
    return {
        "x_prompt": nrm(ks[0], (BATCH, SEQ, D_MODEL), 1.0),
        "x_sample": nrm(ks[1], (DEC_BATCH, DEC_SEQ, D_MODEL), 1.0),
        "state_ret": nrm(ks[2], (DEPTH, DEC_BATCH, RET_HEADS, RET_DK, RET_DV), 0.05),
        "state_gdn": nrm(ks[3], (DEPTH, DEC_BATCH, GDN_HEADS, GDN_DK, GDN_DV), 0.05),
        "state_conv": nrm(ks[4], (DEPTH, DEC_BATCH, CONV_W - 1, GDN_CONV_CH), 1.0),
        "pre_mix_w": gain(ks[5], (DEPTH, D_MODEL)),
        "w_in": nrm(ks[6], (DEPTH, D_MODEL, IN_W), D_MODEL ** -0.5),
        "conv_w": nrm(ks[7], (DEPTH, CONV_W, GDN_CONV_CH), CONV_W ** -0.5),
        "A_log": jnp.log(jax.random.uniform(ks[8], (DEPTH, GDN_HEADS), f32, 1.0, 16.0)),
        "dt_bias": dt + jnp.log(-jnp.expm1(-dt)),
        "ret_norm_w": gain(ks[9], (DEPTH, RET_DV)),
        "gdn_norm_w": gain(ks[10], (DEPTH, GDN_DV)),
        "w_out": nrm(ks[11], (DEPTH, MIX_W, D_MODEL), MIX_W ** -0.5),
        "post_mix_w": gain(ks[12], (DEPTH, D_MODEL)),
        "pre_mlp_w": gain(ks[13], (DEPTH, D_MODEL)),
        "w_up": nrm(ks[14], (DEPTH, D_MODEL, D_FF), D_MODEL ** -0.5),
        "w_down": nrm(ks[15], (DEPTH, D_FF, D_MODEL), D_FF ** -0.5),
        "post_mlp_w": gain(ks[16], (DEPTH, D_MODEL)),
    }


def reference(x_prompt, x_sample, state_ret, state_gdn, state_conv, pre_mix_w, w_in, conv_w, A_log,
              dt_bias, ret_norm_w, gdn_norm_w, w_out, post_mix_w, pre_mlp_w, w_up, w_down, post_mlp_w):
    f32 = jnp.float32
    B = x_prompt.shape[0]
    yp, ys = x_prompt, x_sample
    rp, gp, cp, rs, gs, cs = [], [], [], [], [], []
    for l in range(DEPTH):
        params = (pre_mix_w[l], w_in[l], conv_w[l], A_log[l], dt_bias[l], ret_norm_w[l], gdn_norm_w[l],
                  w_out[l], post_mix_w[l], pre_mlp_w[l], w_up[l], w_down[l], post_mlp_w[l])
        z_r = jnp.zeros((B, RET_HEADS, RET_DK, RET_DV), f32)
        z_g = jnp.zeros((B, GDN_HEADS, GDN_DK, GDN_DV), f32)
        z_c = jnp.zeros((B, CONV_W - 1, GDN_CONV_CH), f32)
        yp, s1, s2, s3 = _layer(yp, 0, z_r, z_g, z_c, *params)
        ys, t1, t2, t3 = _layer(ys, PAST_LEN, state_ret[l], state_gdn[l], state_conv[l], *params)
        rp.append(s1.astype(state_ret.dtype)); gp.append(s2.astype(state_gdn.dtype)); cp.append(s3.astype(state_conv.dtype))
        rs.append(t1.astype(state_ret.dtype)); gs.append(t2.astype(state_gdn.dtype)); cs.append(t3.astype(state_conv.dtype))
    return (yp, ys, jnp.stack(rp), jnp.stack(gp), jnp.stack(cp), jnp.stack(rs), jnp.stack(gs), jnp.stack(cs))
```

```cpp
#include <hip/hip_runtime.h>
#include <hip/hip_cooperative_groups.h>
#include <cstdio>
#include <cmath>
#include <cstring>
namespace cg = cooperative_groups;

#ifndef MULTI_LAUNCH
#define MULTI_LAUNCH 0
#endif

typedef unsigned short bf16_t;
typedef short bf16x8 __attribute__((ext_vector_type(8)));
typedef float f32x4 __attribute__((ext_vector_type(4)));
typedef float f32x16 __attribute__((ext_vector_type(16)));
typedef unsigned u32x4 __attribute__((ext_vector_type(4)));
typedef unsigned u32x2 __attribute__((ext_vector_type(2)));

constexpr int TP = 16384, TS = 1024, TT = TP + TS, DM = 1024, INW = 4104, NPJ = 4096, DFF = 4096;
constexpr size_t O_YP = 0, O_YS = 16777216, O_RP = 17825792, O_GP = 18350080, O_CP = 18874368, O_RS = 18911232, O_GS = 27299840, O_CS = 35688448;
constexpr size_t W_WIN = 0, W_WOUT = W_WIN + 8388608, W_WUP = W_WOUT + 2097152, W_WDN = W_WUP + 8388608, W_H = W_WDN + 8388608,
                 W_MIX = W_H + 35651584, W_PROJ = W_MIX + 35651584, W_AB = W_PROJ + 142606336, W_ROPE = W_AB + 557056,
                 W_SCP = W_ROPE + 1052672, W_SCS = W_SCP + 8388608, W_DEC = W_SCS + 4194304, W_END = W_DEC + 8192;

struct Params {
    const float *x_prompt, *x_sample, *state_ret, *state_gdn, *state_conv, *pre_mix_w, *w_in, *conv_w, *A_log, *dt_bias,
                *ret_norm_w, *gdn_norm_w, *w_out, *post_mix_w, *pre_mlp_w, *w_up, *w_down, *post_mlp_w;
    float* out;
    unsigned char* ws;
    double rope_r;
    int phase_lo, phase_hi;
};

#define DI __device__ __forceinline__
DI float bf2f(unsigned short b) { return __uint_as_float(((unsigned)b) << 16); }
DI float bflo(unsigned u) { return __uint_as_float(u << 16); }
DI float bfhi(unsigned u) { return __uint_as_float(u & 0xffff0000u); }
typedef float f32x2_t __attribute__((ext_vector_type(2)));
typedef __bf16 bf16x2_t __attribute__((ext_vector_type(2)));
DI unsigned pk_bf16(float lo, float hi) { f32x2_t v = {lo, hi}; bf16x2_t b = __builtin_convertvector(v, bf16x2_t); return __builtin_bit_cast(unsigned, b); }
DI unsigned short f2bf(float f) { return (unsigned short)(pk_bf16(f, 0.f) & 0xffffu); }
DI int sw256(int row, int chunk) { return row * 272 + (chunk << 4); }
DI int sw128(int row, int chunk) { return row * 144 + (chunk << 4); }
DI int crow(int reg, int hh) { return (reg & 3) + 8 * (reg >> 2) + 4 * hh; }
DI float wave_sum(float v) { for (int o = 32; o >= 1; o >>= 1) v += __shfl_xor(v, o); return v; }
DI float silu(float x) { return x / (1.0f + __expf(-x)); }
#define MFMA32(a, b, c) __builtin_amdgcn_mfma_f32_32x32x16_bf16((a), (b), (c), 0, 0, 0)

template <int NR> DI void fwd_subst(float (&x)[64], const float* Amat) {
#pragma unroll
    for (int i = 1; i < NR; ++i) {
        float s = x[i];
#pragma unroll
        for (int j = 0; j < i; ++j) s -= Amat[i * 64 + j] * x[j];
        x[i] = s;
        asm volatile("" ::: "memory");
    }
}
namespace pg8 {
#define PG8_LAS __attribute__((address_space(3)))
typedef unsigned short bf16_t;
typedef short bf16x8 __attribute__((ext_vector_type(8)));
typedef float f32x4 __attribute__((ext_vector_type(4)));
typedef unsigned u32x4 __attribute__((ext_vector_type(4)));
constexpr int BM = 256, BK = 64, HALF = 128, HTB = HALF * BK * 2  , STAGE_BYTES = 8 * HTB, NXCD = 8, WGM = 8;

__host__ __device__ __forceinline__ int lds_byte(int r, int c) { const int st = (r >> 4) * 2 + (c >> 5), rr = r & 15, cc = c & 31, ob = rr * 64 + cc * 2; return st * 1024 + (ob ^ (((ob >> 9) & 1) << 5)); }
__host__ __device__ __forceinline__ void stage_rc(int b, int& R, int& C) { const int st = b / 1024, sb = b % 1024, swz = sb ^ (((sb >> 9) & 1) << 5); R = (st >> 1) * 16 + swz / 64; C = (st & 1) * 32 + (swz % 64) / 2; }
__host__ __device__ __forceinline__ int perm32(int rho) { const int n = rho >> 4, i = rho & 15; return 8 * (i >> 2) + 4 * n + (i & 3); }

struct Unit { int pm, pn; };
struct Gemm { const bf16_t* A; const bf16_t* Bt; int M, N, K; };

struct StaticOrder {
    int nM, nN, nwg, G, c;
    __host__ __device__ void init(int M, int N, int G_, int c_) { nM = M / BM; nN = N / BM; nwg = nM * nN; G = G_; c = c_; }
    __host__ __device__ bool next(int i, Unit& u) const {
        const long L = (long)i * G + c; if (L >= nwg) return false;
        int wgid = (int)L; { const int q = nwg / NXCD, r = nwg % NXCD, xcd = wgid % NXCD, off = wgid / NXCD; wgid = (xcd < r ? xcd * (q + 1) : r * (q + 1) + (xcd - r) * q) + off; }
        const int nig = WGM * nN, gid = wgid / nig, fm = gid * WGM, gsz = (nM - fm) < WGM ? (nM - fm) : WGM;
        u.pm = fm + ((wgid % nig) % gsz); u.pn = (wgid % nig) / gsz; return true;
    }
    __device__ __forceinline__ void a_ready(const Unit&) const {}
    __device__ __forceinline__ void done(const Unit&) const {}
};

__device__ __forceinline__ unsigned cvt_pk_bf16(float lo, float hi) { return ::pk_bf16(lo, hi); }
struct EpiF32 {
    static constexpr bool PERM = false, AFTER_DRAIN = false;
    float* C; int ldc;
    __device__ __forceinline__ void operator()(const f32x4 (&acc)[2][2][4][2], const Unit& u, int wr, int wc, int fr, int fq) const {
        const int row0 = u.pm * BM + wr * 64 + fr, col0 = u.pn * BM + wc * 32 + 4 * fq;
#pragma unroll
        for (int ai = 0; ai < 2; ++ai)
#pragma unroll
            for (int m = 0; m < 4; ++m) { float* rowp = C + (size_t)(row0 + ai * HALF + m * 16) * ldc + col0;
#pragma unroll
                for (int bj = 0; bj < 2; ++bj)
#pragma unroll
                    for (int n = 0; n < 2; ++n) *(f32x4*)(rowp + bj * HALF + n * 16) = acc[ai][bj][m][n]; }
    }
};
template <int ACT  > struct EpiBf16 {
    static constexpr bool PERM = true, AFTER_DRAIN = false;
    bf16_t* O; int ldc;
    __device__ __forceinline__ void operator()(const f32x4 (&acc)[2][2][4][2], const Unit& u, int wr, int wc, int fr, int fq) const {
        const int row0 = u.pm * BM + wr * 64 + fr; const int col0 = u.pn * BM + wc * 32 + 8 * fq;
#pragma unroll
        for (int ai = 0; ai < 2; ++ai)
#pragma unroll
            for (int m = 0; m < 4; ++m) { bf16_t* rowp = O + (size_t)(row0 + ai * HALF + m * 16) * ldc + col0;
#pragma unroll
                for (int bj = 0; bj < 2; ++bj) { f32x4 v0 = acc[ai][bj][m][0], v1 = acc[ai][bj][m][1];
                    if (ACT == 1) {
#pragma unroll
                        for (int j = 0; j < 4; ++j) { const float a = fmaxf(v0[j], 0.f), b = fmaxf(v1[j], 0.f); v0[j] = a * a; v1[j] = b * b; } }
                    u32x4 w; w.x = cvt_pk_bf16(v0[0], v0[1]); w.y = cvt_pk_bf16(v0[2], v0[3]); w.z = cvt_pk_bf16(v1[0], v1[1]); w.w = cvt_pk_bf16(v1[2], v1[3]);
                    *(u32x4*)(rowp + bj * HALF) = w; } }
    }
};
template <class Epi, class Sched, bool STAMP = false>
__device__ __forceinline__ void gemm_phase(PG8_LAS unsigned char* lds, const Gemm g, const Sched& S, const Epi& E, unsigned long long* stamps) {
    const int tid = threadIdx.x, wid = __builtin_amdgcn_readfirstlane(tid >> 6), lane = tid & 63, wr = wid >> 2, wc = wid & 3, fr = lane & 15, fq = lane >> 4;
    const int K = g.K, nt = K / BK;
    int ts_lo = 0, ts_hi = 0, nts = 0; const unsigned long long rt_entry = STAMP ? (unsigned long long)wall_clock64() : 0ull;
#define PG8_STAMP() do { if (STAMP && wid == 0 && nts < 64) { const unsigned long long _c = (unsigned long long)clock64(); \
        ts_lo = (lane == nts) ? (int)(unsigned)_c : ts_lo; ts_hi = (lane == nts) ? (int)(unsigned)(_c >> 32) : ts_hi; ++nts; } } while (0)
    PG8_STAMP();
    unsigned voffA[2], voffB[2];
#pragma unroll
    for (int i = 0; i < 2; ++i) { int R, C; stage_rc(tid * 16 + i * 8192, R, C); const int Rb = Epi::PERM ? ((R & ~31) + perm32(R & 31)) : R;
        voffA[i] = (unsigned)(R * K + C) * 2u; voffB[i] = (unsigned)(Rb * K + C) * 2u; }
    const size_t kstep = (size_t)(BK * 2);
    const size_t hstep = (size_t)HALF * K * 2;
    const size_t tstep = 2 * hstep;
    const unsigned ldsw = (unsigned)wid * 1024u;
    const int aoff = lds_byte(wr * 64 + fr, fq * 8), boff = lds_byte(wc * 32 + fr, fq * 8);
#define PG8_SA(b, h) (((b) * 2 + (h)) * HTB)
#define PG8_SB(b, h) ((4 + (b) * 2 + (h)) * HTB)
#define PG8_STAGE(bufoff, gbase, voff) do { _Pragma("unroll") for (int _i = 0; _i < 2; ++_i) \
        __builtin_amdgcn_global_load_lds((const unsigned*)((const char*)(gbase) + (voff)[_i]), (PG8_LAS unsigned*)(lds + (bufoff) + ldsw + _i * 8192), 16, 0, 0); } while (0)
#define PG8_LDA(dst, b, h) do { _Pragma("unroll") for (int m = 0; m < 4; ++m) _Pragma("unroll") for (int k = 0; k < 2; ++k) dst[m][k] = *(const PG8_LAS bf16x8*)(lds + PG8_SA(b, h) + aoff + m * 2048 + k * 1024); } while (0)
#define PG8_LDB(dst, b, h) do { _Pragma("unroll") for (int n = 0; n < 2; ++n) _Pragma("unroll") for (int k = 0; k < 2; ++k) dst[n][k] = *(const PG8_LAS bf16x8*)(lds + PG8_SB(b, h) + boff + n * 2048 + k * 1024); } while (0)
#define PG8_MMA(ai, bj, At, Bt) do { __builtin_amdgcn_s_setprio(1); _Pragma("unroll") for (int m = 0; m < 4; ++m) _Pragma("unroll") for (int n = 0; n < 2; ++n) _Pragma("unroll") for (int k = 0; k < 2; ++k) \
        acc[ai][bj][m][n] = __builtin_amdgcn_mfma_f32_16x16x32_bf16(Bt[n][k], At[m][k], acc[ai][bj][m][n], 0, 0, 0); __builtin_amdgcn_s_setprio(0); } while (0)
#define PG8_WAIT_V(n) asm volatile("s_waitcnt vmcnt(" #n ")" ::: "memory")
#define PG8_WAIT_L(n) asm volatile("s_waitcnt lgkmcnt(" #n ")" ::: "memory")
#define PG8_BAR __builtin_amdgcn_s_barrier()
#define PG8_SCHED __builtin_amdgcn_sched_barrier(0)
    Unit cur, nxt; int ui = 0;
    if (!S.next(0, cur)) return;
    f32x4 acc[2][2][4][2];
#pragma unroll
    for (int a = 0; a < 2; ++a)
#pragma unroll
        for (int b = 0; b < 2; ++b)
#pragma unroll
            for (int m = 0; m < 4; ++m)
#pragma unroll
                for (int n = 0; n < 2; ++n) acc[a][b][m][n] = (f32x4){0.f, 0.f, 0.f, 0.f};
    bf16x8 At[4][2], B0[2][2], B1[2][2];
    const char* cA = (const char*)g.A + (size_t)cur.pm * tstep; const char* cB = (const char*)g.Bt + (size_t)cur.pn * tstep;
    S.a_ready(cur);
    PG8_STAGE(PG8_SB(0, 0), cB, voffB); PG8_STAGE(PG8_SA(0, 0), cA, voffA); PG8_STAGE(PG8_SB(0, 1), cB + hstep, voffB); PG8_STAGE(PG8_SA(0, 1), cA + hstep, voffA);
    if (wr == 1) PG8_BAR;
    PG8_WAIT_V(4); PG8_BAR;
    PG8_STAGE(PG8_SB(1, 0), cB + kstep, voffB); PG8_STAGE(PG8_SA(1, 0), cA + kstep, voffA); PG8_STAGE(PG8_SB(1, 1), cB + hstep + kstep, voffB);
    PG8_WAIT_V(6); PG8_BAR;
    PG8_STAMP();
    for (;;) {
        const bool has_next = S.next(ui + 1, nxt);
        const char* nA = has_next ? (const char*)g.A + (size_t)nxt.pm * tstep : cA; const char* nB = has_next ? (const char*)g.Bt + (size_t)nxt.pn * tstep : cB;
        for (int t = 0; t < nt; t += 2) {
            const bool last = (t == nt - 2);
            const char* a1 = cA + (size_t)(t + 1) * kstep;
            const char* a2 = last ? nA : cA + (size_t)(t + 2) * kstep; const char* b2 = last ? nB : cB + (size_t)(t + 2) * kstep;
            const char* a3 = a2 + kstep; const char* b3 = b2 + kstep;
            if (last && has_next) S.a_ready(nxt);
            PG8_LDB(B0, 0, 0); PG8_SCHED; PG8_LDA(At, 0, 0); PG8_STAGE(PG8_SA(1, 1), a1 + hstep, voffA);
            PG8_WAIT_L(8); PG8_BAR; PG8_WAIT_L(0); PG8_MMA(0, 0, At, B0); PG8_BAR; PG8_SCHED;
            PG8_LDB(B1, 0, 1); PG8_STAGE(PG8_SB(0, 0), b2, voffB);
            PG8_BAR; PG8_WAIT_L(0); PG8_MMA(0, 1, At, B1); PG8_BAR;
            PG8_LDA(At, 0, 1); PG8_STAGE(PG8_SA(0, 0), a2, voffA);
            PG8_BAR; PG8_WAIT_L(0); PG8_MMA(1, 0, At, B0); PG8_BAR; PG8_SCHED;
            PG8_STAGE(PG8_SB(0, 1), b2 + hstep, voffB);
            PG8_WAIT_V(6); PG8_BAR; PG8_MMA(1, 1, At, B1); PG8_BAR;
            PG8_LDB(B0, 1, 0); PG8_SCHED; PG8_LDA(At, 1, 0); PG8_STAGE(PG8_SA(0, 1), a2 + hstep, voffA);
            PG8_WAIT_L(8); PG8_BAR; PG8_WAIT_L(0); PG8_MMA(0, 0, At, B0); PG8_BAR; PG8_SCHED;
            PG8_LDB(B1, 1, 1); PG8_STAGE(PG8_SB(1, 0), b3, voffB);
            PG8_BAR; PG8_WAIT_L(0); PG8_MMA(0, 1, At, B1); PG8_BAR;
            PG8_LDA(At, 1, 1); PG8_STAGE(PG8_SA(1, 0), a3, voffA);
            PG8_BAR; PG8_WAIT_L(0); PG8_MMA(1, 0, At, B0); PG8_BAR; PG8_SCHED;
            PG8_STAGE(PG8_SB(1, 1), b3 + hstep, voffB);
            PG8_WAIT_V(6); PG8_BAR; PG8_MMA(1, 1, At, B1); PG8_BAR;
        }
        PG8_STAMP();
        if constexpr (!Epi::AFTER_DRAIN) { E(acc, cur, wr, wc, fr, fq); S.done(cur); }
        PG8_STAMP();
        if (!has_next) break;
#pragma unroll
        for (int a = 0; a < 2; ++a)
#pragma unroll
            for (int b = 0; b < 2; ++b)
#pragma unroll
                for (int m = 0; m < 4; ++m)
#pragma unroll
                    for (int n = 0; n < 2; ++n) acc[a][b][m][n] = (f32x4){0.f, 0.f, 0.f, 0.f};
        cur = nxt; cA = nA; cB = nB; ++ui;
    }
    PG8_WAIT_V(0);
    if (wr == 0) PG8_BAR;
    PG8_BAR;
    if constexpr (Epi::AFTER_DRAIN) { E.fused(acc, cur, wr, wc, fr, fq, lds, wid, lane); S.done(cur); }
    PG8_STAMP();
    if (STAMP && wid == 0) { stamps[lane] = lane < nts ? (((unsigned long long)(unsigned)ts_hi << 32) | (unsigned)ts_lo) : 0ull;
        if (lane == 62) stamps[62] = rt_entry; if (lane == 63) stamps[63] = (unsigned long long)wall_clock64(); }
#undef PG8_STAMP
#undef PG8_SA
#undef PG8_SB
#undef PG8_STAGE
#undef PG8_LDA
#undef PG8_LDB
#undef PG8_MMA
#undef PG8_WAIT_V
#undef PG8_WAIT_L
#undef PG8_BAR
#undef PG8_SCHED
}
}

__device__ __forceinline__ void phaseA_weights(const Params& p, float* tl  ) {
    const int tid = threadIdx.x;
    for (int tile = blockIdx.x; tile < 3328; tile += gridDim.x) {
        const float* src; bf16_t* dst; int ldn, K, lt;
        if (tile < 1024)      { src = p.w_in;   ldn = INW;  K = 1024; dst = (bf16_t*)(p.ws + W_WIN);  lt = tile; }
        else if (tile < 1280) { src = p.w_out;  ldn = 1024; K = 1024; dst = (bf16_t*)(p.ws + W_WOUT); lt = tile - 1024; }
        else if (tile < 2304) { src = p.w_up;   ldn = 4096; K = 1024; dst = (bf16_t*)(p.ws + W_WUP);  lt = tile - 1280; }
        else                  { src = p.w_down; ldn = 1024; K = 4096; dst = (bf16_t*)(p.ws + W_WDN);  lt = tile - 2304; }
        const int nkt = K >> 6, kt = lt % nkt, nt = lt / nkt;
#pragma unroll
        for (int i = 0; i < 2; ++i) {
            const int r = (tid >> 4) + 32 * i, c4 = (tid & 15) * 4;
            const float4 v = *(const float4*)(src + (size_t)(kt * 64 + r) * ldn + nt * 64 + c4);
            tl[r * 65 + c4 + 0] = v.x; tl[r * 65 + c4 + 1] = v.y; tl[r * 65 + c4 + 2] = v.z; tl[r * 65 + c4 + 3] = v.w;
        }
        __syncthreads();
        {
            const int n = tid >> 3, k8 = (tid & 7) * 8;
            float v[8];
#pragma unroll
            for (int j = 0; j < 8; ++j) v[j] = tl[(k8 + j) * 65 + n];
            u32x4 w; w.x = pk_bf16(v[0], v[1]); w.y = pk_bf16(v[2], v[3]); w.z = pk_bf16(v[4], v[5]); w.w = pk_bf16(v[6], v[7]);
            *(u32x4*)(dst + (size_t)(nt * 64 + n) * K + kt * 64 + k8) = w;
        }
        __syncthreads();
    }
}

__device__ __forceinline__ void phaseA_rope(const Params& p) {
    float2* tab = (float2*)(p.ws + W_ROPE);
    for (int idx = blockIdx.x * 512 + threadIdx.x; idx < 2056 * 64; idx += gridDim.x * 512) {
        const int pi = idx >> 6, f = idx & 63;
        double ivd = 1.0; for (int k = 0; k < f; ++k) ivd *= p.rope_r;
        const float ivf = (float)ivd;
        const float pos = pi < 2048 ? (float)pi : (float)(16384 + pi - 2048);
        const float ang = pos * ivf;
        const double a = (double)ang, q = rint(a * 0.63661977236758134308);
        double r = fma(-q, 1.57079632679489655800, a); r = fma(-q, 6.12323399573676603587e-17, r);
        const int qd = ((int)q) & 3;
        const double r2 = r * r;
        const double s = r * (1.0 + r2 * (-1.0 / 6.0 + r2 * (1.0 / 120.0 + r2 * (-1.0 / 5040.0 + r2 * (1.0 / 362880.0 + r2 * (-1.0 / 39916800.0 + r2 * (1.0 / 6227020800.0)))))));
        const double c = 1.0 + r2 * (-0.5 + r2 * (1.0 / 24.0 + r2 * (-1.0 / 720.0 + r2 * (1.0 / 40320.0 + r2 * (-1.0 / 3628800.0 + r2 * (1.0 / 479001600.0 + r2 * (-1.0 / 87178291200.0)))))));
        double co, si;
        if (qd == 0) { co = c; si = s; } else if (qd == 1) { co = -s; si = c; } else if (qd == 2) { co = -c; si = -s; } else { co = s; si = -c; }
        tab[idx] = make_float2((float)co, (float)si);
    }
}

__device__ __forceinline__ void phaseA_norm(const Params& p, float* wab  ) {
    const int tid = threadIdx.x, wave = tid >> 6, lane = tid & 63;
    for (int i = tid; i < 8192; i += 512) { const int k = i >> 3, j = i & 7; wab[j * 1024 + k] = p.w_in[(size_t)k * INW + 4096 + j]; }
    __syncthreads();
    bf16_t* hbuf = (bf16_t*)(p.ws + W_H); float* ab = (float*)(p.ws + W_AB);
    for (int row = blockIdx.x * 8 + wave; row < TT; row += gridDim.x * 8) {
        const float* xr = row < TP ? p.x_prompt + (size_t)row * DM : p.x_sample + (size_t)(row - TP) * DM;
        float4 v[4]; float ss = 0.f;
#pragma unroll
        for (int i = 0; i < 4; ++i) { v[i] = *(const float4*)(xr + lane * 4 + 256 * i); ss += v[i].x * v[i].x + v[i].y * v[i].y + v[i].z * v[i].z + v[i].w * v[i].w; }
        ss = wave_sum(ss);
        const float rs = rsqrtf(ss * (1.0f / 1024.0f) + 1e-6f);
        float acc[8];
#pragma unroll
        for (int j = 0; j < 8; ++j) acc[j] = 0.f;
#pragma unroll
        for (int i = 0; i < 4; ++i) {
            const float4 w = *(const float4*)(p.pre_mix_w + lane * 4 + 256 * i);
            const float h0 = v[i].x * rs * w.x, h1 = v[i].y * rs * w.y, h2 = v[i].z * rs * w.z, h3 = v[i].w * rs * w.w;
            u32x2 o; o.x = pk_bf16(h0, h1); o.y = pk_bf16(h2, h3);
            *(u32x2*)(hbuf + (size_t)row * DM + lane * 4 + 256 * i) = o;
#pragma unroll
            for (int j = 0; j < 8; ++j) { const float4 wj = *(const float4*)(wab + j * 1024 + lane * 4 + 256 * i); acc[j] += h0 * wj.x + h1 * wj.y + h2 * wj.z + h3 * wj.w; }
        }
#pragma unroll
        for (int j = 0; j < 8; ++j) acc[j] = wave_sum(acc[j]);
        if (lane < 8) {
            float a = acc[0];
#pragma unroll
            for (int j = 1; j < 8; ++j) a = (lane == j) ? acc[j] : a;
            float o;
            if (lane < 4) { const float xx = a + p.dt_bias[lane]; const float sp = xx > 20.f ? xx : log1pf(expf(xx)); o = -expf(p.A_log[lane]) * sp; }
            else o = 1.0f / (1.0f + expf(-a));
            ab[(size_t)row * 8 + lane] = o;
        }
    }
}

__device__ __forceinline__ void phaseE_rows(const Params& p) {
    const int tid = threadIdx.x, wave = tid >> 6, lane = tid & 63;
    const float* mbuf = (const float*)(p.ws + W_PROJ); bf16_t* hbuf = (bf16_t*)(p.ws + W_H);
    for (int row = blockIdx.x * 8 + wave; row < TT; row += gridDim.x * 8) {
        const float* xr = row < TP ? p.x_prompt + (size_t)row * DM : p.x_sample + (size_t)(row - TP) * DM;
        const float* mr = mbuf + (size_t)row * DM; float* yr = p.out + (size_t)row * DM;
        float4 m[4], x[4]; float ss = 0.f;
#pragma unroll
        for (int i = 0; i < 4; ++i) { m[i] = *(const float4*)(mr + lane * 4 + 256 * i); x[i] = *(const float4*)(xr + lane * 4 + 256 * i); ss += m[i].x * m[i].x + m[i].y * m[i].y + m[i].z * m[i].z + m[i].w * m[i].w; }
        ss = wave_sum(ss);
        const float rs = rsqrtf(ss * (1.0f / 1024.0f) + 1e-6f);
        float ss2 = 0.f;
#pragma unroll
        for (int i = 0; i < 4; ++i) { const float4 w = *(const float4*)(p.post_mix_w + lane * 4 + 256 * i);
            x[i].x += m[i].x * rs * w.x; x[i].y += m[i].y * rs * w.y; x[i].z += m[i].z * rs * w.z; x[i].w += m[i].w * rs * w.w;
            *(float4*)(yr + lane * 4 + 256 * i) = x[i];
            ss2 += x[i].x * x[i].x + x[i].y * x[i].y + x[i].z * x[i].z + x[i].w * x[i].w; }
        ss2 = wave_sum(ss2);
        const float rs2 = rsqrtf(ss2 * (1.0f / 1024.0f) + 1e-6f);
#pragma unroll
        for (int i = 0; i < 4; ++i) { const float4 w = *(const float4*)(p.pre_mlp_w + lane * 4 + 256 * i);
            u32x2 o; o.x = pk_bf16(x[i].x * rs2 * w.x, x[i].y * rs2 * w.y); o.y = pk_bf16(x[i].z * rs2 * w.z, x[i].w * rs2 * w.w);
            *(u32x2*)(hbuf + (size_t)row * DM + lane * 4 + 256 * i) = o; }
    }
}
__device__ __forceinline__ void phaseH_rows(const Params& p) {
    const int tid = threadIdx.x, wave = tid >> 6, lane = tid & 63;
    const float* fbuf = (const float*)(p.ws + W_H);
    for (int row = blockIdx.x * 8 + wave; row < TT; row += gridDim.x * 8) {
        const float* fr = fbuf + (size_t)row * DM; float* yr = p.out + (size_t)row * DM;
        float4 f[4], x[4]; float ss = 0.f;
#pragma unroll
        for (int i = 0; i < 4; ++i) { f[i] = *(const float4*)(fr + lane * 4 + 256 * i); x[i] = *(const float4*)(yr + lane * 4 + 256 * i); ss += f[i].x * f[i].x + f[i].y * f[i].y + f[i].z * f[i].z + f[i].w * f[i].w; }
        ss = wave_sum(ss);
        const float rs = rsqrtf(ss * (1.0f / 1024.0f) + 1e-6f);
#pragma unroll
        for (int i = 0; i < 4; ++i) { const float4 w = *(const float4*)(p.post_mlp_w + lane * 4 + 256 * i);
            x[i].x += f[i].x * rs * w.x; x[i].y += f[i].y * rs * w.y; x[i].z += f[i].z * rs * w.z; x[i].w += f[i].w * rs * w.w;
            *(float4*)(yr + lane * 4 + 256 * i) = x[i]; }
    }
}

__device__ __forceinline__ void phaseC1_gdn_prep(const Params& p, unsigned char* lds) {
    const int tid = threadIdx.x, w = tid >> 6, lane = tid & 63, r = lane & 31, hh = lane >> 5;
    float* qc = (float*)lds; float* kc = qc + 64 * 129; float* vc = kc + 64 * 129;
    unsigned char* knb = lds + 99072; unsigned char* qnb = lds + 116480;
    float* Amat = (float*)(lds + 133888); float* cum = (float*)(lds + 150272); float* beta = cum + 64; float* rnq = cum + 128; float* rnk = cum + 192; float* fack = cum + 256;
    const bf16_t* proj = (const bf16_t*)(p.ws + W_PROJ); const float* ab = (const float*)(p.ws + W_AB);
    for (int item = blockIdx.x; item < 1536; item += gridDim.x) {
        const bool sample = item >= 1024;
        int b, n, h, row0, nrows, slot;
        if (!sample) { b = item >> 7; n = (item >> 2) & 31; h = item & 3; row0 = b * 2048 + n * 64; nrows = 64; slot = (b * 4 + h) * 32 + n; }
        else { const int s = item - 1024; b = s >> 2; n = 0; h = s & 3; row0 = TP + b * 8; nrows = 8; slot = s; }
        unsigned char* sbase = sample ? (unsigned char*)(p.out + O_GS) + (size_t)slot * 65536 : (unsigned char*)(p.out + O_YP) + (size_t)slot * 65536;
        bf16_t* sc_out = (bf16_t*)(p.ws + (sample ? W_SCS : W_SCP)) + (size_t)slot * 4096;
        float* dec_out = (float*)(p.ws + W_DEC) + (sample ? 1024 + slot : slot);
        if (tid < 384) {
            const int seg = tid >> 7, d = tid & 127, ch = seg * 512 + h * 128 + d;
            const float c0 = p.conv_w[ch], c1 = p.conv_w[1536 + ch], c2 = p.conv_w[3072 + ch], c3 = p.conv_w[4608 + ch];
            const bf16_t* src = proj + (size_t)row0 * NPJ + 2048 + ch;
            float xm3 = 0.f, xm2 = 0.f, xm1 = 0.f;
            if (sample) { const float* sc = p.state_conv + (size_t)b * 3 * 1536 + ch; xm3 = sc[0]; xm2 = sc[1536]; xm1 = sc[3072]; }
            else if (n > 0) { xm3 = bf2f(*(src - 3 * NPJ)); xm2 = bf2f(*(src - 2 * NPJ)); xm1 = bf2f(*(src - NPJ)); }
            float* dst = qc + seg * (64 * 129) + d;
#pragma unroll 8
            for (int i = 0; i < nrows; ++i) {
                const float x = bf2f(src[(size_t)i * NPJ]);
                float cv = c0 * xm3; cv += c1 * xm2; cv += c2 * xm1; cv += c3 * x;
                dst[i * 129] = cv / (1.0f + __expf(-cv));
                xm3 = xm2; xm2 = xm1; xm1 = x;
            }
            for (int i = nrows; i < 64; ++i) dst[i * 129] = 0.f;
            if (sample) { float* co = p.out + O_CS + (size_t)b * 3 * 1536 + ch; co[0] = xm3; co[1536] = xm2; co[3072] = xm1; }
            else if (n == 31) { float* co = p.out + O_CP + (size_t)b * 3 * 1536 + ch; co[0] = xm3; co[1536] = xm2; co[3072] = xm1; }
        } else if (tid < 448) {
            const int i = tid - 384;
            float g = 0.f, be = 0.f;
            if (i < nrows) { g = ab[(size_t)(row0 + i) * 8 + h]; be = ab[(size_t)(row0 + i) * 8 + 4 + h]; }
#pragma unroll
            for (int o = 1; o < 64; o <<= 1) { const float t = __shfl_up(g, o); if (i >= o) g += t; }
            cum[i] = g; beta[i] = be;
        }
        __syncthreads();
        if (tid < 128) {
            const int which = tid >> 6, row = tid & 63; const float* bp = (which ? kc : qc) + row * 129;
            float ss = 0.f;
#pragma unroll 16
            for (int d = 0; d < 128; ++d) ss += bp[d] * bp[d];
            float rn = rsqrtf(ss + 1e-6f);
            if (!which) rnq[row] = rn * 0.08838834764831845f; else { rnk[row] = rn; fack[row] = rn * beta[row] * __expf(cum[row]); }
        }
        __syncthreads();
#pragma unroll
        for (int it = 0; it < 4; ++it) {
            const int idx = tid + 512 * it, img = idx >> 10, rem = idx & 1023, row = rem >> 4, chunk = rem & 15;
            const float* sp = (img ? kc : qc) + row * 129 + chunk * 8; const float rn = img ? rnk[row] : rnq[row];
            u32x4 o; o.x = pk_bf16(sp[0] * rn, sp[1] * rn); o.y = pk_bf16(sp[2] * rn, sp[3] * rn); o.z = pk_bf16(sp[4] * rn, sp[5] * rn); o.w = pk_bf16(sp[6] * rn, sp[7] * rn);
            *(u32x4*)((img ? knb : qnb) + sw256(row, chunk)) = o;
        }
        __syncthreads();
        {
            const int isq = w >> 2, it_ = (w >> 1) & 1, jt = w & 1;
            f32x16 acc;
#pragma unroll
            for (int i = 0; i < 16; ++i) acc[i] = 0.f;
            const unsigned char* ai = isq ? qnb : knb;
#pragma unroll
            for (int s = 0; s < 8; ++s) {
                const bf16x8 a = *(const bf16x8*)(ai + sw256(it_ * 32 + r, 2 * s + hh));
                const bf16x8 bb = *(const bf16x8*)(knb + sw256(jt * 32 + r, 2 * s + hh));
                acc = MFMA32(a, bb, acc);
            }
            const int j = jt * 32 + r; const float cj = cum[j];
#pragma unroll
            for (int reg = 0; reg < 16; ++reg) {
                const int i = it_ * 32 + crow(reg, hh);
                const float dm = __expf(fminf(cum[i] - cj, 0.f)), dm2 = __expf(fminf(cj - cum[i], 0.f));
                if (!isq) Amat[i * 64 + j] = (i < j) ? beta[j] * acc[reg] * dm2 : 0.f;
                else sc_out[i * 64 + j] = f2bf((j <= i) ? acc[reg] * dm : 0.f);
            }
        }
        __syncthreads();
        {
#pragma unroll
            for (int it = 0; it < 2; ++it) {
                const int idx = tid + 512 * it, row = idx >> 4, chunk = idx & 15;
                const float e = __expf(cum[row]) * rnq[row]; const float* sp = qc + row * 129 + chunk * 8;
                u32x4 o; o.x = pk_bf16(sp[0] * e, sp[1] * e); o.y = pk_bf16(sp[2] * e, sp[3] * e); o.z = pk_bf16(sp[4] * e, sp[5] * e); o.w = pk_bf16(sp[6] * e, sp[7] * e);
                *(u32x4*)(sbase + 16384 + row * 256 + chunk * 16) = o;
            }
            const int d = tid & 127, cq = tid >> 7; const float cl = cum[63];
            u32x4* o = (u32x4*)(sbase + 49152 + (size_t)d * 128 + cq * 32);
#pragma unroll
            for (int c8 = 0; c8 < 2; ++c8) {
                float v[8];
#pragma unroll
                for (int j = 0; j < 8; ++j) { const int c = cq * 16 + c8 * 8 + j; v[j] = kc[c * 129 + d] * rnk[c] * __expf(cl - cum[c]); }
                u32x4 q; q.x = pk_bf16(v[0], v[1]); q.y = pk_bf16(v[2], v[3]); q.z = pk_bf16(v[4], v[5]); q.w = pk_bf16(v[6], v[7]); o[c8] = q;
            }
            if (tid == 0) *dec_out = __expf(cl);
        }
        __syncthreads();
        if (tid < 256) {
            int vz; asm volatile("v_mov_b32 %0, 0" : "=v"(vz));
            const float* At = Amat + vz;
            float* colp = (tid < 128) ? (kc + tid) : (vc + tid - 128);
            const float* facp = ((tid < 128) ? fack : beta) + vz;
            const int nblk = nrows == 64 ? 4 : 1;
            for (int bi = 0; bi < nblk; ++bi) {
                const int R0 = bi * 16;
                float acc[16];
#pragma unroll
                for (int ii = 0; ii < 16; ++ii) acc[ii] = colp[(R0 + ii) * 129] * facp[R0 + ii];
                for (int j = 0; j < R0; ++j) {
                    const float xj = colp[j * 129];
                    const f32x4 a0 = *(const f32x4*)(At + j * 64 + R0), a1 = *(const f32x4*)(At + j * 64 + R0 + 4), a2 = *(const f32x4*)(At + j * 64 + R0 + 8), a3 = *(const f32x4*)(At + j * 64 + R0 + 12);
#pragma unroll
                    for (int q = 0; q < 4; ++q) { acc[q] -= a0[q] * xj; acc[4 + q] -= a1[q] * xj; acc[8 + q] -= a2[q] * xj; acc[12 + q] -= a3[q] * xj; }
                }
#pragma unroll
                for (int jj = 0; jj < 15; ++jj) {
                    const float* ar = At + (R0 + jj) * 64 + R0;
#pragma unroll
                    for (int ii = jj + 1; ii < 16; ++ii) acc[ii] -= ar[ii] * acc[jj];
                }
#pragma unroll
                for (int ii = 0; ii < 16; ++ii) colp[(R0 + ii) * 129] = acc[ii];
            }
            if (tid < 128) {
                bf16_t* o = (bf16_t*)sbase + tid;
#pragma unroll 8
                for (int i = 0; i < 64; ++i) o[i * 128] = f2bf(-colp[i * 129]);
            } else {
                u32x4* o = (u32x4*)(sbase + 32768 + (size_t)(tid - 128) * 128);
#pragma unroll
                for (int c8 = 0; c8 < 8; ++c8) { float x[8];
#pragma unroll
                    for (int j = 0; j < 8; ++j) x[j] = colp[(c8 * 8 + j) * 129];
                    u32x4 v; v.x = pk_bf16(x[0], x[1]); v.y = pk_bf16(x[2], x[3]); v.z = pk_bf16(x[4], x[5]); v.w = pk_bf16(x[6], x[7]); o[c8] = v; }
            }
        }
        __syncthreads();
    }
}

template <bool GDN> __device__ __forceinline__ void scan_item(const Params& p, unsigned char* lds, int b, int h, bool sample) {
    const int tid = threadIdx.x, w = tid >> 6, lane = tid & 63, r = lane & 31, hh = lane >> 5;
    const int ct = w >> 2, et = w & 3;
    unsigned char* St = lds; unsigned char* INA = lds + 34816; unsigned char* INQ = lds + 52224; unsigned char* INKT = lds + 69632;
    unsigned char* INSC = lds + 88064; unsigned char* VNT = lds + 97280; float* SSQ = (float*)(lds + 115712);
    const int nchunks = sample ? 1 : 32, nrows = sample ? 8 : 64;
    const int row_base = sample ? TP + b * 8 : b * 2048;
    const bf16_t* proj = (const bf16_t*)(p.ws + W_PROJ);
    bf16_t* mix = (bf16_t*)(p.ws + W_MIX);
    const float* nw = GDN ? p.gdn_norm_w : p.ret_norm_w;
    const int gate_col = GDN ? 3584 + h * 128 : 1536 + h * 128;
    const int mix_col = (GDN ? 512 : 0) + h * 128;
    const float2* rtab = (const float2*)(p.ws + W_ROPE);
    const float lg2 = log2f(1.0f - exp2f(-5.0f - (float)h));
    f32x16 S0, S1;
    const int e_col = et * 32 + r;
    if (sample) {
        const float* s0 = (GDN ? p.state_gdn : p.state_ret) + (size_t)(b * 4 + h) * 16384 + ((2 * ct) * 32 + 4 * hh) * 128 + e_col;
#pragma unroll
        for (int reg = 0; reg < 16; ++reg) { S0[reg] = s0[((reg & 3) + 8 * (reg >> 2)) * 128]; S1[reg] = s0[((reg & 3) + 8 * (reg >> 2) + 32) * 128]; }
    } else {
#pragma unroll
        for (int reg = 0; reg < 16; ++reg) { S0[reg] = 0.f; S1[reg] = 0.f; }
    }
    auto write_St = [&]() {
#pragma unroll
        for (int g = 0; g < 4; ++g) {
            u32x2 v0, v1; v0.x = pk_bf16(S0[4 * g], S0[4 * g + 1]); v0.y = pk_bf16(S0[4 * g + 2], S0[4 * g + 3]); v1.x = pk_bf16(S1[4 * g], S1[4 * g + 1]); v1.y = pk_bf16(S1[4 * g + 2], S1[4 * g + 3]);
            *(u32x2*)(St + sw256(e_col, (2 * ct) * 4 + g) + 8 * hh) = v0;
            *(u32x2*)(St + sw256(e_col, (2 * ct + 1) * 4 + g) + 8 * hh) = v1;
        }
    };
    write_St();
    u32x4 ra[2], rq[2], rk[2], rs4;
    u32x2 ru[4], rg[4];
    f32x4 rt[4];
    float decay = 1.f;
    const unsigned char* gbase = nullptr; const bf16_t* gsc = nullptr; const float* gdec = nullptr;
    if (GDN) {
        const int slot0 = sample ? (b * 4 + h) : (b * 4 + h) * 32;
        gbase = sample ? (const unsigned char*)(p.out + O_GS) + (size_t)slot0 * 65536 : (const unsigned char*)(p.out + O_YP) + (size_t)slot0 * 65536;
        gsc = (const bf16_t*)(p.ws + (sample ? W_SCS : W_SCP)) + (size_t)slot0 * 4096;
        gdec = (const float*)(p.ws + W_DEC) + (sample ? 1024 + slot0 : slot0);
    }
    const int c_tok = ct * 32 + r;
    auto prefetch = [&](int n) {
        const size_t trow = (size_t)row_base + n * 64;
        if (GDN) {
            const unsigned char* sb = gbase + (size_t)n * 65536;
#pragma unroll
            for (int i = 0; i < 2; ++i) { const int idx = tid + 512 * i; ra[i] = *(const u32x4*)(sb + idx * 16); rq[i] = *(const u32x4*)(sb + 16384 + idx * 16); rk[i] = *(const u32x4*)(sb + 49152 + idx * 16); }
            rs4 = *(const u32x4*)((const unsigned char*)(gsc + (size_t)n * 4096) + tid * 16);
#pragma unroll
            for (int g = 0; g < 4; ++g) ru[g] = *(const u32x2*)(sb + 32768 + (e_col * 64 + ct * 32 + 8 * g + 4 * hh) * 2);
            decay = gdec[n];
        } else {
            const int c = tid >> 3, cp = tid & 7;
            if (c < nrows) {
                const bf16_t* qr = proj + (trow + c) * NPJ + h * 128 + cp * 8;
                ra[0] = *(const u32x4*)qr; ra[1] = *(const u32x4*)(qr + 64);
                rq[0] = *(const u32x4*)(qr + 512); rq[1] = *(const u32x4*)(qr + 512 + 64);
                const int pidx = sample ? 2048 + c : n * 64 + c;
                const f32x4* tp = (const f32x4*)(rtab + (size_t)pidx * 64 + cp * 8);
                rt[0] = tp[0]; rt[1] = tp[1]; rt[2] = tp[2]; rt[3] = tp[3];
            }
#pragma unroll
            for (int i = 0; i < 2; ++i) { const int idx = tid + 512 * i, row = idx >> 4, chunk = idx & 15;
                if (row < nrows) rk[i] = *(const u32x4*)(proj + (trow + row) * NPJ + 1024 + h * 128 + chunk * 8); }
        }
        if (c_tok < nrows) {
#pragma unroll
            for (int g = 0; g < 4; ++g) rg[g] = *(const u32x2*)(proj + (trow + c_tok) * NPJ + gate_col + et * 32 + 8 * g + 4 * hh);
        }
    };
    prefetch(0);
    for (int n = 0; n < nchunks; ++n) {
        u32x2 gate[4];
#pragma unroll
        for (int g = 0; g < 4; ++g) gate[g] = rg[g];
        f32x16 acc1;
        if (GDN) {
#pragma unroll
            for (int i = 0; i < 2; ++i) { const int idx = tid + 512 * i;
                *(u32x4*)(INA + sw256(idx >> 4, idx & 15)) = ra[i]; *(u32x4*)(INQ + sw256(idx >> 4, idx & 15)) = rq[i]; *(u32x4*)(INKT + sw128(idx >> 3, idx & 7)) = rk[i]; }
            *(u32x4*)(INSC + sw128(tid >> 3, tid & 7)) = rs4;
#pragma unroll
            for (int g = 0; g < 4; ++g) { acc1[4 * g] = bflo(ru[g].x); acc1[4 * g + 1] = bfhi(ru[g].x); acc1[4 * g + 2] = bflo(ru[g].y); acc1[4 * g + 3] = bfhi(ru[g].y); }
        } else {
            const int c = tid >> 3, cp = tid & 7;
            u32x4 q1 = {0u, 0u, 0u, 0u}, q2 = q1, k1 = q1, k2 = q1;
            unsigned short kt1[8], kt2[8];
#pragma unroll
            for (int j = 0; j < 8; ++j) { kt1[j] = 0; kt2[j] = 0; }
            if (c < nrows) {
                const float fq = exp2f((float)(c + 1) * lg2), fk = 0.08838834764831845f * exp2f((float)(nrows - 1 - c) * lg2);
                float oq1[8], oq2[8], ok1[8], ok2[8];
#pragma unroll
                for (int j = 0; j < 8; ++j) {
                    const unsigned qa = ra[0][j >> 1], qb = ra[1][j >> 1], ka = rq[0][j >> 1], kb = rq[1][j >> 1];
                    const float x1 = (j & 1) ? bfhi(qa) : bflo(qa), x2 = (j & 1) ? bfhi(qb) : bflo(qb);
                    const float y1 = (j & 1) ? bfhi(ka) : bflo(ka), y2 = (j & 1) ? bfhi(kb) : bflo(kb);
                    const float co = rt[j >> 1][(j & 1) * 2], si = rt[j >> 1][(j & 1) * 2 + 1];
                    oq1[j] = (x1 * co - x2 * si) * fq; oq2[j] = (x1 * si + x2 * co) * fq;
                    ok1[j] = (y1 * co - y2 * si) * fk; ok2[j] = (y1 * si + y2 * co) * fk;
                }
#pragma unroll
                for (int j = 0; j < 4; ++j) { q1[j] = pk_bf16(oq1[2 * j], oq1[2 * j + 1]); q2[j] = pk_bf16(oq2[2 * j], oq2[2 * j + 1]); k1[j] = pk_bf16(ok1[2 * j], ok1[2 * j + 1]); k2[j] = pk_bf16(ok2[2 * j], ok2[2 * j + 1]); }
#pragma unroll
                for (int j = 0; j < 8; ++j) { kt1[j] = (unsigned short)((j & 1) ? (k1[j >> 1] >> 16) : (k1[j >> 1] & 0xffffu)); kt2[j] = (unsigned short)((j & 1) ? (k2[j >> 1] >> 16) : (k2[j >> 1] & 0xffffu)); }
            }
            *(u32x4*)(INQ + sw256(c, cp)) = q1; *(u32x4*)(INQ + sw256(c, cp + 8)) = q2;
            *(u32x4*)(INA + sw256(c, cp)) = k1; *(u32x4*)(INA + sw256(c, cp + 8)) = k2;
#pragma unroll
            for (int j = 0; j < 8; ++j) {
                const int d1 = cp * 8 + j, d2 = d1 + 64;
                *(unsigned short*)(INKT + sw128(d1, c >> 3) + (c & 7) * 2) = kt1[j];
                *(unsigned short*)(INKT + sw128(d2, c >> 3) + (c & 7) * 2) = kt2[j];
            }
#pragma unroll
            for (int i = 0; i < 2; ++i) { const int idx = tid + 512 * i, row = idx >> 4, chunk = idx & 15;
                const u32x4 vv = (row < nrows) ? rk[i] : (u32x4){0u, 0u, 0u, 0u};
#pragma unroll
                for (int j = 0; j < 8; ++j) { const int e = chunk * 8 + j;
                    *(unsigned short*)(VNT + sw128(e, row >> 3) + (row & 7) * 2) = (unsigned short)((j & 1) ? (vv[j >> 1] >> 16) : (vv[j >> 1] & 0xffffu)); } }
            decay = exp2f((float)nrows * lg2);
        }
        const float dec_n = decay;
        __syncthreads();
        if (n + 1 < nchunks) prefetch(n + 1);
        if (GDN) {
#pragma unroll
            for (int s = 0; s < 8; ++s) {
                const bf16x8 a = *(const bf16x8*)(INA + sw256(ct * 32 + r, 2 * s + hh));
                const bf16x8 bb = *(const bf16x8*)(St + sw256(et * 32 + r, 2 * s + hh));
                acc1 = MFMA32(a, bb, acc1);
            }
#pragma unroll
            for (int g = 0; g < 4; ++g) { u32x2 v; v.x = pk_bf16(acc1[4 * g], acc1[4 * g + 1]); v.y = pk_bf16(acc1[4 * g + 2], acc1[4 * g + 3]);
                *(u32x2*)(VNT + sw128(e_col, ct * 4 + g) + 8 * hh) = v; }
        } else {
            if (w < 4) {
                const int it_ = w >> 1, jt = w & 1;
#pragma unroll
                for (int i = 0; i < 16; ++i) acc1[i] = 0.f;
#pragma unroll
                for (int s = 0; s < 8; ++s) {
                    const bf16x8 a = *(const bf16x8*)(INQ + sw256(it_ * 32 + r, 2 * s + hh));
                    const bf16x8 bb = *(const bf16x8*)(INA + sw256(jt * 32 + r, 2 * s + hh));
                    acc1 = MFMA32(a, bb, acc1);
                }
                const float sc = exp2f(-(float)nrows * lg2); const int j = jt * 32 + r;
#pragma unroll
                for (int reg = 0; reg < 16; ++reg) { const int i = it_ * 32 + crow(reg, hh);
                    *(unsigned short*)(INSC + sw128(i, j >> 3) + (j & 7) * 2) = f2bf((j <= i) ? acc1[reg] * sc : 0.f); }
            }
        }
        __syncthreads();
        f32x16 acc2;
#pragma unroll
        for (int i = 0; i < 16; ++i) acc2[i] = 0.f;
#pragma unroll
        for (int s = 0; s < 8; ++s) {
            const bf16x8 a = *(const bf16x8*)(St + sw256(et * 32 + r, 2 * s + hh));
            const bf16x8 bb = *(const bf16x8*)(INQ + sw256(ct * 32 + r, 2 * s + hh));
            acc2 = MFMA32(a, bb, acc2);
        }
#pragma unroll
        for (int s = 0; s < 4; ++s) {
            const bf16x8 a = *(const bf16x8*)(VNT + sw128(et * 32 + r, 2 * s + hh));
            const bf16x8 bb = *(const bf16x8*)(INSC + sw128(ct * 32 + r, 2 * s + hh));
            acc2 = MFMA32(a, bb, acc2);
        }
        {
            float sq = 0.f;
#pragma unroll
            for (int i = 0; i < 16; ++i) sq += acc2[i] * acc2[i];
            sq += __shfl_xor(sq, 32);
            if (hh == 0) SSQ[et * 64 + c_tok] = sq;
        }
#pragma unroll
        for (int i = 0; i < 16; ++i) { S0[i] *= dec_n; S1[i] *= dec_n; }
#pragma unroll
        for (int s = 0; s < 4; ++s) {
            const bf16x8 bb = *(const bf16x8*)(VNT + sw128(et * 32 + r, 2 * s + hh));
            const bf16x8 a0 = *(const bf16x8*)(INKT + sw128((2 * ct) * 32 + r, 2 * s + hh));
            const bf16x8 a1 = *(const bf16x8*)(INKT + sw128((2 * ct + 1) * 32 + r, 2 * s + hh));
            S0 = MFMA32(a0, bb, S0); S1 = MFMA32(a1, bb, S1);
        }
        __syncthreads();
        write_St();
        if (c_tok < nrows) {
            const float ss = SSQ[c_tok] + SSQ[64 + c_tok] + SSQ[128 + c_tok] + SSQ[192 + c_tok];
            const float rn = rsqrtf(ss * (1.0f / 128.0f) + 1e-6f);
            bf16_t* orow = mix + ((size_t)row_base + n * 64 + c_tok) * DM + mix_col + et * 32;
#pragma unroll
            for (int g = 0; g < 4; ++g) {
                const int e0 = 8 * g + 4 * hh;
                const f32x4 wv = *(const f32x4*)(nw + et * 32 + e0);
                const float o0 = acc2[4 * g] * rn * wv[0] * silu(bflo(gate[g].x)), o1 = acc2[4 * g + 1] * rn * wv[1] * silu(bfhi(gate[g].x));
                const float o2 = acc2[4 * g + 2] * rn * wv[2] * silu(bflo(gate[g].y)), o3 = acc2[4 * g + 3] * rn * wv[3] * silu(bfhi(gate[g].y));
                u32x2 v; v.x = pk_bf16(o0, o1); v.y = pk_bf16(o2, o3);
                *(u32x2*)(orow + e0) = v;
            }
        }
    }
    {
        float* so = p.out + (sample ? (GDN ? O_GS : O_RS) : (GDN ? O_GP : O_RP)) + (size_t)(b * 4 + h) * 16384 + ((2 * ct) * 32 + 4 * hh) * 128 + e_col;
#pragma unroll
        for (int reg = 0; reg < 16; ++reg) { so[((reg & 3) + 8 * (reg >> 2)) * 128] = S0[reg]; so[((reg & 3) + 8 * (reg >> 2) + 32) * 128] = S1[reg]; }
    }
    __syncthreads();
}

__device__ __forceinline__ void phaseC2_scan(const Params& p, unsigned char* lds) {
    const int G = gridDim.x, bid = blockIdx.x;
    int start = bid, limit = 1088, stride = G;
    if (G >= 128) { if (bid < 64) { limit = 64; stride = 64; } else { start = bid; stride = G - 64; } }
    for (int s = start; s < limit; s += stride) {
        const bool sample = s >= 64; const int t = sample ? s - 64 : s; const int bh = t >> 1, b = bh >> 2, h = bh & 3;
        if (t & 1) scan_item<true>(p, lds, b, h, sample); else scan_item<false>(p, lds, b, h, sample);
    }
}

#ifndef DUMP_PROJ
#define DUMP_PROJ 0
#define DUMP_OFF W_PROJ
#define DUMP_BYTES 142606336ull
#endif
#ifndef SANITIZE
#define SANITIZE 0
#endif
#ifndef PHASE_MASK
#define PHASE_MASK 511
#endif
__global__ void __launch_bounds__(512, 2) fwd_megakernel(Params p) {
    extern __shared__ __attribute__((aligned(16))) unsigned char shm[];
    cg::grid_group grid = cg::this_grid();
    const bool multi = (p.phase_hi - p.phase_lo) > 1;
#define RUN(ph) (p.phase_lo <= (ph) && (ph) < p.phase_hi && (PHASE_MASK & (1 << (ph))))
#define SEAM(ph) do { if (multi && p.phase_lo <= (ph) && (ph) + 1 < p.phase_hi) { __syncthreads(); grid.sync(); } } while (0)
    if (RUN(0)) { phaseA_weights(p, (float*)shm); phaseA_norm(p, (float*)shm); phaseA_rope(p); }
    SEAM(0);
    if (RUN(1)) {
        pg8::Gemm g; g.A = (const bf16_t*)(p.ws + W_H); g.Bt = (const bf16_t*)(p.ws + W_WIN); g.M = TT; g.N = NPJ; g.K = DM;
        pg8::StaticOrder S; S.init(g.M, g.N, (int)gridDim.x, (int)blockIdx.x);
        pg8::EpiBf16<0> E; E.O = (bf16_t*)(p.ws + W_PROJ); E.ldc = NPJ;
        pg8::gemm_phase<pg8::EpiBf16<0>, pg8::StaticOrder, false>((PG8_LAS unsigned char*)shm, g, S, E, nullptr);
    }
    SEAM(1);
    if (RUN(2)) phaseC1_gdn_prep(p, shm);
    SEAM(2);
    if (RUN(3)) phaseC2_scan(p, shm);
    SEAM(3);
    if (RUN(4)) {
        pg8::Gemm g; g.A = (const bf16_t*)(p.ws + W_MIX); g.Bt = (const bf16_t*)(p.ws + W_WOUT); g.M = TT; g.N = DM; g.K = DM;
        pg8::StaticOrder S; S.init(g.M, g.N, (int)gridDim.x, (int)blockIdx.x);
        pg8::EpiF32 E; E.C = (float*)(p.ws + W_PROJ); E.ldc = DM;
        pg8::gemm_phase<pg8::EpiF32, pg8::StaticOrder, false>((PG8_LAS unsigned char*)shm, g, S, E, nullptr);
    }
    SEAM(4);
    if (RUN(5)) phaseE_rows(p);
    SEAM(5);
    if (RUN(6)) {
        pg8::Gemm g; g.A = (const bf16_t*)(p.ws + W_H); g.Bt = (const bf16_t*)(p.ws + W_WUP); g.M = TT; g.N = DFF; g.K = DM;
        pg8::StaticOrder S; S.init(g.M, g.N, (int)gridDim.x, (int)blockIdx.x);
        pg8::EpiBf16<1> E; E.O = (bf16_t*)(p.ws + W_PROJ); E.ldc = DFF;
        pg8::gemm_phase<pg8::EpiBf16<1>, pg8::StaticOrder, false>((PG8_LAS unsigned char*)shm, g, S, E, nullptr);
    }
    SEAM(6);
    if (RUN(7)) {
        pg8::Gemm g; g.A = (const bf16_t*)(p.ws + W_PROJ); g.Bt = (const bf16_t*)(p.ws + W_WDN); g.M = TT; g.N = DM; g.K = DFF;
        pg8::StaticOrder S; S.init(g.M, g.N, (int)gridDim.x, (int)blockIdx.x);
        pg8::EpiF32 E; E.C = (float*)(p.ws + W_H); E.ldc = DM;
        pg8::gemm_phase<pg8::EpiF32, pg8::StaticOrder, false>((PG8_LAS unsigned char*)shm, g, S, E, nullptr);
    }
    SEAM(7);
    if (RUN(8)) phaseH_rows(p);
#if DUMP_PROJ
    if (p.phase_lo <= 9 && 9 < p.phase_hi) { const u32x4* src = (const u32x4*)(p.ws + DUMP_OFF); u32x4* dst = (u32x4*)p.out; for (size_t i = (size_t)blockIdx.x * 512 + threadIdx.x; i < DUMP_BYTES / 16; i += (size_t)gridDim.x * 512) dst[i] = src[i]; }
#endif
#if SANITIZE
    SEAM(8);
    if (p.phase_lo <= 9 && 9 < p.phase_hi) { for (size_t i = (size_t)blockIdx.x * 512 + threadIdx.x; i < 36278272; i += (size_t)gridDim.x * 512) { const float v = p.out[i]; if (!(fabsf(v) < 1e30f)) p.out[i] = 0.f; } }
#endif
}

constexpr size_t kDynLds = 152576;

extern "C" void kernel_launch(void* const* d_in, const int* in_sizes, int n_in, void* d_out, int out_size, void* d_ws, size_t ws_size, hipStream_t stream) {
    (void)in_sizes; (void)n_in; (void)out_size; (void)ws_size;
    static int grid_blocks = 0;
    if (!grid_blocks) {
        hipFuncSetAttribute((const void*)fwd_megakernel, hipFuncAttributeMaxDynamicSharedMemorySize, (int)kDynLds);
        int dev = 0, cus = 0, per_cu = 0;
        hipGetDevice(&dev);
        hipDeviceGetAttribute(&cus, hipDeviceAttributeMultiprocessorCount, dev);
        hipOccupancyMaxActiveBlocksPerMultiprocessor(&per_cu, fwd_megakernel, 512, kDynLds);
        if (per_cu < 1) per_cu = 1;
        if (per_cu > 1) per_cu = 1;
        grid_blocks = cus * per_cu;
    }
    Params p; memset(&p, 0, sizeof(p));
    p.x_prompt = (const float*)d_in[0]; p.x_sample = (const float*)d_in[1]; p.state_ret = (const float*)d_in[2]; p.state_gdn = (const float*)d_in[3];
    p.state_conv = (const float*)d_in[4]; p.pre_mix_w = (const float*)d_in[5]; p.w_in = (const float*)d_in[6]; p.conv_w = (const float*)d_in[7];
    p.A_log = (const float*)d_in[8]; p.dt_bias = (const float*)d_in[9]; p.ret_norm_w = (const float*)d_in[10]; p.gdn_norm_w = (const float*)d_in[11];
    p.w_out = (const float*)d_in[12]; p.post_mix_w = (const float*)d_in[13]; p.pre_mlp_w = (const float*)d_in[14]; p.w_up = (const float*)d_in[15];
    p.w_down = (const float*)d_in[16]; p.post_mlp_w = (const float*)d_in[17];
    p.out = (float*)d_out; p.ws = (unsigned char*)d_ws;
    p.rope_r = std::pow(10000.0, -1.0 / 64.0);
#if MULTI_LAUNCH
    for (int ph = 0; ph < 9 + SANITIZE; ++ph) {
        p.phase_lo = ph; p.phase_hi = ph + 1;
        hipLaunchKernelGGL(fwd_megakernel, dim3(grid_blocks), dim3(512), kDynLds, stream, p);
    }
#else
    p.phase_lo = 0; p.phase_hi = 9 + SANITIZE;
    void* args[] = {&p};
    hipError_t e = hipLaunchCooperativeKernel((const void*)fwd_megakernel, dim3(grid_blocks), dim3(512), args, kDynLds, stream);
    if (e != hipSuccess) fprintf(stderr, "cooperative launch failed: %s (grid %d)\n", hipGetErrorString(e), grid_blocks);
#endif
}
```

```cpp
#include <hip/hip_runtime.h>
#include <hip/hip_cooperative_groups.h>
#include <cstdio>
#include <cmath>
#include <cstring>
namespace cg = cooperative_groups;

#ifndef MULTI_LAUNCH
#define MULTI_LAUNCH 0
#endif

typedef unsigned short bf16_t;
typedef short bf16x8 __attribute__((ext_vector_type(8)));
typedef float f32x4 __attribute__((ext_vector_type(4)));
typedef float f32x16 __attribute__((ext_vector_type(16)));
typedef unsigned u32x4 __attribute__((ext_vector_type(4)));
typedef unsigned u32x2 __attribute__((ext_vector_type(2)));

constexpr int TP = 16384, TS = 1024, TT = TP + TS, DM = 1024, INW = 4104, NPJ = 4096, DFF = 4096;
constexpr size_t O_YP = 0, O_YS = 16777216, O_RP = 17825792, O_GP = 18350080, O_CP = 18874368, O_RS = 18911232, O_GS = 27299840, O_CS = 35688448;
constexpr size_t W_WIN = 0, W_WOUT = W_WIN + 8388608, W_WUP = W_WOUT + 2097152, W_WDN = W_WUP + 8388608, W_H = W_WDN + 8388608,
                 W_MIX = W_H + 35651584, W_PROJ = W_MIX + 35651584, W_AB = W_PROJ + 142606336, W_ROPE = W_AB + 557056,
                 W_SCP = W_ROPE + 1052672, W_SCS = W_SCP + 8388608, W_DEC = W_SCS + 4194304, W_END = W_DEC + 8192;

struct Params {
    const float *x_prompt, *x_sample, *state_ret, *state_gdn, *state_conv, *pre_mix_w, *w_in, *conv_w, *A_log, *dt_bias,
                *ret_norm_w, *gdn_norm_w, *w_out, *post_mix_w, *pre_mlp_w, *w_up, *w_down, *post_mlp_w;
    float* out;
    unsigned char* ws;
    double rope_r;
    int phase_lo, phase_hi;
};

#define DI __device__ __forceinline__
DI float bf2f(unsigned short b) { return __uint_as_float(((unsigned)b) << 16); }
DI float bflo(unsigned u) { return __uint_as_float(u << 16); }
DI float bfhi(unsigned u) { return __uint_as_float(u & 0xffff0000u); }
typedef float f32x2_t __attribute__((ext_vector_type(2)));
typedef __bf16 bf16x2_t __attribute__((ext_vector_type(2)));
DI unsigned pk_bf16(float lo, float hi) { f32x2_t v = {lo, hi}; bf16x2_t b = __builtin_convertvector(v, bf16x2_t); return __builtin_bit_cast(unsigned, b); }
DI unsigned short f2bf(float f) { return (unsigned short)(pk_bf16(f, 0.f) & 0xffffu); }
DI int sw256(int row, int chunk) { return row * 272 + (chunk << 4); }
DI int sw128(int row, int chunk) { return row * 144 + (chunk << 4); }
DI int sw128x(int row, int chunk) { return row * 144 + ((chunk ^ ((row >> 3) & 7)) << 4); }
DI int crow(int reg, int hh) { return (reg & 3) + 8 * (reg >> 2) + 4 * hh; }
DI float wave_sum(float v) { for (int o = 32; o >= 1; o >>= 1) v += __shfl_xor(v, o); return v; }
DI float silu(float x) { return x / (1.0f + __expf(-x)); }
#define MFMA32(a, b, c) __builtin_amdgcn_mfma_f32_32x32x16_bf16((a), (b), (c), 0, 0, 0)

template <int NR> DI void fwd_subst(float (&x)[64], const float* Amat) {
#pragma unroll
    for (int i = 1; i < NR; ++i) {
        float s = x[i];
#pragma unroll
        for (int j = 0; j < i; ++j) s -= Amat[i * 64 + j] * x[j];
        x[i] = s;
        asm volatile("" ::: "memory");
    }
}
namespace pg8 {
#define PG8_LAS __attribute__((address_space(3)))
typedef unsigned short bf16_t;
typedef short bf16x8 __attribute__((ext_vector_type(8)));
typedef float f32x4 __attribute__((ext_vector_type(4)));
typedef unsigned u32x4 __attribute__((ext_vector_type(4)));
constexpr int BM = 256, BK = 64, HALF = 128, HTB = HALF * BK * 2  , STAGE_BYTES = 8 * HTB, NXCD = 8, WGM = 8;

__host__ __device__ __forceinline__ int lds_byte(int r, int c) { const int st = (r >> 4) * 2 + (c >> 5), rr = r & 15, cc = c & 31, ob = rr * 64 + cc * 2; return st * 1024 + (ob ^ (((ob >> 9) & 1) << 5)); }
__host__ __device__ __forceinline__ void stage_rc(int b, int& R, int& C) { const int st = b / 1024, sb = b % 1024, swz = sb ^ (((sb >> 9) & 1) << 5); R = (st >> 1) * 16 + swz / 64; C = (st & 1) * 32 + (swz % 64) / 2; }
__host__ __device__ __forceinline__ int perm32(int rho) { const int n = rho >> 4, i = rho & 15; return 8 * (i >> 2) + 4 * n + (i & 3); }

struct Unit { int pm, pn; };
struct Gemm { const bf16_t* A; const bf16_t* Bt; int M, N, K; };

struct StaticOrder {
    int nM, nN, nwg, G, c;
    __host__ __device__ void init(int M, int N, int G_, int c_) { nM = M / BM; nN = N / BM; nwg = nM * nN; G = G_; c = c_; }
    __host__ __device__ bool next(int i, Unit& u) const {
        const long L = (long)i * G + c; if (L >= nwg) return false;
        int wgid = (int)L; { const int q = nwg / NXCD, r = nwg % NXCD, xcd = wgid % NXCD, off = wgid / NXCD; wgid = (xcd < r ? xcd * (q + 1) : r * (q + 1) + (xcd - r) * q) + off; }
        const int nig = WGM * nN, gid = wgid / nig, fm = gid * WGM, gsz = (nM - fm) < WGM ? (nM - fm) : WGM;
        u.pm = fm + ((wgid % nig) % gsz); u.pn = (wgid % nig) / gsz; return true;
    }
    __device__ __forceinline__ void a_ready(const Unit&) const {}
    __device__ __forceinline__ void done(const Unit&) const {}
};

__device__ __forceinline__ unsigned cvt_pk_bf16(float lo, float hi) { return ::pk_bf16(lo, hi); }
struct EpiF32 {
    static constexpr bool PERM = false, AFTER_DRAIN = false;
    float* C; int ldc;
    __device__ __forceinline__ void operator()(const f32x4 (&acc)[2][2][4][2], const Unit& u, int wr, int wc, int fr, int fq) const {
        const int row0 = u.pm * BM + wr * 64 + fr, col0 = u.pn * BM + wc * 32 + 4 * fq;
#pragma unroll
        for (int ai = 0; ai < 2; ++ai)
#pragma unroll
            for (int m = 0; m < 4; ++m) { float* rowp = C + (size_t)(row0 + ai * HALF + m * 16) * ldc + col0;
#pragma unroll
                for (int bj = 0; bj < 2; ++bj)
#pragma unroll
                    for (int n = 0; n < 2; ++n) *(f32x4*)(rowp + bj * HALF + n * 16) = acc[ai][bj][m][n]; }
    }
};
template <int ACT  > struct EpiBf16 {
    static constexpr bool PERM = true, AFTER_DRAIN = false;
    bf16_t* O; int ldc;
    __device__ __forceinline__ void operator()(const f32x4 (&acc)[2][2][4][2], const Unit& u, int wr, int wc, int fr, int fq) const {
        const int row0 = u.pm * BM + wr * 64 + fr; const int col0 = u.pn * BM + wc * 32 + 8 * fq;
#pragma unroll
        for (int ai = 0; ai < 2; ++ai)
#pragma unroll
            for (int m = 0; m < 4; ++m) { bf16_t* rowp = O + (size_t)(row0 + ai * HALF + m * 16) * ldc + col0;
#pragma unroll
                for (int bj = 0; bj < 2; ++bj) { f32x4 v0 = acc[ai][bj][m][0], v1 = acc[ai][bj][m][1];
                    if (ACT == 1) {
#pragma unroll
                        for (int j = 0; j < 4; ++j) { const float a = fmaxf(v0[j], 0.f), b = fmaxf(v1[j], 0.f); v0[j] = a * a; v1[j] = b * b; } }
                    u32x4 w; w.x = cvt_pk_bf16(v0[0], v0[1]); w.y = cvt_pk_bf16(v0[2], v0[3]); w.z = cvt_pk_bf16(v1[0], v1[1]); w.w = cvt_pk_bf16(v1[2], v1[3]);
                    *(u32x4*)(rowp + bj * HALF) = w; } }
    }
};
template <class Epi, class Sched, bool STAMP = false>
__device__ __forceinline__ void gemm_phase(PG8_LAS unsigned char* lds, const Gemm g, const Sched& S, const Epi& E, unsigned long long* stamps) {
    const int tid = threadIdx.x, wid = __builtin_amdgcn_readfirstlane(tid >> 6), lane = tid & 63, wr = wid >> 2, wc = wid & 3, fr = lane & 15, fq = lane >> 4;
    const int K = g.K, nt = K / BK;
    int ts_lo = 0, ts_hi = 0, nts = 0; const unsigned long long rt_entry = STAMP ? (unsigned long long)wall_clock64() : 0ull;
#define PG8_STAMP() do { if (STAMP && wid == 0 && nts < 64) { const unsigned long long _c = (unsigned long long)clock64(); \
        ts_lo = (lane == nts) ? (int)(unsigned)_c : ts_lo; ts_hi = (lane == nts) ? (int)(unsigned)(_c >> 32) : ts_hi; ++nts; } } while (0)
    PG8_STAMP();
    unsigned voffA[2], voffB[2];
#pragma unroll
    for (int i = 0; i < 2; ++i) { int R, C; stage_rc(tid * 16 + i * 8192, R, C); const int Rb = Epi::PERM ? ((R & ~31) + perm32(R & 31)) : R;
        voffA[i] = (unsigned)(R * K + C) * 2u; voffB[i] = (unsigned)(Rb * K + C) * 2u; }
    const size_t kstep = (size_t)(BK * 2);
    const size_t hstep = (size_t)HALF * K * 2;
    const size_t tstep = 2 * hstep;
    const unsigned ldsw = (unsigned)wid * 1024u;
    const int aoff = lds_byte(wr * 64 + fr, fq * 8), boff = lds_byte(wc * 32 + fr, fq * 8);
#define PG8_SA(b, h) (((b) * 2 + (h)) * HTB)
#define PG8_SB(b, h) ((4 + (b) * 2 + (h)) * HTB)
#define PG8_STAGE(bufoff, gbase, voff) do { _Pragma("unroll") for (int _i = 0; _i < 2; ++_i) \
        __builtin_amdgcn_global_load_lds((const unsigned*)((const char*)(gbase) + (voff)[_i]), (PG8_LAS unsigned*)(lds + (bufoff) + ldsw + _i * 8192), 16, 0, 0); } while (0)
#define PG8_LDA(dst, b, h) do { _Pragma("unroll") for (int m = 0; m < 4; ++m) _Pragma("unroll") for (int k = 0; k < 2; ++k) dst[m][k] = *(const PG8_LAS bf16x8*)(lds + PG8_SA(b, h) + aoff + m * 2048 + k * 1024); } while (0)
#define PG8_LDB(dst, b, h) do { _Pragma("unroll") for (int n = 0; n < 2; ++n) _Pragma("unroll") for (int k = 0; k < 2; ++k) dst[n][k] = *(const PG8_LAS bf16x8*)(lds + PG8_SB(b, h) + boff + n * 2048 + k * 1024); } while (0)
#define PG8_MMA(ai, bj, At, Bt) do { __builtin_amdgcn_s_setprio(1); _Pragma("unroll") for (int m = 0; m < 4; ++m) _Pragma("unroll") for (int n = 0; n < 2; ++n) _Pragma("unroll") for (int k = 0; k < 2; ++k) \
        acc[ai][bj][m][n] = __builtin_amdgcn_mfma_f32_16x16x32_bf16(Bt[n][k], At[m][k], acc[ai][bj][m][n], 0, 0, 0); __builtin_amdgcn_s_setprio(0); } while (0)
#define PG8_WAIT_V(n) asm volatile("s_waitcnt vmcnt(" #n ")" ::: "memory")
#define PG8_WAIT_L(n) asm volatile("s_waitcnt lgkmcnt(" #n ")" ::: "memory")
#define PG8_BAR __builtin_amdgcn_s_barrier()
#define PG8_SCHED __builtin_amdgcn_sched_barrier(0)
    Unit cur, nxt; int ui = 0;
    if (!S.next(0, cur)) return;
    f32x4 acc[2][2][4][2];
#pragma unroll
    for (int a = 0; a < 2; ++a)
#pragma unroll
        for (int b = 0; b < 2; ++b)
#pragma unroll
            for (int m = 0; m < 4; ++m)
#pragma unroll
                for (int n = 0; n < 2; ++n) acc[a][b][m][n] = (f32x4){0.f, 0.f, 0.f, 0.f};
    bf16x8 At[4][2], B0[2][2], B1[2][2];
    const char* cA = (const char*)g.A + (size_t)cur.pm * tstep; const char* cB = (const char*)g.Bt + (size_t)cur.pn * tstep;
    S.a_ready(cur);
    PG8_STAGE(PG8_SB(0, 0), cB, voffB); PG8_STAGE(PG8_SA(0, 0), cA, voffA); PG8_STAGE(PG8_SB(0, 1), cB + hstep, voffB); PG8_STAGE(PG8_SA(0, 1), cA + hstep, voffA);
    if (wr == 1) PG8_BAR;
    PG8_WAIT_V(4); PG8_BAR;
    PG8_STAGE(PG8_SB(1, 0), cB + kstep, voffB); PG8_STAGE(PG8_SA(1, 0), cA + kstep, voffA); PG8_STAGE(PG8_SB(1, 1), cB + hstep + kstep, voffB);
    PG8_WAIT_V(6); PG8_BAR;
    PG8_STAMP();
    for (;;) {
        const bool has_next = S.next(ui + 1, nxt);
        const char* nA = has_next ? (const char*)g.A + (size_t)nxt.pm * tstep : cA; const char* nB = has_next ? (const char*)g.Bt + (size_t)nxt.pn * tstep : cB;
        for (int t = 0; t < nt; t += 2) {
            const bool last = (t == nt - 2);
            const char* a1 = cA + (size_t)(t + 1) * kstep;
            const char* a2 = last ? nA : cA + (size_t)(t + 2) * kstep; const char* b2 = last ? nB : cB + (size_t)(t + 2) * kstep;
            const char* a3 = a2 + kstep; const char* b3 = b2 + kstep;
            if (last && has_next) S.a_ready(nxt);
            PG8_LDB(B0, 0, 0); PG8_SCHED; PG8_LDA(At, 0, 0); PG8_STAGE(PG8_SA(1, 1), a1 + hstep, voffA);
            PG8_WAIT_L(8); PG8_BAR; PG8_WAIT_L(0); PG8_MMA(0, 0, At, B0); PG8_BAR; PG8_SCHED;
            PG8_LDB(B1, 0, 1); PG8_STAGE(PG8_SB(0, 0), b2, voffB);
            PG8_BAR; PG8_WAIT_L(0); PG8_MMA(0, 1, At, B1); PG8_BAR;
            PG8_LDA(At, 0, 1); PG8_STAGE(PG8_SA(0, 0), a2, voffA);
            PG8_BAR; PG8_WAIT_L(0); PG8_MMA(1, 0, At, B0); PG8_BAR; PG8_SCHED;
            PG8_STAGE(PG8_SB(0, 1), b2 + hstep, voffB);
            PG8_WAIT_V(6); PG8_BAR; PG8_MMA(1, 1, At, B1); PG8_BAR;
            PG8_LDB(B0, 1, 0); PG8_SCHED; PG8_LDA(At, 1, 0); PG8_STAGE(PG8_SA(0, 1), a2 + hstep, voffA);
            PG8_WAIT_L(8); PG8_BAR; PG8_WAIT_L(0); PG8_MMA(0, 0, At, B0); PG8_BAR; PG8_SCHED;
            PG8_LDB(B1, 1, 1); PG8_STAGE(PG8_SB(1, 0), b3, voffB);
            PG8_BAR; PG8_WAIT_L(0); PG8_MMA(0, 1, At, B1); PG8_BAR;
            PG8_LDA(At, 1, 1); PG8_STAGE(PG8_SA(1, 0), a3, voffA);
            PG8_BAR; PG8_WAIT_L(0); PG8_MMA(1, 0, At, B0); PG8_BAR; PG8_SCHED;
            PG8_STAGE(PG8_SB(1, 1), b3 + hstep, voffB);
            PG8_WAIT_V(6); PG8_BAR; PG8_MMA(1, 1, At, B1); PG8_BAR;
        }
        PG8_STAMP();
        if constexpr (!Epi::AFTER_DRAIN) { E(acc, cur, wr, wc, fr, fq); S.done(cur); }
        PG8_STAMP();
        if (!has_next) break;
#pragma unroll
        for (int a = 0; a < 2; ++a)
#pragma unroll
            for (int b = 0; b < 2; ++b)
#pragma unroll
                for (int m = 0; m < 4; ++m)
#pragma unroll
                    for (int n = 0; n < 2; ++n) acc[a][b][m][n] = (f32x4){0.f, 0.f, 0.f, 0.f};
        cur = nxt; cA = nA; cB = nB; ++ui;
    }
    PG8_WAIT_V(0);
    if (wr == 0) PG8_BAR;
    PG8_BAR;
    if constexpr (Epi::AFTER_DRAIN) { E.fused(acc, cur, wr, wc, fr, fq, lds, wid, lane); S.done(cur); }
    PG8_STAMP();
    if (STAMP && wid == 0) { stamps[lane] = lane < nts ? (((unsigned long long)(unsigned)ts_hi << 32) | (unsigned)ts_lo) : 0ull;
        if (lane == 62) stamps[62] = rt_entry; if (lane == 63) stamps[63] = (unsigned long long)wall_clock64(); }
#undef PG8_STAMP
#undef PG8_SA
#undef PG8_SB
#undef PG8_STAGE
#undef PG8_LDA
#undef PG8_LDB
#undef PG8_MMA
#undef PG8_WAIT_V
#undef PG8_WAIT_L
#undef PG8_BAR
#undef PG8_SCHED
}
}

__device__ __forceinline__ void phaseA_weights(const Params& p, float* tl  ) {
    const int tid = threadIdx.x;
    for (int tile = blockIdx.x; tile < 3328; tile += gridDim.x) {
        const float* src; bf16_t* dst; int ldn, K, lt;
        if (tile < 1024)      { src = p.w_in;   ldn = INW;  K = 1024; dst = (bf16_t*)(p.ws + W_WIN);  lt = tile; }
        else if (tile < 1280) { src = p.w_out;  ldn = 1024; K = 1024; dst = (bf16_t*)(p.ws + W_WOUT); lt = tile - 1024; }
        else if (tile < 2304) { src = p.w_up;   ldn = 4096; K = 1024; dst = (bf16_t*)(p.ws + W_WUP);  lt = tile - 1280; }
        else                  { src = p.w_down; ldn = 1024; K = 4096; dst = (bf16_t*)(p.ws + W_WDN);  lt = tile - 2304; }
        const int nkt = K >> 6, kt = lt % nkt, nt = lt / nkt;
#pragma unroll
        for (int i = 0; i < 2; ++i) {
            const int r = (tid >> 4) + 32 * i, c4 = (tid & 15) * 4;
            const float4 v = *(const float4*)(src + (size_t)(kt * 64 + r) * ldn + nt * 64 + c4);
            tl[r * 65 + c4 + 0] = v.x; tl[r * 65 + c4 + 1] = v.y; tl[r * 65 + c4 + 2] = v.z; tl[r * 65 + c4 + 3] = v.w;
        }
        __syncthreads();
        {
            const int n = tid >> 3, k8 = (tid & 7) * 8;
            float v[8];
#pragma unroll
            for (int j = 0; j < 8; ++j) v[j] = tl[(k8 + j) * 65 + n];
            u32x4 w; w.x = pk_bf16(v[0], v[1]); w.y = pk_bf16(v[2], v[3]); w.z = pk_bf16(v[4], v[5]); w.w = pk_bf16(v[6], v[7]);
            *(u32x4*)(dst + (size_t)(nt * 64 + n) * K + kt * 64 + k8) = w;
        }
        __syncthreads();
    }
}

__device__ __forceinline__ void phaseA_rope(const Params& p) {
    float2* tab = (float2*)(p.ws + W_ROPE);
    for (int idx = blockIdx.x * 512 + threadIdx.x; idx < 2056 * 64; idx += gridDim.x * 512) {
        const int pi = idx >> 6, f = idx & 63;
        double ivd = 1.0; for (int k = 0; k < f; ++k) ivd *= p.rope_r;
        const float ivf = (float)ivd;
        const float pos = pi < 2048 ? (float)pi : (float)(16384 + pi - 2048);
        const float ang = pos * ivf;
        const double a = (double)ang, q = rint(a * 0.63661977236758134308);
        double r = fma(-q, 1.57079632679489655800, a); r = fma(-q, 6.12323399573676603587e-17, r);
        const int qd = ((int)q) & 3;
        const double r2 = r * r;
        const double s = r * (1.0 + r2 * (-1.0 / 6.0 + r2 * (1.0 / 120.0 + r2 * (-1.0 / 5040.0 + r2 * (1.0 / 362880.0 + r2 * (-1.0 / 39916800.0 + r2 * (1.0 / 6227020800.0)))))));
        const double c = 1.0 + r2 * (-0.5 + r2 * (1.0 / 24.0 + r2 * (-1.0 / 720.0 + r2 * (1.0 / 40320.0 + r2 * (-1.0 / 3628800.0 + r2 * (1.0 / 479001600.0 + r2 * (-1.0 / 87178291200.0)))))));
        double co, si;
        if (qd == 0) { co = c; si = s; } else if (qd == 1) { co = -s; si = c; } else if (qd == 2) { co = -c; si = -s; } else { co = s; si = -c; }
        tab[idx] = make_float2((float)co, (float)si);
    }
}

__device__ __forceinline__ void phaseA_norm(const Params& p, float* wab  ) {
    const int tid = threadIdx.x, wave = tid >> 6, lane = tid & 63;
    for (int i = tid; i < 8192; i += 512) { const int k = i >> 3, j = i & 7; wab[j * 1024 + k] = p.w_in[(size_t)k * INW + 4096 + j]; }
    __syncthreads();
    bf16_t* hbuf = (bf16_t*)(p.ws + W_H); float* ab = (float*)(p.ws + W_AB);
    for (int row = blockIdx.x * 8 + wave; row < TT; row += gridDim.x * 8) {
        const float* xr = row < TP ? p.x_prompt + (size_t)row * DM : p.x_sample + (size_t)(row - TP) * DM;
        float4 v[4]; float ss = 0.f;
#pragma unroll
        for (int i = 0; i < 4; ++i) { v[i] = *(const float4*)(xr + lane * 4 + 256 * i); ss += v[i].x * v[i].x + v[i].y * v[i].y + v[i].z * v[i].z + v[i].w * v[i].w; }
        ss = wave_sum(ss);
        const float rs = rsqrtf(ss * (1.0f / 1024.0f) + 1e-6f);
        float acc[8];
#pragma unroll
        for (int j = 0; j < 8; ++j) acc[j] = 0.f;
#pragma unroll
        for (int i = 0; i < 4; ++i) {
            const float4 w = *(const float4*)(p.pre_mix_w + lane * 4 + 256 * i);
            const float h0 = v[i].x * rs * w.x, h1 = v[i].y * rs * w.y, h2 = v[i].z * rs * w.z, h3 = v[i].w * rs * w.w;
            u32x2 o; o.x = pk_bf16(h0, h1); o.y = pk_bf16(h2, h3);
            *(u32x2*)(hbuf + (size_t)row * DM + lane * 4 + 256 * i) = o;
#pragma unroll
            for (int j = 0; j < 8; ++j) { const float4 wj = *(const float4*)(wab + j * 1024 + lane * 4 + 256 * i); acc[j] += h0 * wj.x + h1 * wj.y + h2 * wj.z + h3 * wj.w; }
        }
#pragma unroll
        for (int j = 0; j < 8; ++j) acc[j] = wave_sum(acc[j]);
        if (lane < 8) {
            float a = acc[0];
#pragma unroll
            for (int j = 1; j < 8; ++j) a = (lane == j) ? acc[j] : a;
            float o;
            if (lane < 4) { const float xx = a + p.dt_bias[lane]; const float sp = xx > 20.f ? xx : log1pf(expf(xx)); o = -expf(p.A_log[lane]) * sp; }
            else o = 1.0f / (1.0f + expf(-a));
            ab[(size_t)row * 8 + lane] = o;
        }
    }
}

__device__ __forceinline__ void phaseE_rows(const Params& p) {
    const int tid = threadIdx.x, wave = tid >> 6, lane = tid & 63;
    const float* mbuf = (const float*)(p.ws + W_PROJ); bf16_t* hbuf = (bf16_t*)(p.ws + W_H);
    for (int row = blockIdx.x * 8 + wave; row < TT; row += gridDim.x * 8) {
        const float* xr = row < TP ? p.x_prompt + (size_t)row * DM : p.x_sample + (size_t)(row - TP) * DM;
        const float* mr = mbuf + (size_t)row * DM; float* yr = p.out + (size_t)row * DM;
        float4 m[4], x[4]; float ss = 0.f;
#pragma unroll
        for (int i = 0; i < 4; ++i) { m[i] = *(const float4*)(mr + lane * 4 + 256 * i); x[i] = *(const float4*)(xr + lane * 4 + 256 * i); ss += m[i].x * m[i].x + m[i].y * m[i].y + m[i].z * m[i].z + m[i].w * m[i].w; }
        ss = wave_sum(ss);
        const float rs = rsqrtf(ss * (1.0f / 1024.0f) + 1e-6f);
        float ss2 = 0.f;
#pragma unroll
        for (int i = 0; i < 4; ++i) { const float4 w = *(const float4*)(p.post_mix_w + lane * 4 + 256 * i);
            x[i].x += m[i].x * rs * w.x; x[i].y += m[i].y * rs * w.y; x[i].z += m[i].z * rs * w.z; x[i].w += m[i].w * rs * w.w;
            *(float4*)(yr + lane * 4 + 256 * i) = x[i];
            ss2 += x[i].x * x[i].x + x[i].y * x[i].y + x[i].z * x[i].z + x[i].w * x[i].w; }
        ss2 = wave_sum(ss2);
        const float rs2 = rsqrtf(ss2 * (1.0f / 1024.0f) + 1e-6f);
#pragma unroll
        for (int i = 0; i < 4; ++i) { const float4 w = *(const float4*)(p.pre_mlp_w + lane * 4 + 256 * i);
            u32x2 o; o.x = pk_bf16(x[i].x * rs2 * w.x, x[i].y * rs2 * w.y); o.y = pk_bf16(x[i].z * rs2 * w.z, x[i].w * rs2 * w.w);
            *(u32x2*)(hbuf + (size_t)row * DM + lane * 4 + 256 * i) = o; }
    }
}
__device__ __forceinline__ void phaseH_rows(const Params& p) {
    const int tid = threadIdx.x, wave = tid >> 6, lane = tid & 63;
    const float* fbuf = (const float*)(p.ws + W_H);
    for (int row = blockIdx.x * 8 + wave; row < TT; row += gridDim.x * 8) {
        const float* fr = fbuf + (size_t)row * DM; float* yr = p.out + (size_t)row * DM;
        float4 f[4], x[4]; float ss = 0.f;
#pragma unroll
        for (int i = 0; i < 4; ++i) { f[i] = *(const float4*)(fr + lane * 4 + 256 * i); x[i] = *(const float4*)(yr + lane * 4 + 256 * i); ss += f[i].x * f[i].x + f[i].y * f[i].y + f[i].z * f[i].z + f[i].w * f[i].w; }
        ss = wave_sum(ss);
        const float rs = rsqrtf(ss * (1.0f / 1024.0f) + 1e-6f);
#pragma unroll
        for (int i = 0; i < 4; ++i) { const float4 w = *(const float4*)(p.post_mlp_w + lane * 4 + 256 * i);
            x[i].x += f[i].x * rs * w.x; x[i].y += f[i].y * rs * w.y; x[i].z += f[i].z * rs * w.z; x[i].w += f[i].w * rs * w.w;
            *(float4*)(yr + lane * 4 + 256 * i) = x[i]; }
    }
}

__device__ __forceinline__ void phaseC1_gdn_prep(const Params& p, unsigned char* lds) {
    const int tid = threadIdx.x, w = tid >> 6, lane = tid & 63, r = lane & 31, hh = lane >> 5;
    float* qc = (float*)lds; float* kc = qc + 64 * 129; float* vc = kc + 64 * 129;
    unsigned char* knb = lds + 99072; unsigned char* qnb = lds + 116480;
    float* Amat = (float*)(lds + 133888); float* cum = (float*)(lds + 150528); float* beta = cum + 64; float* rnq = cum + 128; float* rnk = cum + 192; float* fack = cum + 256;
    bf16_t* stg = (bf16_t*)(lds + 99072);
    const bf16_t* proj = (const bf16_t*)(p.ws + W_PROJ); const float* ab = (const float*)(p.ws + W_AB);
    for (int item = blockIdx.x; item < 1536; item += gridDim.x) {
        const bool sample = item >= 1024;
        int b, n, h, row0, nrows, slot;
        if (!sample) { b = item >> 7; n = (item >> 2) & 31; h = item & 3; row0 = b * 2048 + n * 64; nrows = 64; slot = (b * 4 + h) * 32 + n; }
        else { const int s = item - 1024; b = s >> 2; n = 0; h = s & 3; row0 = TP + b * 8; nrows = 8; slot = s; }
        unsigned char* sbase = sample ? (unsigned char*)(p.out + O_GS) + (size_t)slot * 65536 : (unsigned char*)(p.out + O_YP) + (size_t)slot * 65536;
        bf16_t* sc_out = (bf16_t*)(p.ws + (sample ? W_SCS : W_SCP)) + (size_t)slot * 4096;
        float* dec_out = (float*)(p.ws + W_DEC) + (sample ? 1024 + slot : slot);
        {
            const int nld = nrows * 48;
            for (int idx = tid; idx < nld; idx += 512) {
                const int row = idx / 48, rem = idx - row * 48, seg = rem >> 4, pc = rem & 15;
                *(u32x4*)(stg + row * 384 + seg * 128 + pc * 8) = *(const u32x4*)(proj + (size_t)(row0 + row) * NPJ + 2048 + seg * 512 + h * 128 + pc * 8);
            }
        }
        __syncthreads();
        if (tid < 384) {
            const int seg = tid >> 7, d = tid & 127, ch = seg * 512 + h * 128 + d;
            const float c0 = p.conv_w[ch], c1 = p.conv_w[1536 + ch], c2 = p.conv_w[3072 + ch], c3 = p.conv_w[4608 + ch];
            const bf16_t* src = proj + (size_t)row0 * NPJ + 2048 + ch;
            float xm3 = 0.f, xm2 = 0.f, xm1 = 0.f;
            if (sample) { const float* sc = p.state_conv + (size_t)b * 3 * 1536 + ch; xm3 = sc[0]; xm2 = sc[1536]; xm1 = sc[3072]; }
            else if (n > 0) { xm3 = bf2f(*(src - 3 * NPJ)); xm2 = bf2f(*(src - 2 * NPJ)); xm1 = bf2f(*(src - NPJ)); }
            float* dst = qc + seg * (64 * 129) + d;
#pragma unroll 8
            for (int i = 0; i < nrows; ++i) {
                const float x = bf2f(stg[i * 384 + tid]);
                float cv = c0 * xm3; cv += c1 * xm2; cv += c2 * xm1; cv += c3 * x;
                dst[i * 129] = cv / (1.0f + __expf(-cv));
                xm3 = xm2; xm2 = xm1; xm1 = x;
            }
            for (int i = nrows; i < 64; ++i) dst[i * 129] = 0.f;
            if (sample) { float* co = p.out + O_CS + (size_t)b * 3 * 1536 + ch; co[0] = xm3; co[1536] = xm2; co[3072] = xm1; }
            else if (n == 31) { float* co = p.out + O_CP + (size_t)b * 3 * 1536 + ch; co[0] = xm3; co[1536] = xm2; co[3072] = xm1; }
        } else if (tid < 448) {
            const int i = tid - 384;
            float g = 0.f, be = 0.f;
            if (i < nrows) { g = ab[(size_t)(row0 + i) * 8 + h]; be = ab[(size_t)(row0 + i) * 8 + 4 + h]; }
#pragma unroll
            for (int o = 1; o < 64; o <<= 1) { const float t = __shfl_up(g, o); if (i >= o) g += t; }
            cum[i] = g; beta[i] = be;
        }
        __syncthreads();
        if (tid < 128) {
            const int which = tid >> 6, row = tid & 63; const float* bp = (which ? kc : qc) + row * 129;
            float ss = 0.f;
#pragma unroll 16
            for (int d = 0; d < 128; ++d) ss += bp[d] * bp[d];
            float rn = rsqrtf(ss + 1e-6f);
            if (!which) rnq[row] = rn * 0.08838834764831845f; else { rnk[row] = rn; fack[row] = rn * beta[row] * __expf(cum[row]); }
        }
        __syncthreads();
#pragma unroll
        for (int it = 0; it < 4; ++it) {
            const int idx = tid + 512 * it, img = idx >> 10, rem = idx & 1023, row = rem >> 4, chunk = rem & 15;
            const float* sp = (img ? kc : qc) + row * 129 + chunk * 8; const float rn = img ? rnk[row] : rnq[row];
            u32x4 o; o.x = pk_bf16(sp[0] * rn, sp[1] * rn); o.y = pk_bf16(sp[2] * rn, sp[3] * rn); o.z = pk_bf16(sp[4] * rn, sp[5] * rn); o.w = pk_bf16(sp[6] * rn, sp[7] * rn);
            *(u32x4*)((img ? knb : qnb) + sw256(row, chunk)) = o;
        }
        __syncthreads();
        {
            const int isq = w >> 2, it_ = (w >> 1) & 1, jt = w & 1;
            f32x16 acc;
#pragma unroll
            for (int i = 0; i < 16; ++i) acc[i] = 0.f;
            const unsigned char* ai = isq ? qnb : knb;
#pragma unroll
            for (int s = 0; s < 8; ++s) {
                const bf16x8 a = *(const bf16x8*)(ai + sw256(it_ * 32 + r, 2 * s + hh));
                const bf16x8 bb = *(const bf16x8*)(knb + sw256(jt * 32 + r, 2 * s + hh));
                acc = MFMA32(a, bb, acc);
            }
            const int j = jt * 32 + r; const float cj = cum[j];
#pragma unroll
            for (int reg = 0; reg < 16; ++reg) {
                const int i = it_ * 32 + crow(reg, hh);
                const float dm = __expf(fminf(cum[i] - cj, 0.f)), dm2 = __expf(fminf(cj - cum[i], 0.f));
                if (!isq) Amat[i * 64 + j] = (i < j) ? beta[j] * acc[reg] * dm2 : 0.f;
                else sc_out[i * 64 + j] = f2bf((j <= i) ? acc[reg] * dm : 0.f);
            }
        }
        __syncthreads();
        {
#pragma unroll
            for (int it = 0; it < 2; ++it) {
                const int idx = tid + 512 * it, row = idx >> 4, chunk = idx & 15;
                const float e = __expf(cum[row]) * rnq[row]; const float* sp = qc + row * 129 + chunk * 8;
                u32x4 o; o.x = pk_bf16(sp[0] * e, sp[1] * e); o.y = pk_bf16(sp[2] * e, sp[3] * e); o.z = pk_bf16(sp[4] * e, sp[5] * e); o.w = pk_bf16(sp[6] * e, sp[7] * e);
                *(u32x4*)(sbase + 16384 + row * 256 + chunk * 16) = o;
            }
            const int d = tid & 127, cq = tid >> 7; const float cl = cum[63];
            u32x4* o = (u32x4*)(sbase + 49152 + (size_t)d * 128 + cq * 32);
#pragma unroll
            for (int c8 = 0; c8 < 2; ++c8) {
                float v[8];
#pragma unroll
                for (int j = 0; j < 8; ++j) { const int c = cq * 16 + c8 * 8 + j; v[j] = kc[c * 129 + d] * rnk[c] * __expf(cl - cum[c]); }
                u32x4 q; q.x = pk_bf16(v[0], v[1]); q.y = pk_bf16(v[2], v[3]); q.z = pk_bf16(v[4], v[5]); q.w = pk_bf16(v[6], v[7]); o[c8] = q;
            }
            if (tid == 0) *dec_out = __expf(cl);
        }
        __syncthreads();
        if (tid < 256) {
            int vz; asm volatile("v_mov_b32 %0, 0" : "=v"(vz));
            const float* At = Amat + vz;
            float* colp = (tid < 128) ? (kc + tid) : (vc + tid - 128);
            const float* facp = ((tid < 128) ? fack : beta) + vz;
            const int nblk = nrows == 64 ? 4 : 1;
            for (int bi = 0; bi < nblk; ++bi) {
                const int R0 = bi * 16;
                float acc[16];
#pragma unroll
                for (int ii = 0; ii < 16; ++ii) acc[ii] = colp[(R0 + ii) * 129] * facp[R0 + ii];
#pragma unroll 4
                for (int j = 0; j < R0; ++j) {
                    const float xj = colp[j * 129];
                    const f32x4 a0 = *(const f32x4*)(At + j * 64 + R0), a1 = *(const f32x4*)(At + j * 64 + R0 + 4), a2 = *(const f32x4*)(At + j * 64 + R0 + 8), a3 = *(const f32x4*)(At + j * 64 + R0 + 12);
#pragma unroll
                    for (int q = 0; q < 4; ++q) { acc[q] -= a0[q] * xj; acc[4 + q] -= a1[q] * xj; acc[8 + q] -= a2[q] * xj; acc[12 + q] -= a3[q] * xj; }
                }
#pragma unroll
                for (int jj = 0; jj < 15; ++jj) {
                    const float* ar = At + (R0 + jj) * 64 + R0;
#pragma unroll
                    for (int ii = jj + 1; ii < 16; ++ii) acc[ii] -= ar[ii] * acc[jj];
                }
#pragma unroll
                for (int ii = 0; ii < 16; ++ii) colp[(R0 + ii) * 129] = acc[ii];
            }
            if (tid < 128) {
                bf16_t* o = (bf16_t*)sbase + tid;
#pragma unroll 8
                for (int i = 0; i < 64; ++i) o[i * 128] = f2bf(-colp[i * 129]);
            } else {
                u32x4* o = (u32x4*)(sbase + 32768 + (size_t)(tid - 128) * 128);
#pragma unroll
                for (int c8 = 0; c8 < 8; ++c8) { float x[8];
#pragma unroll
                    for (int j = 0; j < 8; ++j) x[j] = colp[(c8 * 8 + j) * 129];
                    u32x4 v; v.x = pk_bf16(x[0], x[1]); v.y = pk_bf16(x[2], x[3]); v.z = pk_bf16(x[4], x[5]); v.w = pk_bf16(x[6], x[7]); o[c8] = v; }
            }
        }
        __syncthreads();
    }
}

template <bool GDN> __device__ __forceinline__ void scan_item(const Params& p, unsigned char* lds, int b, int h, bool sample) {
    const int tid = threadIdx.x, w = tid >> 6, lane = tid & 63, r = lane & 31, hh = lane >> 5;
    const int ct = w >> 2, et = w & 3;
    unsigned char* St = lds; unsigned char* INA = lds + 34816; unsigned char* INQ = lds + 52224; unsigned char* INKT = lds + 69632;
    unsigned char* INSC = lds + 88064; unsigned char* VNT = lds + 97280; float* SSQ = (float*)(lds + 115712);
    const int nchunks = sample ? 1 : 32, nrows = sample ? 8 : 64;
    const int row_base = sample ? TP + b * 8 : b * 2048;
    const bf16_t* proj = (const bf16_t*)(p.ws + W_PROJ);
    bf16_t* mix = (bf16_t*)(p.ws + W_MIX);
    const float* nw = GDN ? p.gdn_norm_w : p.ret_norm_w;
    const int gate_col = GDN ? 3584 + h * 128 : 1536 + h * 128;
    const int mix_col = (GDN ? 512 : 0) + h * 128;
    const float2* rtab = (const float2*)(p.ws + W_ROPE);
    const float lg2 = log2f(1.0f - exp2f(-5.0f - (float)h));
    f32x16 S0, S1;
    const int e_col = et * 32 + r;
    if (sample) {
        const float* s0 = (GDN ? p.state_gdn : p.state_ret) + (size_t)(b * 4 + h) * 16384 + ((2 * ct) * 32 + 4 * hh) * 128 + e_col;
#pragma unroll
        for (int reg = 0; reg < 16; ++reg) { S0[reg] = s0[((reg & 3) + 8 * (reg >> 2)) * 128]; S1[reg] = s0[((reg & 3) + 8 * (reg >> 2) + 32) * 128]; }
    } else {
#pragma unroll
        for (int reg = 0; reg < 16; ++reg) { S0[reg] = 0.f; S1[reg] = 0.f; }
    }
    auto write_St = [&]() {
#pragma unroll
        for (int g = 0; g < 4; ++g) {
            u32x2 v0, v1; v0.x = pk_bf16(S0[4 * g], S0[4 * g + 1]); v0.y = pk_bf16(S0[4 * g + 2], S0[4 * g + 3]); v1.x = pk_bf16(S1[4 * g], S1[4 * g + 1]); v1.y = pk_bf16(S1[4 * g + 2], S1[4 * g + 3]);
            *(u32x2*)(St + sw256(e_col, (2 * ct) * 4 + g) + 8 * hh) = v0;
            *(u32x2*)(St + sw256(e_col, (2 * ct + 1) * 4 + g) + 8 * hh) = v1;
        }
    };
    write_St();
    u32x4 ra[2], rq[2], rk[2], rs4;
    u32x2 ru[4];
    f32x4 rt[4];
    float decay = 1.f;
    const unsigned char* gbase = nullptr; const bf16_t* gsc = nullptr; const float* gdec = nullptr;
    if (GDN) {
        const int slot0 = sample ? (b * 4 + h) : (b * 4 + h) * 32;
        gbase = sample ? (const unsigned char*)(p.out + O_GS) + (size_t)slot0 * 65536 : (const unsigned char*)(p.out + O_YP) + (size_t)slot0 * 65536;
        gsc = (const bf16_t*)(p.ws + (sample ? W_SCS : W_SCP)) + (size_t)slot0 * 4096;
        gdec = (const float*)(p.ws + W_DEC) + (sample ? 1024 + slot0 : slot0);
    }
    const int c_tok = ct * 32 + r;
    auto prefetch = [&](int n) {
        const size_t trow = (size_t)row_base + n * 64;
        if (GDN) {
            const unsigned char* sb = gbase + (size_t)n * 65536;
#pragma unroll
            for (int i = 0; i < 2; ++i) { const int idx = tid + 512 * i; ra[i] = *(const u32x4*)(sb + idx * 16); rq[i] = *(const u32x4*)(sb + 16384 + idx * 16); rk[i] = *(const u32x4*)(sb + 49152 + idx * 16); }
            rs4 = *(const u32x4*)((const unsigned char*)(gsc + (size_t)n * 4096) + tid * 16);
#pragma unroll
            for (int g = 0; g < 4; ++g) ru[g] = *(const u32x2*)(sb + 32768 + (e_col * 64 + ct * 32 + 8 * g + 4 * hh) * 2);
            decay = gdec[n];
        } else {
            const int c = tid >> 3, cp = tid & 7;
            if (c < nrows) {
                const bf16_t* qr = proj + (trow + c) * NPJ + h * 128 + cp * 8;
                ra[0] = *(const u32x4*)qr; ra[1] = *(const u32x4*)(qr + 64);
                rq[0] = *(const u32x4*)(qr + 512); rq[1] = *(const u32x4*)(qr + 512 + 64);
                const int pidx = sample ? 2048 + c : n * 64 + c;
                const f32x4* tp = (const f32x4*)(rtab + (size_t)pidx * 64 + cp * 8);
                rt[0] = tp[0]; rt[1] = tp[1]; rt[2] = tp[2]; rt[3] = tp[3];
            }
#pragma unroll
            for (int i = 0; i < 2; ++i) { const int idx = tid + 512 * i, row = idx >> 4, chunk = idx & 15;
                if (row < nrows) rk[i] = *(const u32x4*)(proj + (trow + row) * NPJ + 1024 + h * 128 + chunk * 8); }
        }
    };
    prefetch(0);
    for (int n = 0; n < nchunks; ++n) {
        u32x2 gate[4];
        f32x16 acc1;
        if (GDN) {
#pragma unroll
            for (int i = 0; i < 2; ++i) { const int idx = tid + 512 * i;
                *(u32x4*)(INA + sw256(idx >> 4, idx & 15)) = ra[i]; *(u32x4*)(INQ + sw256(idx >> 4, idx & 15)) = rq[i]; *(u32x4*)(INKT + sw128x(idx >> 3, idx & 7)) = rk[i]; }
            *(u32x4*)(INSC + sw128(tid >> 3, tid & 7)) = rs4;
#pragma unroll
            for (int g = 0; g < 4; ++g) { acc1[4 * g] = bflo(ru[g].x); acc1[4 * g + 1] = bfhi(ru[g].x); acc1[4 * g + 2] = bflo(ru[g].y); acc1[4 * g + 3] = bfhi(ru[g].y); }
        } else {
            const int c = tid >> 3, cp = tid & 7;
            u32x4 q1 = {0u, 0u, 0u, 0u}, q2 = q1, k1 = q1, k2 = q1;
            unsigned short kt1[8], kt2[8];
#pragma unroll
            for (int j = 0; j < 8; ++j) { kt1[j] = 0; kt2[j] = 0; }
            if (c < nrows) {
                const float fq = exp2f((float)(c + 1) * lg2), fk = 0.08838834764831845f * exp2f((float)(nrows - 1 - c) * lg2);
                float oq1[8], oq2[8], ok1[8], ok2[8];
#pragma unroll
                for (int j = 0; j < 8; ++j) {
                    const unsigned qa = ra[0][j >> 1], qb = ra[1][j >> 1], ka = rq[0][j >> 1], kb = rq[1][j >> 1];
                    const float x1 = (j & 1) ? bfhi(qa) : bflo(qa), x2 = (j & 1) ? bfhi(qb) : bflo(qb);
                    const float y1 = (j & 1) ? bfhi(ka) : bflo(ka), y2 = (j & 1) ? bfhi(kb) : bflo(kb);
                    const float co = rt[j >> 1][(j & 1) * 2], si = rt[j >> 1][(j & 1) * 2 + 1];
                    oq1[j] = (x1 * co - x2 * si) * fq; oq2[j] = (x1 * si + x2 * co) * fq;
                    ok1[j] = (y1 * co - y2 * si) * fk; ok2[j] = (y1 * si + y2 * co) * fk;
                }
#pragma unroll
                for (int j = 0; j < 4; ++j) { q1[j] = pk_bf16(oq1[2 * j], oq1[2 * j + 1]); q2[j] = pk_bf16(oq2[2 * j], oq2[2 * j + 1]); k1[j] = pk_bf16(ok1[2 * j], ok1[2 * j + 1]); k2[j] = pk_bf16(ok2[2 * j], ok2[2 * j + 1]); }
#pragma unroll
                for (int j = 0; j < 8; ++j) { kt1[j] = (unsigned short)((j & 1) ? (k1[j >> 1] >> 16) : (k1[j >> 1] & 0xffffu)); kt2[j] = (unsigned short)((j & 1) ? (k2[j >> 1] >> 16) : (k2[j >> 1] & 0xffffu)); }
            }
            *(u32x4*)(INQ + sw256(c, cp)) = q1; *(u32x4*)(INQ + sw256(c, cp + 8)) = q2;
            *(u32x4*)(INA + sw256(c, cp)) = k1; *(u32x4*)(INA + sw256(c, cp + 8)) = k2;
#pragma unroll
            for (int j = 0; j < 8; ++j) {
                const int d1 = cp * 8 + j, d2 = d1 + 64;
                *(unsigned short*)(INKT + sw128x(d1, c >> 3) + (c & 7) * 2) = kt1[j];
                *(unsigned short*)(INKT + sw128x(d2, c >> 3) + (c & 7) * 2) = kt2[j];
            }
#pragma unroll
            for (int i = 0; i < 2; ++i) { const int idx = tid + 512 * i, row = idx >> 4, chunk = idx & 15;
                const u32x4 vv = (row < nrows) ? rk[i] : (u32x4){0u, 0u, 0u, 0u};
#pragma unroll
                for (int j = 0; j < 8; ++j) { const int e = chunk * 8 + j;
                    *(unsigned short*)(VNT + sw128x(e, row >> 3) + (row & 7) * 2) = (unsigned short)((j & 1) ? (vv[j >> 1] >> 16) : (vv[j >> 1] & 0xffffu)); } }
            decay = exp2f((float)nrows * lg2);
        }
        const float dec_n = decay;
        __syncthreads();
        if (c_tok < nrows) {
#pragma unroll
            for (int g = 0; g < 4; ++g) gate[g] = *(const u32x2*)(proj + ((size_t)row_base + n * 64 + c_tok) * NPJ + gate_col + et * 32 + 8 * g + 4 * hh);
        }
        if (n + 1 < nchunks) prefetch(n + 1);
        if (GDN) {
#pragma unroll
            for (int s = 0; s < 8; ++s) {
                const bf16x8 a = *(const bf16x8*)(INA + sw256(ct * 32 + r, 2 * s + hh));
                const bf16x8 bb = *(const bf16x8*)(St + sw256(et * 32 + r, 2 * s + hh));
                acc1 = MFMA32(a, bb, acc1);
            }
#pragma unroll
            for (int g = 0; g < 4; ++g) { u32x2 v; v.x = pk_bf16(acc1[4 * g], acc1[4 * g + 1]); v.y = pk_bf16(acc1[4 * g + 2], acc1[4 * g + 3]);
                *(u32x2*)(VNT + sw128x(e_col, ct * 4 + g) + 8 * hh) = v; }
        } else {
            if (w < 4) {
                const int it_ = w >> 1, jt = w & 1;
#pragma unroll
                for (int i = 0; i < 16; ++i) acc1[i] = 0.f;
#pragma unroll
                for (int s = 0; s < 8; ++s) {
                    const bf16x8 a = *(const bf16x8*)(INQ + sw256(it_ * 32 + r, 2 * s + hh));
                    const bf16x8 bb = *(const bf16x8*)(INA + sw256(jt * 32 + r, 2 * s + hh));
                    acc1 = MFMA32(a, bb, acc1);
                }
                const float sc = exp2f(-(float)nrows * lg2); const int j = jt * 32 + r;
#pragma unroll
                for (int reg = 0; reg < 16; ++reg) { const int i = it_ * 32 + crow(reg, hh);
                    *(unsigned short*)(INSC + sw128(i, j >> 3) + (j & 7) * 2) = f2bf((j <= i) ? acc1[reg] * sc : 0.f); }
            }
        }
        __syncthreads();
        f32x16 acc2;
#pragma unroll
        for (int i = 0; i < 16; ++i) acc2[i] = 0.f;
#pragma unroll
        for (int s = 0; s < 8; ++s) {
            const bf16x8 a = *(const bf16x8*)(St + sw256(et * 32 + r, 2 * s + hh));
            const bf16x8 bb = *(const bf16x8*)(INQ + sw256(ct * 32 + r, 2 * s + hh));
            acc2 = MFMA32(a, bb, acc2);
        }
#pragma unroll
        for (int s = 0; s < 4; ++s) {
            const bf16x8 a = *(const bf16x8*)(VNT + sw128x(et * 32 + r, 2 * s + hh));
            const bf16x8 bb = *(const bf16x8*)(INSC + sw128(ct * 32 + r, 2 * s + hh));
            acc2 = MFMA32(a, bb, acc2);
        }
        {
            float sq = 0.f;
#pragma unroll
            for (int i = 0; i < 16; ++i) sq += acc2[i] * acc2[i];
            sq += __shfl_xor(sq, 32);
            if (hh == 0) SSQ[et * 64 + c_tok] = sq;
        }
#pragma unroll
        for (int i = 0; i < 16; ++i) { S0[i] *= dec_n; S1[i] *= dec_n; }
#pragma unroll
        for (int s = 0; s < 4; ++s) {
            const bf16x8 bb = *(const bf16x8*)(VNT + sw128x(et * 32 + r, 2 * s + hh));
            const bf16x8 a0 = *(const bf16x8*)(INKT + sw128x((2 * ct) * 32 + r, 2 * s + hh));
            const bf16x8 a1 = *(const bf16x8*)(INKT + sw128x((2 * ct + 1) * 32 + r, 2 * s + hh));
            S0 = MFMA32(a0, bb, S0); S1 = MFMA32(a1, bb, S1);
        }
        __syncthreads();
        write_St();
        if (c_tok < nrows) {
            const float ss = SSQ[c_tok] + SSQ[64 + c_tok] + SSQ[128 + c_tok] + SSQ[192 + c_tok];
            const float rn = rsqrtf(ss * (1.0f / 128.0f) + 1e-6f);
            bf16_t* orow = mix + ((size_t)row_base + n * 64 + c_tok) * DM + mix_col + et * 32;
#pragma unroll
            for (int g = 0; g < 4; ++g) {
                const int e0 = 8 * g + 4 * hh;
                const f32x4 wv = *(const f32x4*)(nw + et * 32 + e0);
                const float o0 = acc2[4 * g] * rn * wv[0] * silu(bflo(gate[g].x)), o1 = acc2[4 * g + 1] * rn * wv[1] * silu(bfhi(gate[g].x));
                const float o2 = acc2[4 * g + 2] * rn * wv[2] * silu(bflo(gate[g].y)), o3 = acc2[4 * g + 3] * rn * wv[3] * silu(bfhi(gate[g].y));
                u32x2 v; v.x = pk_bf16(o0, o1); v.y = pk_bf16(o2, o3);
                *(u32x2*)(orow + e0) = v;
            }
        }
    }
    {
        float* so = p.out + (sample ? (GDN ? O_GS : O_RS) : (GDN ? O_GP : O_RP)) + (size_t)(b * 4 + h) * 16384 + ((2 * ct) * 32 + 4 * hh) * 128 + e_col;
#pragma unroll
        for (int reg = 0; reg < 16; ++reg) { so[((reg & 3) + 8 * (reg >> 2)) * 128] = S0[reg]; so[((reg & 3) + 8 * (reg >> 2) + 32) * 128] = S1[reg]; }
    }
    __syncthreads();
}

__device__ __forceinline__ void phaseC2_scan(const Params& p, unsigned char* lds) {
    const int G = gridDim.x, bid = blockIdx.x;
    int start = bid, limit = 1088, stride = G;
    if (G >= 128) { if (bid < 64) { limit = 64; stride = 64; } else { start = bid; stride = G - 64; } }
    for (int s = start; s < limit; s += stride) {
        const bool sample = s >= 64; const int t = sample ? s - 64 : s; const int bh = t >> 1, b = bh >> 2, h = bh & 3;
        if (t & 1) scan_item<true>(p, lds, b, h, sample); else scan_item<false>(p, lds, b, h, sample);
    }
}

#ifndef DUMP_PROJ
#define DUMP_PROJ 0
#define DUMP_OFF W_PROJ
#define DUMP_BYTES 142606336ull
#endif
#ifndef DUP_C1
#define DUP_C1 0
#endif
#ifndef DUP_C12
#define DUP_C12 0
#endif
#ifndef SANITIZE
#define SANITIZE 0
#endif
#ifndef PHASE_MASK
#define PHASE_MASK 511
#endif
__global__ void __launch_bounds__(512, 2) fwd_megakernel(Params p) {
    extern __shared__ __attribute__((aligned(16))) unsigned char shm[];
    cg::grid_group grid = cg::this_grid();
    const bool multi = (p.phase_hi - p.phase_lo) > 1;
#define RUN(ph) (p.phase_lo <= (ph) && (ph) < p.phase_hi && (PHASE_MASK & (1 << (ph))))
#define SEAM(ph) do { if (multi && p.phase_lo <= (ph) && (ph) + 1 < p.phase_hi) { __syncthreads(); grid.sync(); } } while (0)
    if (RUN(0)) { phaseA_weights(p, (float*)shm); phaseA_norm(p, (float*)shm); phaseA_rope(p); }
    SEAM(0);
    if (RUN(1)) {
        pg8::Gemm g; g.A = (const bf16_t*)(p.ws + W_H); g.Bt = (const bf16_t*)(p.ws + W_WIN); g.M = TT; g.N = NPJ; g.K = DM;
        pg8::StaticOrder S; S.init(g.M, g.N, (int)gridDim.x, (int)blockIdx.x);
        pg8::EpiBf16<0> E; E.O = (bf16_t*)(p.ws + W_PROJ); E.ldc = NPJ;
        pg8::gemm_phase<pg8::EpiBf16<0>, pg8::StaticOrder, false>((PG8_LAS unsigned char*)shm, g, S, E, nullptr);
    }
    SEAM(1);
    if (RUN(2)) phaseC1_gdn_prep(p, shm);
    SEAM(2);
#if DUP_C1
    if (RUN(2)) phaseC1_gdn_prep(p, shm);
    SEAM(2);
#endif
    if (RUN(3)) phaseC2_scan(p, shm);
    SEAM(3);
#if DUP_C12
    if (RUN(2)) phaseC1_gdn_prep(p, shm);
    SEAM(2);
    if (RUN(3)) phaseC2_scan(p, shm);
    SEAM(3);
#endif
    if (RUN(4)) {
        pg8::Gemm g; g.A = (const bf16_t*)(p.ws + W_MIX); g.Bt = (const bf16_t*)(p.ws + W_WOUT); g.M = TT; g.N = DM; g.K = DM;
        pg8::StaticOrder S; S.init(g.M, g.N, (int)gridDim.x, (int)blockIdx.x);
        pg8::EpiF32 E; E.C = (float*)(p.ws + W_PROJ); E.ldc = DM;
        pg8::gemm_phase<pg8::EpiF32, pg8::StaticOrder, false>((PG8_LAS unsigned char*)shm, g, S, E, nullptr);
    }
    SEAM(4);
    if (RUN(5)) phaseE_rows(p);
    SEAM(5);
    if (RUN(6)) {
        pg8::Gemm g; g.A = (const bf16_t*)(p.ws + W_H); g.Bt = (const bf16_t*)(p.ws + W_WUP); g.M = TT; g.N = DFF; g.K = DM;
        pg8::StaticOrder S; S.init(g.M, g.N, (int)gridDim.x, (int)blockIdx.x);
        pg8::EpiBf16<1> E; E.O = (bf16_t*)(p.ws + W_PROJ); E.ldc = DFF;
        pg8::gemm_phase<pg8::EpiBf16<1>, pg8::StaticOrder, false>((PG8_LAS unsigned char*)shm, g, S, E, nullptr);
    }
    SEAM(6);
    if (RUN(7)) {
        pg8::Gemm g; g.A = (const bf16_t*)(p.ws + W_PROJ); g.Bt = (const bf16_t*)(p.ws + W_WDN); g.M = TT; g.N = DM; g.K = DFF;
        pg8::StaticOrder S; S.init(g.M, g.N, (int)gridDim.x, (int)blockIdx.x);
        pg8::EpiF32 E; E.C = (float*)(p.ws + W_H); E.ldc = DM;
        pg8::gemm_phase<pg8::EpiF32, pg8::StaticOrder, false>((PG8_LAS unsigned char*)shm, g, S, E, nullptr);
    }
    SEAM(7);
    if (RUN(8)) phaseH_rows(p);
#if DUMP_PROJ
    if (p.phase_lo <= 9 && 9 < p.phase_hi) { const u32x4* src = (const u32x4*)(p.ws + DUMP_OFF); u32x4* dst = (u32x4*)p.out; for (size_t i = (size_t)blockIdx.x * 512 + threadIdx.x; i < DUMP_BYTES / 16; i += (size_t)gridDim.x * 512) dst[i] = src[i]; }
#endif
#if SANITIZE
    SEAM(8);
    if (p.phase_lo <= 9 && 9 < p.phase_hi) { for (size_t i = (size_t)blockIdx.x * 512 + threadIdx.x; i < 36278272; i += (size_t)gridDim.x * 512) { const float v = p.out[i]; if (!(fabsf(v) < 1e30f)) p.out[i] = 0.f; } }
#endif
}

constexpr size_t kDynLds = 152576;

extern "C" void kernel_launch(void* const* d_in, const int* in_sizes, int n_in, void* d_out, int out_size, void* d_ws, size_t ws_size, hipStream_t stream) {
    (void)in_sizes; (void)n_in; (void)out_size; (void)ws_size;
    static int grid_blocks = 0;
    if (!grid_blocks) {
        hipFuncSetAttribute((const void*)fwd_megakernel, hipFuncAttributeMaxDynamicSharedMemorySize, (int)kDynLds);
        int dev = 0, cus = 0, per_cu = 0;
        hipGetDevice(&dev);
        hipDeviceGetAttribute(&cus, hipDeviceAttributeMultiprocessorCount, dev);
        hipOccupancyMaxActiveBlocksPerMultiprocessor(&per_cu, fwd_megakernel, 512, kDynLds);
        if (per_cu < 1) per_cu = 1;
        if (per_cu > 1) per_cu = 1;
        grid_blocks = cus * per_cu;
    }
    Params p; memset(&p, 0, sizeof(p));
    p.x_prompt = (const float*)d_in[0]; p.x_sample = (const float*)d_in[1]; p.state_ret = (const float*)d_in[2]; p.state_gdn = (const float*)d_in[3];
    p.state_conv = (const float*)d_in[4]; p.pre_mix_w = (const float*)d_in[5]; p.w_in = (const float*)d_in[6]; p.conv_w = (const float*)d_in[7];
    p.A_log = (const float*)d_in[8]; p.dt_bias = (const float*)d_in[9]; p.ret_norm_w = (const float*)d_in[10]; p.gdn_norm_w = (const float*)d_in[11];
    p.w_out = (const float*)d_in[12]; p.post_mix_w = (const float*)d_in[13]; p.pre_mlp_w = (const float*)d_in[14]; p.w_up = (const float*)d_in[15];
    p.w_down = (const float*)d_in[16]; p.post_mlp_w = (const float*)d_in[17];
    p.out = (float*)d_out; p.ws = (unsigned char*)d_ws;
    p.rope_r = std::pow(10000.0, -1.0 / 64.0);
#if MULTI_LAUNCH
    for (int ph = 0; ph < 9 + SANITIZE; ++ph) {
        p.phase_lo = ph; p.phase_hi = ph + 1;
        hipLaunchKernelGGL(fwd_megakernel, dim3(grid_blocks), dim3(512), kDynLds, stream, p);
    }
#else
    p.phase_lo = 0; p.phase_hi = 9 + SANITIZE;
    void* args[] = {&p};
    hipError_t e = hipLaunchCooperativeKernel((const void*)fwd_megakernel, dim3(grid_blocks), dim3(512), args, kDynLds, stream);
    if (e != hipSuccess) fprintf(stderr, "cooperative launch failed: %s (grid %d)\n", hipGetErrorString(e), grid_blocks);
#endif
}
```

```cpp
#include <hip/hip_runtime.h>
#include <hip/hip_cooperative_groups.h>
#include <cstdio>
#include <cmath>
#include <cstring>
namespace cg = cooperative_groups;

#ifndef MULTI_LAUNCH
#define MULTI_LAUNCH 0
#endif

typedef unsigned short bf16_t;
typedef short bf16x8 __attribute__((ext_vector_type(8)));
typedef float f32x4 __attribute__((ext_vector_type(4)));
typedef float f32x16 __attribute__((ext_vector_type(16)));
typedef unsigned u32x4 __attribute__((ext_vector_type(4)));
typedef unsigned u32x2 __attribute__((ext_vector_type(2)));

constexpr int TP = 16384, TS = 1024, TT = TP + TS, DM = 1024, INW = 4104, NPJ = 4096, DFF = 4096;
constexpr size_t O_YP = 0, O_YS = 16777216, O_RP = 17825792, O_GP = 18350080, O_CP = 18874368, O_RS = 18911232, O_GS = 27299840, O_CS = 35688448;
constexpr size_t W_WIN = 0, W_WOUT = W_WIN + 8388608, W_WUP = W_WOUT + 2097152, W_WDN = W_WUP + 8388608, W_H = W_WDN + 8388608,
                 W_MIX = W_H + 35651584, W_PROJ = W_MIX + 35651584, W_AB = W_PROJ + 142606336, W_ROPE = W_AB + 557056,
                 W_SCP = W_ROPE + 1052672, W_SCS = W_SCP + 8388608, W_DEC = W_SCS + 4194304, W_END = W_DEC + 8192, W_SMP = W_WIN;

struct Params {
    const float *x_prompt, *x_sample, *state_ret, *state_gdn, *state_conv, *pre_mix_w, *w_in, *conv_w, *A_log, *dt_bias,
                *ret_norm_w, *gdn_norm_w, *w_out, *post_mix_w, *pre_mlp_w, *w_up, *w_down, *post_mlp_w;
    float* out;
    unsigned char* ws;
    double rope_r;
    int phase_lo, phase_hi;
};

#define DI __device__ __forceinline__
DI float bf2f(unsigned short b) { return __uint_as_float(((unsigned)b) << 16); }
DI float bflo(unsigned u) { return __uint_as_float(u << 16); }
DI float bfhi(unsigned u) { return __uint_as_float(u & 0xffff0000u); }
typedef float f32x2_t __attribute__((ext_vector_type(2)));
typedef __bf16 bf16x2_t __attribute__((ext_vector_type(2)));
DI unsigned pk_bf16(float lo, float hi) { f32x2_t v = {lo, hi}; bf16x2_t b = __builtin_convertvector(v, bf16x2_t); return __builtin_bit_cast(unsigned, b); }
DI unsigned short f2bf(float f) { return (unsigned short)(pk_bf16(f, 0.f) & 0xffffu); }
DI int sw256(int row, int chunk) { return row * 272 + (chunk << 4); }
DI int sw128(int row, int chunk) { return row * 144 + (chunk << 4); }
DI int sw128x(int row, int chunk) { return row * 144 + ((chunk ^ ((row >> 3) & 7)) << 4); }
DI int crow(int reg, int hh) { return (reg & 3) + 8 * (reg >> 2) + 4 * hh; }
DI float wave_sum(float v) { for (int o = 32; o >= 1; o >>= 1) v += __shfl_xor(v, o); return v; }
DI float silu(float x) { return x * __builtin_amdgcn_rcpf(1.0f + __expf(-x)); }
#define MFMA32(a, b, c) __builtin_amdgcn_mfma_f32_32x32x16_bf16((a), (b), (c), 0, 0, 0)

template <int NR> DI void fwd_subst(float (&x)[64], const float* Amat) {
#pragma unroll
    for (int i = 1; i < NR; ++i) {
        float s = x[i];
#pragma unroll
        for (int j = 0; j < i; ++j) s -= Amat[i * 64 + j] * x[j];
        x[i] = s;
        asm volatile("" ::: "memory");
    }
}
namespace pg8 {
#define PG8_LAS __attribute__((address_space(3)))
typedef unsigned short bf16_t;
typedef short bf16x8 __attribute__((ext_vector_type(8)));
typedef float f32x4 __attribute__((ext_vector_type(4)));
typedef unsigned u32x4 __attribute__((ext_vector_type(4)));
constexpr int BM = 256, BK = 64, HALF = 128, HTB = HALF * BK * 2  , STAGE_BYTES = 8 * HTB, NXCD = 8, WGM = 8;

__host__ __device__ __forceinline__ int lds_byte(int r, int c) { const int st = (r >> 4) * 2 + (c >> 5), rr = r & 15, cc = c & 31, ob = rr * 64 + cc * 2; return st * 1024 + (ob ^ (((ob >> 9) & 1) << 5)); }
__host__ __device__ __forceinline__ void stage_rc(int b, int& R, int& C) { const int st = b / 1024, sb = b % 1024, swz = sb ^ (((sb >> 9) & 1) << 5); R = (st >> 1) * 16 + swz / 64; C = (st & 1) * 32 + (swz % 64) / 2; }
__host__ __device__ __forceinline__ int perm32(int rho) { const int n = rho >> 4, i = rho & 15; return 8 * (i >> 2) + 4 * n + (i & 3); }

struct Unit { int pm, pn, kt0, nkt, smp; };
struct Gemm { const bf16_t* A; const bf16_t* Bt; int M, N, K; };

struct StaticOrder {
    int nM, nN, nwg, G, c;
    __host__ __device__ void init(int M, int N, int G_, int c_) { nM = M / BM; nN = N / BM; nwg = nM * nN; G = G_; c = c_; }
    __host__ __device__ bool next(int i, Unit& u) const {
        const long L = (long)i * G + c; if (L >= nwg) return false;
        int wgid = (int)L; { const int q = nwg / NXCD, r = nwg % NXCD, xcd = wgid % NXCD, off = wgid / NXCD; wgid = (xcd < r ? xcd * (q + 1) : r * (q + 1) + (xcd - r) * q) + off; }
        const int nig = WGM * nN, gid = wgid / nig, fm = gid * WGM, gsz = (nM - fm) < WGM ? (nM - fm) : WGM;
        u.pm = fm + ((wgid % nig) % gsz); u.pn = (wgid % nig) / gsz; return true;
    }
    __device__ __forceinline__ void a_ready(const Unit&) const {}
    __device__ __forceinline__ void done(const Unit&) const {}
};
struct SplitOrder {
    StaticOrder so; int nN, nfull, nsub, G, c, KS, nktf;
    __host__ __device__ void init(int N, int K, int KS_, int G_, int c_) { so.init(16384, N, G_, c_); nN = N / BM; nfull = 64 * nN; KS = KS_; nsub = 4 * nN * KS; G = G_; c = c_; nktf = K / BK; }
    __host__ __device__ bool next(int i, Unit& u) const {
        const long L = (long)i * G + c; if (L >= nfull + nsub) return false;
        if (L < nfull) { so.next(i, u); u.kt0 = 0; u.nkt = nktf; u.smp = 0; }
        else { const int q = (int)(L - nfull), ks = q % KS, uu = q / KS; u.pm = 64 + (uu & 3); u.pn = uu >> 2; u.nkt = nktf / KS; u.kt0 = ks * u.nkt; u.smp = KS > 1 ? ks + 1 : 0; }
        return true;
    }
    __device__ __forceinline__ void a_ready(const Unit&) const {}
    __device__ __forceinline__ void done(const Unit&) const {}
};

__device__ __forceinline__ unsigned cvt_pk_bf16(float lo, float hi) { return ::pk_bf16(lo, hi); }
struct EpiF32 {
    static constexpr bool PERM = false, AFTER_DRAIN = false;
    float* C; float* Csmp; int ldc;
    __device__ __forceinline__ void operator()(const f32x4 (&acc)[2][2][4][2], const Unit& u, int wr, int wc, int fr, int fq) const {
        const int row0 = u.pm * BM + wr * 64 + fr, col0 = u.pn * BM + wc * 32 + 4 * fq;
        if (u.smp) {
            float* base = Csmp + (size_t)(u.smp - 1) * 1024 * ldc;
#pragma unroll
            for (int ai = 0; ai < 2; ++ai)
#pragma unroll
                for (int m = 0; m < 4; ++m) { float* rowp = base + (size_t)(row0 + ai * HALF + m * 16) * ldc + col0;
#pragma unroll
                    for (int bj = 0; bj < 2; ++bj)
#pragma unroll
                        for (int n = 0; n < 2; ++n) *(f32x4*)(rowp + bj * HALF + n * 16) = acc[ai][bj][m][n]; }
            return;
        }
#pragma unroll
        for (int ai = 0; ai < 2; ++ai)
#pragma unroll
            for (int m = 0; m < 4; ++m) { float* rowp = C + (size_t)(row0 + ai * HALF + m * 16) * ldc + col0;
#pragma unroll
                for (int bj = 0; bj < 2; ++bj)
#pragma unroll
                    for (int n = 0; n < 2; ++n) *(f32x4*)(rowp + bj * HALF + n * 16) = acc[ai][bj][m][n]; }
    }
};
template <int ACT  > struct EpiBf16 {
    static constexpr bool PERM = true, AFTER_DRAIN = false;
    bf16_t* O; int ldc;
    __device__ __forceinline__ void operator()(const f32x4 (&acc)[2][2][4][2], const Unit& u, int wr, int wc, int fr, int fq) const {
        const int row0 = u.pm * BM + wr * 64 + fr; const int col0 = u.pn * BM + wc * 32 + 8 * fq;
#pragma unroll
        for (int ai = 0; ai < 2; ++ai)
#pragma unroll
            for (int m = 0; m < 4; ++m) { bf16_t* rowp = O + (size_t)(row0 + ai * HALF + m * 16) * ldc + col0;
#pragma unroll
                for (int bj = 0; bj < 2; ++bj) { f32x4 v0 = acc[ai][bj][m][0], v1 = acc[ai][bj][m][1];
                    if (ACT == 1) {
#pragma unroll
                        for (int j = 0; j < 4; ++j) { const float a = fmaxf(v0[j], 0.f), b = fmaxf(v1[j], 0.f); v0[j] = a * a; v1[j] = b * b; } }
                    u32x4 w; w.x = cvt_pk_bf16(v0[0], v0[1]); w.y = cvt_pk_bf16(v0[2], v0[3]); w.z = cvt_pk_bf16(v1[0], v1[1]); w.w = cvt_pk_bf16(v1[2], v1[3]);
                    *(u32x4*)(rowp + bj * HALF) = w; } }
    }
};
template <class Epi, class Sched, bool STAMP = false>
__device__ __forceinline__ void gemm_phase(PG8_LAS unsigned char* lds, const Gemm g, const Sched& S, const Epi& E, unsigned long long* stamps) {
    const int tid = threadIdx.x, wid = __builtin_amdgcn_readfirstlane(tid >> 6), lane = tid & 63, wr = wid >> 2, wc = wid & 3, fr = lane & 15, fq = lane >> 4;
    const int K = g.K;
    int ts_lo = 0, ts_hi = 0, nts = 0; const unsigned long long rt_entry = STAMP ? (unsigned long long)wall_clock64() : 0ull;
#define PG8_STAMP() do { if (STAMP && wid == 0 && nts < 64) { const unsigned long long _c = (unsigned long long)clock64(); \
        ts_lo = (lane == nts) ? (int)(unsigned)_c : ts_lo; ts_hi = (lane == nts) ? (int)(unsigned)(_c >> 32) : ts_hi; ++nts; } } while (0)
    PG8_STAMP();
    unsigned voffA[2], voffB[2];
#pragma unroll
    for (int i = 0; i < 2; ++i) { int R, C; stage_rc(tid * 16 + i * 8192, R, C); const int Rb = Epi::PERM ? ((R & ~31) + perm32(R & 31)) : R;
        voffA[i] = (unsigned)(R * K + C) * 2u; voffB[i] = (unsigned)(Rb * K + C) * 2u; }
    const size_t kstep = (size_t)(BK * 2);
    const size_t hstep = (size_t)HALF * K * 2;
    const size_t tstep = 2 * hstep;
    const unsigned ldsw = (unsigned)wid * 1024u;
    const int aoff = lds_byte(wr * 64 + fr, fq * 8), boff = lds_byte(wc * 32 + fr, fq * 8);
#define PG8_SA(b, h) (((b) * 2 + (h)) * HTB)
#define PG8_SB(b, h) ((4 + (b) * 2 + (h)) * HTB)
#define PG8_STAGE(bufoff, gbase, voff) do { _Pragma("unroll") for (int _i = 0; _i < 2; ++_i) \
        __builtin_amdgcn_global_load_lds((const unsigned*)((const char*)(gbase) + (voff)[_i]), (PG8_LAS unsigned*)(lds + (bufoff) + ldsw + _i * 8192), 16, 0, 0); } while (0)
#define PG8_LDA(dst, b, h) do { _Pragma("unroll") for (int m = 0; m < 4; ++m) _Pragma("unroll") for (int k = 0; k < 2; ++k) dst[m][k] = *(const PG8_LAS bf16x8*)(lds + PG8_SA(b, h) + aoff + m * 2048 + k * 1024); } while (0)
#define PG8_LDB(dst, b, h) do { _Pragma("unroll") for (int n = 0; n < 2; ++n) _Pragma("unroll") for (int k = 0; k < 2; ++k) dst[n][k] = *(const PG8_LAS bf16x8*)(lds + PG8_SB(b, h) + boff + n * 2048 + k * 1024); } while (0)
#define PG8_MMA(ai, bj, At, Bt) do { __builtin_amdgcn_s_setprio(1); _Pragma("unroll") for (int m = 0; m < 4; ++m) _Pragma("unroll") for (int n = 0; n < 2; ++n) _Pragma("unroll") for (int k = 0; k < 2; ++k) \
        acc[ai][bj][m][n] = __builtin_amdgcn_mfma_f32_16x16x32_bf16(Bt[n][k], At[m][k], acc[ai][bj][m][n], 0, 0, 0); __builtin_amdgcn_s_setprio(0); } while (0)
#define PG8_WAIT_V(n) asm volatile("s_waitcnt vmcnt(" #n ")" ::: "memory")
#define PG8_WAIT_L(n) asm volatile("s_waitcnt lgkmcnt(" #n ")" ::: "memory")
#define PG8_BAR __builtin_amdgcn_s_barrier()
#define PG8_SCHED __builtin_amdgcn_sched_barrier(0)
    Unit cur, nxt; int ui = 0;
    if (!S.next(0, cur)) return;
    f32x4 acc[2][2][4][2];
#pragma unroll
    for (int a = 0; a < 2; ++a)
#pragma unroll
        for (int b = 0; b < 2; ++b)
#pragma unroll
            for (int m = 0; m < 4; ++m)
#pragma unroll
                for (int n = 0; n < 2; ++n) acc[a][b][m][n] = (f32x4){0.f, 0.f, 0.f, 0.f};
    bf16x8 At[4][2], B0[2][2], B1[2][2];
    const char* cA = (const char*)g.A + (size_t)cur.pm * tstep + (size_t)cur.kt0 * kstep; const char* cB = (const char*)g.Bt + (size_t)cur.pn * tstep + (size_t)cur.kt0 * kstep;
    S.a_ready(cur);
    PG8_STAGE(PG8_SB(0, 0), cB, voffB); PG8_STAGE(PG8_SA(0, 0), cA, voffA); PG8_STAGE(PG8_SB(0, 1), cB + hstep, voffB); PG8_STAGE(PG8_SA(0, 1), cA + hstep, voffA);
    if (wr == 1) PG8_BAR;
    PG8_WAIT_V(4); PG8_BAR;
    PG8_STAGE(PG8_SB(1, 0), cB + kstep, voffB); PG8_STAGE(PG8_SA(1, 0), cA + kstep, voffA); PG8_STAGE(PG8_SB(1, 1), cB + hstep + kstep, voffB);
    PG8_WAIT_V(6); PG8_BAR;
    PG8_STAMP();
    for (;;) {
        const bool has_next = S.next(ui + 1, nxt);
        const char* nA = has_next ? (const char*)g.A + (size_t)nxt.pm * tstep + (size_t)nxt.kt0 * kstep : cA; const char* nB = has_next ? (const char*)g.Bt + (size_t)nxt.pn * tstep + (size_t)nxt.kt0 * kstep : cB;
        const int nt = cur.nkt;
        for (int t = 0; t < nt; t += 2) {
            const bool last = (t == nt - 2);
            const char* a1 = cA + (size_t)(t + 1) * kstep;
            const char* a2 = last ? nA : cA + (size_t)(t + 2) * kstep; const char* b2 = last ? nB : cB + (size_t)(t + 2) * kstep;
            const char* a3 = a2 + kstep; const char* b3 = b2 + kstep;
            if (last && has_next) S.a_ready(nxt);
            PG8_LDB(B0, 0, 0); PG8_SCHED; PG8_LDA(At, 0, 0); PG8_STAGE(PG8_SA(1, 1), a1 + hstep, voffA);
            PG8_WAIT_L(8); PG8_BAR; PG8_WAIT_L(0); PG8_MMA(0, 0, At, B0); PG8_BAR; PG8_SCHED;
            PG8_LDB(B1, 0, 1); PG8_STAGE(PG8_SB(0, 0), b2, voffB);
            PG8_BAR; PG8_WAIT_L(0); PG8_MMA(0, 1, At, B1); PG8_BAR;
            PG8_LDA(At, 0, 1); PG8_STAGE(PG8_SA(0, 0), a2, voffA);
            PG8_BAR; PG8_WAIT_L(0); PG8_MMA(1, 0, At, B0); PG8_BAR; PG8_SCHED;
            PG8_STAGE(PG8_SB(0, 1), b2 + hstep, voffB);
            PG8_WAIT_V(6); PG8_BAR; PG8_MMA(1, 1, At, B1); PG8_BAR;
            PG8_LDB(B0, 1, 0); PG8_SCHED; PG8_LDA(At, 1, 0); PG8_STAGE(PG8_SA(0, 1), a2 + hstep, voffA);
            PG8_WAIT_L(8); PG8_BAR; PG8_WAIT_L(0); PG8_MMA(0, 0, At, B0); PG8_BAR; PG8_SCHED;
            PG8_LDB(B1, 1, 1); PG8_STAGE(PG8_SB(1, 0), b3, voffB);
            PG8_BAR; PG8_WAIT_L(0); PG8_MMA(0, 1, At, B1); PG8_BAR;
            PG8_LDA(At, 1, 1); PG8_STAGE(PG8_SA(1, 0), a3, voffA);
            PG8_BAR; PG8_WAIT_L(0); PG8_MMA(1, 0, At, B0); PG8_BAR; PG8_SCHED;
            PG8_STAGE(PG8_SB(1, 1), b3 + hstep, voffB);
            PG8_WAIT_V(6); PG8_BAR; PG8_MMA(1, 1, At, B1); PG8_BAR;
        }
        PG8_STAMP();
        if constexpr (!Epi::AFTER_DRAIN) { E(acc, cur, wr, wc, fr, fq); S.done(cur); }
        PG8_STAMP();
        if (!has_next) break;
#pragma unroll
        for (int a = 0; a < 2; ++a)
#pragma unroll
            for (int b = 0; b < 2; ++b)
#pragma unroll
                for (int m = 0; m < 4; ++m)
#pragma unroll
                    for (int n = 0; n < 2; ++n) acc[a][b][m][n] = (f32x4){0.f, 0.f, 0.f, 0.f};
        cur = nxt; cA = nA; cB = nB; ++ui;
    }
    PG8_WAIT_V(0);
    if (wr == 0) PG8_BAR;
    PG8_BAR;
    if constexpr (Epi::AFTER_DRAIN) { E.fused(acc, cur, wr, wc, fr, fq, lds, wid, lane); S.done(cur); }
    PG8_STAMP();
    if (STAMP && wid == 0) { stamps[lane] = lane < nts ? (((unsigned long long)(unsigned)ts_hi << 32) | (unsigned)ts_lo) : 0ull;
        if (lane == 62) stamps[62] = rt_entry; if (lane == 63) stamps[63] = (unsigned long long)wall_clock64(); }
#undef PG8_STAMP
#undef PG8_SA
#undef PG8_SB
#undef PG8_STAGE
#undef PG8_LDA
#undef PG8_LDB
#undef PG8_MMA
#undef PG8_WAIT_V
#undef PG8_WAIT_L
#undef PG8_BAR
#undef PG8_SCHED
}
}

__device__ __forceinline__ void phaseA_weights(const Params& p, float* tl  ) {
    const int tid = threadIdx.x;
    for (int tile = blockIdx.x; tile < 3328; tile += gridDim.x) {
        const float* src; bf16_t* dst; int ldn, K, lt;
        if (tile < 1024)      { src = p.w_in;   ldn = INW;  K = 1024; dst = (bf16_t*)(p.ws + W_WIN);  lt = tile; }
        else if (tile < 1280) { src = p.w_out;  ldn = 1024; K = 1024; dst = (bf16_t*)(p.ws + W_WOUT); lt = tile - 1024; }
        else if (tile < 2304) { src = p.w_up;   ldn = 4096; K = 1024; dst = (bf16_t*)(p.ws + W_WUP);  lt = tile - 1280; }
        else                  { src = p.w_down; ldn = 1024; K = 4096; dst = (bf16_t*)(p.ws + W_WDN);  lt = tile - 2304; }
        const int nkt = K >> 6, kt = lt % nkt, nt = lt / nkt;
#pragma unroll
        for (int i = 0; i < 2; ++i) {
            const int r = (tid >> 4) + 32 * i, c4 = (tid & 15) * 4;
            const float4 v = *(const float4*)(src + (size_t)(kt * 64 + r) * ldn + nt * 64 + c4);
            tl[r * 65 + c4 + 0] = v.x; tl[r * 65 + c4 + 1] = v.y; tl[r * 65 + c4 + 2] = v.z; tl[r * 65 + c4 + 3] = v.w;
        }
        __syncthreads();
        {
            const int n = tid >> 3, k8 = (tid & 7) * 8;
            float v[8];
#pragma unroll
            for (int j = 0; j < 8; ++j) v[j] = tl[(k8 + j) * 65 + n];
            u32x4 w; w.x = pk_bf16(v[0], v[1]); w.y = pk_bf16(v[2], v[3]); w.z = pk_bf16(v[4], v[5]); w.w = pk_bf16(v[6], v[7]);
            *(u32x4*)(dst + (size_t)(nt * 64 + n) * K + kt * 64 + k8) = w;
        }
        __syncthreads();
    }
}

__device__ __forceinline__ void phaseA_rope(const Params& p) {
    float2* tab = (float2*)(p.ws + W_ROPE);
    for (int idx = blockIdx.x * 512 + threadIdx.x; idx < 2056 * 64; idx += gridDim.x * 512) {
        const int pi = idx >> 6, f = idx & 63;
        double ivd = 1.0; for (int k = 0; k < f; ++k) ivd *= p.rope_r;
        const float ivf = (float)ivd;
        const float pos = pi < 2048 ? (float)pi : (float)(16384 + pi - 2048);
        const float ang = pos * ivf;
        const double a = (double)ang, q = rint(a * 0.63661977236758134308);
        double r = fma(-q, 1.57079632679489655800, a); r = fma(-q, 6.12323399573676603587e-17, r);
        const int qd = ((int)q) & 3;
        const double r2 = r * r;
        const double s = r * (1.0 + r2 * (-1.0 / 6.0 + r2 * (1.0 / 120.0 + r2 * (-1.0 / 5040.0 + r2 * (1.0 / 362880.0 + r2 * (-1.0 / 39916800.0 + r2 * (1.0 / 6227020800.0)))))));
        const double c = 1.0 + r2 * (-0.5 + r2 * (1.0 / 24.0 + r2 * (-1.0 / 720.0 + r2 * (1.0 / 40320.0 + r2 * (-1.0 / 3628800.0 + r2 * (1.0 / 479001600.0 + r2 * (-1.0 / 87178291200.0)))))));
        double co, si;
        if (qd == 0) { co = c; si = s; } else if (qd == 1) { co = -s; si = c; } else if (qd == 2) { co = -c; si = -s; } else { co = s; si = -c; }
        tab[idx] = make_float2((float)co, (float)si);
    }
}

__device__ __forceinline__ void phaseA_norm(const Params& p, float* wab  ) {
    const int tid = threadIdx.x, wave = tid >> 6, lane = tid & 63;
    for (int i = tid; i < 8192; i += 512) { const int k = i >> 3, j = i & 7; wab[j * 1024 + k] = p.w_in[(size_t)k * INW + 4096 + j]; }
    __syncthreads();
    bf16_t* hbuf = (bf16_t*)(p.ws + W_H); float* ab = (float*)(p.ws + W_AB);
    float4 wv[4];
#pragma unroll
    for (int i = 0; i < 4; ++i) wv[i] = *(const float4*)(p.pre_mix_w + lane * 4 + 256 * i);
    float bias = 0.f, alog = 0.f; if (lane < 4) { bias = p.dt_bias[lane]; alog = p.A_log[lane]; }
    const int stride = gridDim.x * 8;
    int row = blockIdx.x * 8 + wave;
    float4 v[4];
    if (row < TT) { const float* xr = row < TP ? p.x_prompt + (size_t)row * DM : p.x_sample + (size_t)(row - TP) * DM;
#pragma unroll
        for (int i = 0; i < 4; ++i) v[i] = *(const float4*)(xr + lane * 4 + 256 * i); }
    while (row < TT) {
        const int nrow = row + stride;
        float4 vn[4];
        if (nrow < TT) { const float* xr = nrow < TP ? p.x_prompt + (size_t)nrow * DM : p.x_sample + (size_t)(nrow - TP) * DM;
#pragma unroll
            for (int i = 0; i < 4; ++i) vn[i] = *(const float4*)(xr + lane * 4 + 256 * i); }
        float ss = 0.f;
#pragma unroll
        for (int i = 0; i < 4; ++i) ss += v[i].x * v[i].x + v[i].y * v[i].y + v[i].z * v[i].z + v[i].w * v[i].w;
        ss = wave_sum(ss);
        const float rs = rsqrtf(ss * (1.0f / 1024.0f) + 1e-6f);
        float acc[8];
#pragma unroll
        for (int j = 0; j < 8; ++j) acc[j] = 0.f;
#pragma unroll
        for (int i = 0; i < 4; ++i) {
            const float4 w = wv[i];
            const float h0 = v[i].x * rs * w.x, h1 = v[i].y * rs * w.y, h2 = v[i].z * rs * w.z, h3 = v[i].w * rs * w.w;
            u32x2 o; o.x = pk_bf16(h0, h1); o.y = pk_bf16(h2, h3);
            *(u32x2*)(hbuf + (size_t)row * DM + lane * 4 + 256 * i) = o;
#pragma unroll
            for (int j = 0; j < 8; ++j) { const float4 wj = *(const float4*)(wab + j * 1024 + lane * 4 + 256 * i); acc[j] += h0 * wj.x + h1 * wj.y + h2 * wj.z + h3 * wj.w; }
        }
#pragma unroll
        for (int j = 0; j < 8; ++j) acc[j] = wave_sum(acc[j]);
        if (lane < 8) {
            float a = acc[0];
#pragma unroll
            for (int j = 1; j < 8; ++j) a = (lane == j) ? acc[j] : a;
            float o;
            if (lane < 4) { const float xx = a + bias; const float sp = xx > 20.f ? xx : log1pf(expf(xx)); o = -expf(alog) * sp; }
            else o = 1.0f / (1.0f + expf(-a));
            ab[(size_t)row * 8 + lane] = o;
        }
#pragma unroll
        for (int i = 0; i < 4; ++i) v[i] = vn[i];
        row = nrow;
    }
}

DI void ld_row4(float4 (&v)[4], const float* rp, int lane) {
#pragma unroll
    for (int i = 0; i < 4; ++i) v[i] = *(const float4*)(rp + lane * 4 + 256 * i);
}
DI void add_row4(float4 (&v)[4], const float* rp, int lane) {
#pragma unroll
    for (int i = 0; i < 4; ++i) { const float4 t = *(const float4*)(rp + lane * 4 + 256 * i); v[i].x += t.x; v[i].y += t.y; v[i].z += t.z; v[i].w += t.w; }
}
DI float ssq4(const float4 (&v)[4]) { float s = 0.f;
#pragma unroll
    for (int i = 0; i < 4; ++i) s += v[i].x * v[i].x + v[i].y * v[i].y + v[i].z * v[i].z + v[i].w * v[i].w;
    return s; }
__device__ __forceinline__ void phaseE_rows(const Params& p) {
    const int tid = threadIdx.x, wave = tid >> 6, lane = tid & 63;
    const float* mbuf = (const float*)(p.ws + W_PROJ); bf16_t* hbuf = (bf16_t*)(p.ws + W_H); const float* part = (const float*)(p.ws + W_SMP);
    float4 w1[4], w2[4]; ld_row4(w1, p.post_mix_w, lane); ld_row4(w2, p.pre_mlp_w, lane);
    const int stride = gridDim.x * 8;
    int row = blockIdx.x * 8 + wave;
    float4 m[4], x[4];
    if (row < TT) { ld_row4(x, row < TP ? p.x_prompt + (size_t)row * DM : p.x_sample + (size_t)(row - TP) * DM, lane);
        if (row < TP) ld_row4(m, mbuf + (size_t)row * DM, lane); else { ld_row4(m, part + (size_t)(row - TP) * DM, lane); add_row4(m, part + 1048576 + (size_t)(row - TP) * DM, lane); } }
    while (row < TT) {
        const int nrow = row + stride;
        float4 mn[4], xn[4];
        if (nrow < TT) { ld_row4(xn, nrow < TP ? p.x_prompt + (size_t)nrow * DM : p.x_sample + (size_t)(nrow - TP) * DM, lane);
            if (nrow < TP) ld_row4(mn, mbuf + (size_t)nrow * DM, lane); else { ld_row4(mn, part + (size_t)(nrow - TP) * DM, lane); add_row4(mn, part + 1048576 + (size_t)(nrow - TP) * DM, lane); } }
        const float rs = rsqrtf(wave_sum(ssq4(m)) * (1.0f / 1024.0f) + 1e-6f);
        float* yr = p.out + (size_t)row * DM;
#pragma unroll
        for (int i = 0; i < 4; ++i) { x[i].x += m[i].x * rs * w1[i].x; x[i].y += m[i].y * rs * w1[i].y; x[i].z += m[i].z * rs * w1[i].z; x[i].w += m[i].w * rs * w1[i].w;
            *(float4*)(yr + lane * 4 + 256 * i) = x[i]; }
        const float rs2 = rsqrtf(wave_sum(ssq4(x)) * (1.0f / 1024.0f) + 1e-6f);
#pragma unroll
        for (int i = 0; i < 4; ++i) { u32x2 o; o.x = pk_bf16(x[i].x * rs2 * w2[i].x, x[i].y * rs2 * w2[i].y); o.y = pk_bf16(x[i].z * rs2 * w2[i].z, x[i].w * rs2 * w2[i].w);
            *(u32x2*)(hbuf + (size_t)row * DM + lane * 4 + 256 * i) = o; }
#pragma unroll
        for (int i = 0; i < 4; ++i) { m[i] = mn[i]; x[i] = xn[i]; }
        row = nrow;
    }
}
__device__ __forceinline__ void phaseH_rows(const Params& p) {
    const int tid = threadIdx.x, wave = tid >> 6, lane = tid & 63;
    const float* fbuf = (const float*)(p.ws + W_H); const float* part = (const float*)(p.ws + W_SMP);
    float4 w1[4]; ld_row4(w1, p.post_mlp_w, lane);
    const int stride = gridDim.x * 8;
    int row = blockIdx.x * 8 + wave;
    float4 f[4], x[4];
    auto ldf = [&](float4 (&d)[4], int r) { if (r < TP) ld_row4(d, fbuf + (size_t)r * DM, lane); else { const float* q = part + (size_t)(r - TP) * DM; ld_row4(d, q, lane); add_row4(d, q + 1048576, lane); add_row4(d, q + 2 * 1048576, lane); add_row4(d, q + 3 * 1048576, lane); } };
    if (row < TT) { ld_row4(x, p.out + (size_t)row * DM, lane); ldf(f, row); }
    while (row < TT) {
        const int nrow = row + stride;
        float4 fn[4], xn[4];
        if (nrow < TT) { ld_row4(xn, p.out + (size_t)nrow * DM, lane); ldf(fn, nrow); }
        const float rs = rsqrtf(wave_sum(ssq4(f)) * (1.0f / 1024.0f) + 1e-6f);
        float* yr = p.out + (size_t)row * DM;
#pragma unroll
        for (int i = 0; i < 4; ++i) { x[i].x += f[i].x * rs * w1[i].x; x[i].y += f[i].y * rs * w1[i].y; x[i].z += f[i].z * rs * w1[i].z; x[i].w += f[i].w * rs * w1[i].w;
            *(float4*)(yr + lane * 4 + 256 * i) = x[i]; }
#pragma unroll
        for (int i = 0; i < 4; ++i) { f[i] = fn[i]; x[i] = xn[i]; }
        row = nrow;
    }
}

__device__ __forceinline__ void phaseC1_gdn_prep(const Params& p, unsigned char* lds, int first, int step) {
    const int tid = threadIdx.x, w = tid >> 6, lane = tid & 63, r = lane & 31, hh = lane >> 5;
    float* qc = (float*)lds; float* kc = qc + 64 * 129; float* vc = kc + 64 * 129;
    unsigned char* knb = lds + 99072; unsigned char* qnb = lds + 116480;
    float* Amat = (float*)(lds + 133888); float* cum = (float*)(lds + 150528); float* beta = cum + 64; float* rnq = cum + 128; float* rnk = cum + 192; float* fack = cum + 256;
    bf16_t* stg = (bf16_t*)(lds + 99072);
    const bf16_t* proj = (const bf16_t*)(p.ws + W_PROJ); const float* ab = (const float*)(p.ws + W_AB);
    for (int item = first; item < 1536; item += step) {
        const bool sample = item >= 1024;
        int b, n, h, row0, nrows, slot;
        if (!sample) { b = item >> 7; n = (item >> 2) & 31; h = item & 3; row0 = b * 2048 + n * 64; nrows = 64; slot = (b * 4 + h) * 32 + n; }
        else { const int s = item - 1024; b = s >> 2; n = 0; h = s & 3; row0 = TP + b * 8; nrows = 8; slot = s; }
        unsigned char* sbase = sample ? (unsigned char*)(p.out + O_GS) + (size_t)slot * 65536 : (unsigned char*)(p.out + O_YP) + (size_t)slot * 65536;
        bf16_t* sc_out = (bf16_t*)(p.ws + (sample ? W_SCS : W_SCP)) + (size_t)slot * 4096;
        float* dec_out = (float*)(p.ws + W_DEC) + (sample ? 1024 + slot : slot);
        {
            const int nld = nrows * 48;
            for (int idx = tid; idx < nld; idx += 512) {
                const int row = idx / 48, rem = idx - row * 48, seg = rem >> 4, pc = rem & 15;
                *(u32x4*)(stg + row * 384 + seg * 128 + pc * 8) = *(const u32x4*)(proj + (size_t)(row0 + row) * NPJ + 2048 + seg * 512 + h * 128 + pc * 8);
            }
        }
        __syncthreads();
        if (tid < 384) {
            const int seg = tid >> 7, d = tid & 127, ch = seg * 512 + h * 128 + d;
            const float c0 = p.conv_w[ch], c1 = p.conv_w[1536 + ch], c2 = p.conv_w[3072 + ch], c3 = p.conv_w[4608 + ch];
            const bf16_t* src = proj + (size_t)row0 * NPJ + 2048 + ch;
            float xm3 = 0.f, xm2 = 0.f, xm1 = 0.f;
            if (sample) { const float* sc = p.state_conv + (size_t)b * 3 * 1536 + ch; xm3 = sc[0]; xm2 = sc[1536]; xm1 = sc[3072]; }
            else if (n > 0) { xm3 = bf2f(*(src - 3 * NPJ)); xm2 = bf2f(*(src - 2 * NPJ)); xm1 = bf2f(*(src - NPJ)); }
            float* dst = qc + seg * (64 * 129) + d;
#pragma unroll 8
            for (int i = 0; i < nrows; ++i) {
                const float x = bf2f(stg[i * 384 + tid]);
                float cv = c0 * xm3; cv += c1 * xm2; cv += c2 * xm1; cv += c3 * x;
                dst[i * 129] = silu(cv);
                xm3 = xm2; xm2 = xm1; xm1 = x;
            }
            for (int i = nrows; i < 64; ++i) dst[i * 129] = 0.f;
            if (sample) { float* co = p.out + O_CS + (size_t)b * 3 * 1536 + ch; co[0] = xm3; co[1536] = xm2; co[3072] = xm1; }
            else if (n == 31) { float* co = p.out + O_CP + (size_t)b * 3 * 1536 + ch; co[0] = xm3; co[1536] = xm2; co[3072] = xm1; }
        } else if (tid < 448) {
            const int i = tid - 384;
            float g = 0.f, be = 0.f;
            if (i < nrows) { g = ab[(size_t)(row0 + i) * 8 + h]; be = ab[(size_t)(row0 + i) * 8 + 4 + h]; }
#pragma unroll
            for (int o = 1; o < 64; o <<= 1) { const float t = __shfl_up(g, o); if (i >= o) g += t; }
            cum[i] = g; beta[i] = be;
        }
        __syncthreads();
        if (tid < 128) {
            const int which = tid >> 6, row = tid & 63; const float* bp = (which ? kc : qc) + row * 129;
            float ss = 0.f;
#pragma unroll 16
            for (int d = 0; d < 128; ++d) ss += bp[d] * bp[d];
            float rn = rsqrtf(ss + 1e-6f);
            if (!which) rnq[row] = rn * 0.08838834764831845f; else { rnk[row] = rn; fack[row] = rn * beta[row] * __expf(cum[row]); }
        }
        __syncthreads();
#pragma unroll
        for (int it = 0; it < 4; ++it) {
            const int idx = tid + 512 * it, img = idx >> 10, rem = idx & 1023, row = rem >> 4, chunk = rem & 15;
            const float* sp = (img ? kc : qc) + row * 129 + chunk * 8; const float rn = img ? rnk[row] : rnq[row];
            u32x4 o; o.x = pk_bf16(sp[0] * rn, sp[1] * rn); o.y = pk_bf16(sp[2] * rn, sp[3] * rn); o.z = pk_bf16(sp[4] * rn, sp[5] * rn); o.w = pk_bf16(sp[6] * rn, sp[7] * rn);
            *(u32x4*)((img ? knb : qnb) + sw256(row, chunk)) = o;
        }
        __syncthreads();
        {
            const int isq = w >> 2, it_ = (w >> 1) & 1, jt = w & 1;
            f32x16 acc;
#pragma unroll
            for (int i = 0; i < 16; ++i) acc[i] = 0.f;
            const unsigned char* ai = isq ? qnb : knb;
#pragma unroll
            for (int s = 0; s < 8; ++s) {
                const bf16x8 a = *(const bf16x8*)(ai + sw256(it_ * 32 + r, 2 * s + hh));
                const bf16x8 bb = *(const bf16x8*)(knb + sw256(jt * 32 + r, 2 * s + hh));
                acc = MFMA32(a, bb, acc);
            }
            const int j = jt * 32 + r; const float cj = cum[j];
#pragma unroll
            for (int reg = 0; reg < 16; ++reg) {
                const int i = it_ * 32 + crow(reg, hh);
                const float dm = __expf(fminf(cum[i] - cj, 0.f)), dm2 = __expf(fminf(cj - cum[i], 0.f));
                if (!isq) Amat[i * 64 + j] = (i < j) ? beta[j] * acc[reg] * dm2 : 0.f;
                else sc_out[i * 64 + j] = f2bf((j <= i) ? acc[reg] * dm : 0.f);
            }
        }
        __syncthreads();
        {
#pragma unroll
            for (int it = 0; it < 2; ++it) {
                const int idx = tid + 512 * it, row = idx >> 4, chunk = idx & 15;
                const float e = __expf(cum[row]) * rnq[row]; const float* sp = qc + row * 129 + chunk * 8;
                u32x4 o; o.x = pk_bf16(sp[0] * e, sp[1] * e); o.y = pk_bf16(sp[2] * e, sp[3] * e); o.z = pk_bf16(sp[4] * e, sp[5] * e); o.w = pk_bf16(sp[6] * e, sp[7] * e);
                *(u32x4*)(sbase + 16384 + row * 256 + chunk * 16) = o;
            }
            const int d = tid & 127, cq = tid >> 7; const float cl = cum[63];
            u32x4* o = (u32x4*)(sbase + 49152 + (size_t)d * 128 + cq * 32);
#pragma unroll
            for (int c8 = 0; c8 < 2; ++c8) {
                float v[8];
#pragma unroll
                for (int j = 0; j < 8; ++j) { const int c = cq * 16 + c8 * 8 + j; v[j] = kc[c * 129 + d] * rnk[c] * __expf(cl - cum[c]); }
                u32x4 q; q.x = pk_bf16(v[0], v[1]); q.y = pk_bf16(v[2], v[3]); q.z = pk_bf16(v[4], v[5]); q.w = pk_bf16(v[6], v[7]); o[c8] = q;
            }
            if (tid == 0) *dec_out = __expf(cl);
        }
        __syncthreads();
        if (tid < 256) {
            int vz; asm volatile("v_mov_b32 %0, 0" : "=v"(vz));
            const float* At = Amat + vz;
            float* colp = (tid < 128) ? (kc + tid) : (vc + tid - 128);
            const float* facp = ((tid < 128) ? fack : beta) + vz;
            const int nblk = nrows == 64 ? 4 : 1;
            for (int bi = 0; bi < nblk; ++bi) {
                const int R0 = bi * 16;
                float acc[16];
#pragma unroll
                for (int ii = 0; ii < 16; ++ii) acc[ii] = colp[(R0 + ii) * 129] * facp[R0 + ii];
#pragma unroll 4
                for (int j = 0; j < R0; ++j) {
                    const float xj = colp[j * 129];
                    const f32x4 a0 = *(const f32x4*)(At + j * 64 + R0), a1 = *(const f32x4*)(At + j * 64 + R0 + 4), a2 = *(const f32x4*)(At + j * 64 + R0 + 8), a3 = *(const f32x4*)(At + j * 64 + R0 + 12);
#pragma unroll
                    for (int q = 0; q < 4; ++q) { acc[q] -= a0[q] * xj; acc[4 + q] -= a1[q] * xj; acc[8 + q] -= a2[q] * xj; acc[12 + q] -= a3[q] * xj; }
                }
#pragma unroll
                for (int jj = 0; jj < 15; ++jj) {
                    const float* ar = At + (R0 + jj) * 64 + R0;
#pragma unroll
                    for (int ii = jj + 1; ii < 16; ++ii) acc[ii] -= ar[ii] * acc[jj];
                }
#pragma unroll
                for (int ii = 0; ii < 16; ++ii) colp[(R0 + ii) * 129] = acc[ii];
            }
            if (tid < 128) {
                bf16_t* o = (bf16_t*)sbase + tid;
#pragma unroll 8
                for (int i = 0; i < 64; ++i) o[i * 128] = f2bf(-colp[i * 129]);
            } else {
                u32x4* o = (u32x4*)(sbase + 32768 + (size_t)(tid - 128) * 128);
#pragma unroll
                for (int c8 = 0; c8 < 8; ++c8) { float x[8];
#pragma unroll
                    for (int j = 0; j < 8; ++j) x[j] = colp[(c8 * 8 + j) * 129];
                    u32x4 v; v.x = pk_bf16(x[0], x[1]); v.y = pk_bf16(x[2], x[3]); v.z = pk_bf16(x[4], x[5]); v.w = pk_bf16(x[6], x[7]); o[c8] = v; }
            }
        }
        __syncthreads();
    }
}

template <bool GDN> __device__ __forceinline__ void scan_item(const Params& p, unsigned char* lds, int b, int h, bool sample) {
    const int tid = threadIdx.x, w = tid >> 6, lane = tid & 63, r = lane & 31, hh = lane >> 5;
    const int ct = w >> 2, et = w & 3;
    unsigned char* St = lds; unsigned char* INA = lds + 34816; unsigned char* INQ = lds + 52224; unsigned char* INKT = lds + 69632;
    unsigned char* INSC = lds + 88064; unsigned char* VNT = lds + 97280; float* SSQ = (float*)(lds + 115712);
    const int nchunks = sample ? 1 : 32, nrows = sample ? 8 : 64;
    const int row_base = sample ? TP + b * 8 : b * 2048;
    const bf16_t* proj = (const bf16_t*)(p.ws + W_PROJ);
    bf16_t* mix = (bf16_t*)(p.ws + W_MIX);
    const float* nw = GDN ? p.gdn_norm_w : p.ret_norm_w;
    const int gate_col = GDN ? 3584 + h * 128 : 1536 + h * 128;
    const int mix_col = (GDN ? 512 : 0) + h * 128;
    const float2* rtab = (const float2*)(p.ws + W_ROPE);
    const float lg2 = log2f(1.0f - exp2f(-5.0f - (float)h));
    f32x16 S0, S1;
    const int e_col = et * 32 + r;
    if (sample) {
        const float* s0 = (GDN ? p.state_gdn : p.state_ret) + (size_t)(b * 4 + h) * 16384 + ((2 * ct) * 32 + 4 * hh) * 128 + e_col;
#pragma unroll
        for (int reg = 0; reg < 16; ++reg) { S0[reg] = s0[((reg & 3) + 8 * (reg >> 2)) * 128]; S1[reg] = s0[((reg & 3) + 8 * (reg >> 2) + 32) * 128]; }
    } else {
#pragma unroll
        for (int reg = 0; reg < 16; ++reg) { S0[reg] = 0.f; S1[reg] = 0.f; }
    }
    auto write_St = [&]() {
#pragma unroll
        for (int g = 0; g < 4; ++g) {
            u32x2 v0, v1; v0.x = pk_bf16(S0[4 * g], S0[4 * g + 1]); v0.y = pk_bf16(S0[4 * g + 2], S0[4 * g + 3]); v1.x = pk_bf16(S1[4 * g], S1[4 * g + 1]); v1.y = pk_bf16(S1[4 * g + 2], S1[4 * g + 3]);
            *(u32x2*)(St + sw256(e_col, (2 * ct) * 4 + g) + 8 * hh) = v0;
            *(u32x2*)(St + sw256(e_col, (2 * ct + 1) * 4 + g) + 8 * hh) = v1;
        }
    };
    write_St();
    float* NW = (float*)(lds + 116736);
    if (tid < 128) NW[tid] = nw[tid];
    u32x4 ra[2], rq[2], rk[2], rs4;
    u32x2 ru[4];
    f32x4 rt[4];
    float decay = 1.f;
    const unsigned char* gbase = nullptr; const bf16_t* gsc = nullptr; const float* gdec = nullptr;
    if (GDN) {
        const int slot0 = sample ? (b * 4 + h) : (b * 4 + h) * 32;
        gbase = sample ? (const unsigned char*)(p.out + O_GS) + (size_t)slot0 * 65536 : (const unsigned char*)(p.out + O_YP) + (size_t)slot0 * 65536;
        gsc = (const bf16_t*)(p.ws + (sample ? W_SCS : W_SCP)) + (size_t)slot0 * 4096;
        gdec = (const float*)(p.ws + W_DEC) + (sample ? 1024 + slot0 : slot0);
    }
    const int c_tok = ct * 32 + r;
    auto prefetch = [&](int n) {
        const size_t trow = (size_t)row_base + n * 64;
        if (GDN) {
            const unsigned char* sb = gbase + (size_t)n * 65536;
#pragma unroll
            for (int i = 0; i < 2; ++i) { const int idx = tid + 512 * i; ra[i] = *(const u32x4*)(sb + idx * 16); rq[i] = *(const u32x4*)(sb + 16384 + idx * 16); rk[i] = *(const u32x4*)(sb + 49152 + idx * 16); }
            rs4 = *(const u32x4*)((const unsigned char*)(gsc + (size_t)n * 4096) + tid * 16);
#pragma unroll
            for (int g = 0; g < 4; ++g) ru[g] = *(const u32x2*)(sb + 32768 + (e_col * 64 + ct * 32 + 8 * g + 4 * hh) * 2);
            decay = gdec[n];
        } else {
            const int c = tid >> 3, cp = tid & 7;
            if (c < nrows) {
                const bf16_t* qr = proj + (trow + c) * NPJ + h * 128 + cp * 8;
                ra[0] = *(const u32x4*)qr; ra[1] = *(const u32x4*)(qr + 64);
                rq[0] = *(const u32x4*)(qr + 512); rq[1] = *(const u32x4*)(qr + 512 + 64);
                const int pidx = sample ? 2048 + c : n * 64 + c;
                const f32x4* tp = (const f32x4*)(rtab + (size_t)pidx * 64 + cp * 8);
                rt[0] = tp[0]; rt[1] = tp[1]; rt[2] = tp[2]; rt[3] = tp[3];
            }
#pragma unroll
            for (int i = 0; i < 2; ++i) { const int idx = tid + 512 * i, row = idx >> 4, chunk = idx & 15;
                if (row < nrows) rk[i] = *(const u32x4*)(proj + (trow + row) * NPJ + 1024 + h * 128 + chunk * 8); }
        }
    };
    prefetch(0);
    for (int n = 0; n < nchunks; ++n) {
        u32x2 gate[4];
        f32x16 acc1;
        if (GDN) {
#pragma unroll
            for (int i = 0; i < 2; ++i) { const int idx = tid + 512 * i;
                *(u32x4*)(INA + sw256(idx >> 4, idx & 15)) = ra[i]; *(u32x4*)(INQ + sw256(idx >> 4, idx & 15)) = rq[i]; *(u32x4*)(INKT + sw128x(idx >> 3, idx & 7)) = rk[i]; }
            *(u32x4*)(INSC + sw128(tid >> 3, tid & 7)) = rs4;
#pragma unroll
            for (int g = 0; g < 4; ++g) { acc1[4 * g] = bflo(ru[g].x); acc1[4 * g + 1] = bfhi(ru[g].x); acc1[4 * g + 2] = bflo(ru[g].y); acc1[4 * g + 3] = bfhi(ru[g].y); }
        } else {
            const int c = tid >> 3, cp = tid & 7;
            u32x4 q1 = {0u, 0u, 0u, 0u}, q2 = q1, k1 = q1, k2 = q1;
            unsigned short kt1[8], kt2[8];
#pragma unroll
            for (int j = 0; j < 8; ++j) { kt1[j] = 0; kt2[j] = 0; }
            if (c < nrows) {
                const float fq = exp2f((float)(c + 1) * lg2), fk = 0.08838834764831845f * exp2f((float)(nrows - 1 - c) * lg2);
                float oq1[8], oq2[8], ok1[8], ok2[8];
#pragma unroll
                for (int j = 0; j < 8; ++j) {
                    const unsigned qa = ra[0][j >> 1], qb = ra[1][j >> 1], ka = rq[0][j >> 1], kb = rq[1][j >> 1];
                    const float x1 = (j & 1) ? bfhi(qa) : bflo(qa), x2 = (j & 1) ? bfhi(qb) : bflo(qb);
                    const float y1 = (j & 1) ? bfhi(ka) : bflo(ka), y2 = (j & 1) ? bfhi(kb) : bflo(kb);
                    const float co = rt[j >> 1][(j & 1) * 2], si = rt[j >> 1][(j & 1) * 2 + 1];
                    oq1[j] = (x1 * co - x2 * si) * fq; oq2[j] = (x1 * si + x2 * co) * fq;
                    ok1[j] = (y1 * co - y2 * si) * fk; ok2[j] = (y1 * si + y2 * co) * fk;
                }
#pragma unroll
                for (int j = 0; j < 4; ++j) { q1[j] = pk_bf16(oq1[2 * j], oq1[2 * j + 1]); q2[j] = pk_bf16(oq2[2 * j], oq2[2 * j + 1]); k1[j] = pk_bf16(ok1[2 * j], ok1[2 * j + 1]); k2[j] = pk_bf16(ok2[2 * j], ok2[2 * j + 1]); }
#pragma unroll
                for (int j = 0; j < 8; ++j) { kt1[j] = (unsigned short)((j & 1) ? (k1[j >> 1] >> 16) : (k1[j >> 1] & 0xffffu)); kt2[j] = (unsigned short)((j & 1) ? (k2[j >> 1] >> 16) : (k2[j >> 1] & 0xffffu)); }
            }
            *(u32x4*)(INQ + sw256(c, cp)) = q1; *(u32x4*)(INQ + sw256(c, cp + 8)) = q2;
            *(u32x4*)(INA + sw256(c, cp)) = k1; *(u32x4*)(INA + sw256(c, cp + 8)) = k2;
#pragma unroll
            for (int j = 0; j < 8; ++j) {
                const int d1 = cp * 8 + j, d2 = d1 + 64;
                *(unsigned short*)(INKT + sw128x(d1, c >> 3) + (c & 7) * 2) = kt1[j];
                *(unsigned short*)(INKT + sw128x(d2, c >> 3) + (c & 7) * 2) = kt2[j];
            }
#pragma unroll
            for (int i = 0; i < 2; ++i) { const int idx = tid + 512 * i, row = idx >> 4, chunk = idx & 15;
                const u32x4 vv = (row < nrows) ? rk[i] : (u32x4){0u, 0u, 0u, 0u};
#pragma unroll
                for (int j = 0; j < 8; ++j) { const int e = chunk * 8 + j;
                    *(unsigned short*)(VNT + sw128x(e, row >> 3) + (row & 7) * 2) = (unsigned short)((j & 1) ? (vv[j >> 1] >> 16) : (vv[j >> 1] & 0xffffu)); } }
            decay = exp2f((float)nrows * lg2);
        }
        const float dec_n = decay;
        __syncthreads();
        if (c_tok < nrows) {
#pragma unroll
            for (int g = 0; g < 4; ++g) gate[g] = *(const u32x2*)(proj + ((size_t)row_base + n * 64 + c_tok) * NPJ + gate_col + et * 32 + 8 * g + 4 * hh);
        }
        if (n + 1 < nchunks) prefetch(n + 1);
        if (GDN) {
#pragma unroll
            for (int s = 0; s < 8; ++s) {
                const bf16x8 a = *(const bf16x8*)(INA + sw256(ct * 32 + r, 2 * s + hh));
                const bf16x8 bb = *(const bf16x8*)(St + sw256(et * 32 + r, 2 * s + hh));
                acc1 = MFMA32(a, bb, acc1);
            }
#pragma unroll
            for (int g = 0; g < 4; ++g) { u32x2 v; v.x = pk_bf16(acc1[4 * g], acc1[4 * g + 1]); v.y = pk_bf16(acc1[4 * g + 2], acc1[4 * g + 3]);
                *(u32x2*)(VNT + sw128x(e_col, ct * 4 + g) + 8 * hh) = v; }
        } else {
            if (w < 4) {
                const int it_ = w >> 1, jt = w & 1;
#pragma unroll
                for (int i = 0; i < 16; ++i) acc1[i] = 0.f;
#pragma unroll
                for (int s = 0; s < 8; ++s) {
                    const bf16x8 a = *(const bf16x8*)(INQ + sw256(it_ * 32 + r, 2 * s + hh));
                    const bf16x8 bb = *(const bf16x8*)(INA + sw256(jt * 32 + r, 2 * s + hh));
                    acc1 = MFMA32(a, bb, acc1);
                }
                const float sc = exp2f(-(float)nrows * lg2); const int j = jt * 32 + r;
#pragma unroll
                for (int reg = 0; reg < 16; ++reg) { const int i = it_ * 32 + crow(reg, hh);
                    *(unsigned short*)(INSC + sw128(i, j >> 3) + (j & 7) * 2) = f2bf((j <= i) ? acc1[reg] * sc : 0.f); }
            }
        }
        __syncthreads();
        f32x16 acc2;
#pragma unroll
        for (int i = 0; i < 16; ++i) acc2[i] = 0.f;
#pragma unroll
        for (int s = 0; s < 8; ++s) {
            const bf16x8 a = *(const bf16x8*)(St + sw256(et * 32 + r, 2 * s + hh));
            const bf16x8 bb = *(const bf16x8*)(INQ + sw256(ct * 32 + r, 2 * s + hh));
            acc2 = MFMA32(a, bb, acc2);
        }
#pragma unroll
        for (int s = 0; s < 4; ++s) {
            const bf16x8 a = *(const bf16x8*)(VNT + sw128x(et * 32 + r, 2 * s + hh));
            const bf16x8 bb = *(const bf16x8*)(INSC + sw128(ct * 32 + r, 2 * s + hh));
            acc2 = MFMA32(a, bb, acc2);
        }
        {
            float sq = 0.f;
#pragma unroll
            for (int i = 0; i < 16; ++i) sq += acc2[i] * acc2[i];
            sq += __shfl_xor(sq, 32);
            if (hh == 0) SSQ[et * 64 + c_tok] = sq;
        }
#pragma unroll
        for (int i = 0; i < 16; ++i) { S0[i] *= dec_n; S1[i] *= dec_n; }
#pragma unroll
        for (int s = 0; s < 4; ++s) {
            const bf16x8 bb = *(const bf16x8*)(VNT + sw128x(et * 32 + r, 2 * s + hh));
            const bf16x8 a0 = *(const bf16x8*)(INKT + sw128x((2 * ct) * 32 + r, 2 * s + hh));
            const bf16x8 a1 = *(const bf16x8*)(INKT + sw128x((2 * ct + 1) * 32 + r, 2 * s + hh));
            S0 = MFMA32(a0, bb, S0); S1 = MFMA32(a1, bb, S1);
        }
        __syncthreads();
        write_St();
        if (c_tok < nrows) {
            const float ss = SSQ[c_tok] + SSQ[64 + c_tok] + SSQ[128 + c_tok] + SSQ[192 + c_tok];
            const float rn = rsqrtf(ss * (1.0f / 128.0f) + 1e-6f);
            bf16_t* orow = mix + ((size_t)row_base + n * 64 + c_tok) * DM + mix_col + et * 32;
#pragma unroll
            for (int g = 0; g < 4; ++g) {
                const int e0 = 8 * g + 4 * hh;
                const f32x4 wv = *(const f32x4*)(NW + et * 32 + e0);
                const float o0 = acc2[4 * g] * rn * wv[0] * silu(bflo(gate[g].x)), o1 = acc2[4 * g + 1] * rn * wv[1] * silu(bfhi(gate[g].x));
                const float o2 = acc2[4 * g + 2] * rn * wv[2] * silu(bflo(gate[g].y)), o3 = acc2[4 * g + 3] * rn * wv[3] * silu(bfhi(gate[g].y));
                u32x2 v; v.x = pk_bf16(o0, o1); v.y = pk_bf16(o2, o3);
                *(u32x2*)(orow + e0) = v;
            }
        }
    }
    {
        float* so = p.out + (sample ? (GDN ? O_GS : O_RS) : (GDN ? O_GP : O_RP)) + (size_t)(b * 4 + h) * 16384 + ((2 * ct) * 32 + 4 * hh) * 128 + e_col;
#pragma unroll
        for (int reg = 0; reg < 16; ++reg) { so[((reg & 3) + 8 * (reg >> 2)) * 128] = S0[reg]; so[((reg & 3) + 8 * (reg >> 2) + 32) * 128] = S1[reg]; }
    }
    __syncthreads();
}

__device__ __forceinline__ void phaseX(const Params& p, unsigned char* lds) {
    const int G = gridDim.x, bid = blockIdx.x;
    if (G > 64) {
        if (bid < 32) scan_item<false>(p, lds, bid >> 2, bid & 3, false);
        else phaseC1_gdn_prep(p, lds, bid - 32, G - 32);
    } else {
        for (int s = bid; s < 32; s += G) scan_item<false>(p, lds, s >> 2, s & 3, false);
        phaseC1_gdn_prep(p, lds, bid, G);
    }
}
__device__ __forceinline__ void phaseY(const Params& p, unsigned char* lds) {
    const int G = gridDim.x, bid = blockIdx.x;
    int start = bid, limit = 32 + 1024, stride = G;
    if (G > 64) { if (bid < 32) { limit = 32; stride = 32; } else { stride = G - 32; } }
    for (int s = start; s < limit; s += stride) {
        if (s < 32) scan_item<true>(p, lds, s >> 2, s & 3, false);
        else { const int t = s - 32, bh = t >> 1, b = bh >> 2, h = bh & 3; if (t & 1) scan_item<true>(p, lds, b, h, true); else scan_item<false>(p, lds, b, h, true); }
    }
}

#ifndef PROBE_S
#define PROBE_S 0
#endif
#ifndef DUMP_PROJ
#define DUMP_PROJ 0
#define DUMP_OFF W_PROJ
#define DUMP_BYTES 142606336ull
#endif
#ifndef DUP_C1
#define DUP_C1 0
#endif
#ifndef DUP_C12
#define DUP_C12 0
#endif
#ifndef SANITIZE
#define SANITIZE 0
#endif
#ifndef PHASE_MASK
#define PHASE_MASK 511
#endif
__global__ void __launch_bounds__(512, 2) fwd_megakernel(Params p) {
    extern __shared__ __attribute__((aligned(16))) unsigned char shm[];
    cg::grid_group grid = cg::this_grid();
    const bool multi = (p.phase_hi - p.phase_lo) > 1;
#define RUN(ph) (p.phase_lo <= (ph) && (ph) < p.phase_hi && (PHASE_MASK & (1 << (ph))))
#define SEAM(ph) do { if (multi && p.phase_lo <= (ph) && (ph) + 1 < p.phase_hi) { __syncthreads(); grid.sync(); } } while (0)
    if (RUN(0)) { phaseA_weights(p, (float*)shm); phaseA_norm(p, (float*)shm); phaseA_rope(p); }
    SEAM(0);
    if (RUN(1)) {
        pg8::Gemm g; g.A = (const bf16_t*)(p.ws + W_H); g.Bt = (const bf16_t*)(p.ws + W_WIN); g.M = TT; g.N = NPJ; g.K = DM;
        pg8::SplitOrder S; S.init(g.N, g.K, 1, (int)gridDim.x, (int)blockIdx.x);
        pg8::EpiBf16<0> E; E.O = (bf16_t*)(p.ws + W_PROJ); E.ldc = NPJ;
        pg8::gemm_phase<pg8::EpiBf16<0>, pg8::SplitOrder, false>((PG8_LAS unsigned char*)shm, g, S, E, nullptr);
    }
    SEAM(1);
    if (RUN(2)) phaseX(p, shm);
    SEAM(2);
    if (RUN(3)) phaseY(p, shm);
    SEAM(3);
#if PROBE_S
    if (RUN(3)) { for (int t = blockIdx.x; t < 512; t += gridDim.x) scan_item<false>(p, shm, t >> 2, t & 3, true); }
    SEAM(3);
#endif
    if (RUN(4)) {
        pg8::Gemm g; g.A = (const bf16_t*)(p.ws + W_MIX); g.Bt = (const bf16_t*)(p.ws + W_WOUT); g.M = TT; g.N = DM; g.K = DM;
        pg8::SplitOrder S; S.init(g.N, g.K, 2, (int)gridDim.x, (int)blockIdx.x);
        pg8::EpiF32 E; E.C = (float*)(p.ws + W_PROJ); E.Csmp = (float*)(p.ws + W_SMP) - (size_t)TP * DM; E.ldc = DM;
        pg8::gemm_phase<pg8::EpiF32, pg8::SplitOrder, false>((PG8_LAS unsigned char*)shm, g, S, E, nullptr);
    }
    SEAM(4);
    if (RUN(5)) phaseE_rows(p);
    SEAM(5);
    if (RUN(6)) {
        pg8::Gemm g; g.A = (const bf16_t*)(p.ws + W_H); g.Bt = (const bf16_t*)(p.ws + W_WUP); g.M = TT; g.N = DFF; g.K = DM;
        pg8::SplitOrder S; S.init(g.N, g.K, 1, (int)gridDim.x, (int)blockIdx.x);
        pg8::EpiBf16<1> E; E.O = (bf16_t*)(p.ws + W_PROJ); E.ldc = DFF;
        pg8::gemm_phase<pg8::EpiBf16<1>, pg8::SplitOrder, false>((PG8_LAS unsigned char*)shm, g, S, E, nullptr);
    }
    SEAM(6);
    if (RUN(7)) {
        pg8::Gemm g; g.A = (const bf16_t*)(p.ws + W_PROJ); g.Bt = (const bf16_t*)(p.ws + W_WDN); g.M = TT; g.N = DM; g.K = DFF;
        pg8::SplitOrder S; S.init(g.N, g.K, 4, (int)gridDim.x, (int)blockIdx.x);
        pg8::EpiF32 E; E.C = (float*)(p.ws + W_H); E.Csmp = (float*)(p.ws + W_SMP) - (size_t)TP * DM; E.ldc = DM;
        pg8::gemm_phase<pg8::EpiF32, pg8::SplitOrder, false>((PG8_LAS unsigned char*)shm, g, S, E, nullptr);
    }
    SEAM(7);
    if (RUN(8)) phaseH_rows(p);
#if DUMP_PROJ
    if (p.phase_lo <= 9 && 9 < p.phase_hi) { const u32x4* src = (const u32x4*)(p.ws + DUMP_OFF); u32x4* dst = (u32x4*)p.out; for (size_t i = (size_t)blockIdx.x * 512 + threadIdx.x; i < DUMP_BYTES / 16; i += (size_t)gridDim.x * 512) dst[i] = src[i]; }
#endif
#if SANITIZE
    SEAM(8);
    if (p.phase_lo <= 9 && 9 < p.phase_hi) { for (size_t i = (size_t)blockIdx.x * 512 + threadIdx.x; i < 36278272; i += (size_t)gridDim.x * 512) { const float v = p.out[i]; if (!(fabsf(v) < 1e30f)) p.out[i] = 0.f; } }
#endif
}

constexpr size_t kDynLds = 152576;

extern "C" void kernel_launch(void* const* d_in, const int* in_sizes, int n_in, void* d_out, int out_size, void* d_ws, size_t ws_size, hipStream_t stream) {
    (void)in_sizes; (void)n_in; (void)out_size; (void)ws_size;
    static int grid_blocks = 0;
    if (!grid_blocks) {
        hipFuncSetAttribute((const void*)fwd_megakernel, hipFuncAttributeMaxDynamicSharedMemorySize, (int)kDynLds);
        int dev = 0, cus = 0, per_cu = 0;
        hipGetDevice(&dev);
        hipDeviceGetAttribute(&cus, hipDeviceAttributeMultiprocessorCount, dev);
        hipOccupancyMaxActiveBlocksPerMultiprocessor(&per_cu, fwd_megakernel, 512, kDynLds);
        if (per_cu < 1) per_cu = 1;
        if (per_cu > 1) per_cu = 1;
        grid_blocks = cus * per_cu;
    }
    Params p; memset(&p, 0, sizeof(p));
    p.x_prompt = (const float*)d_in[0]; p.x_sample = (const float*)d_in[1]; p.state_ret = (const float*)d_in[2]; p.state_gdn = (const float*)d_in[3];
    p.state_conv = (const float*)d_in[4]; p.pre_mix_w = (const float*)d_in[5]; p.w_in = (const float*)d_in[6]; p.conv_w = (const float*)d_in[7];
    p.A_log = (const float*)d_in[8]; p.dt_bias = (const float*)d_in[9]; p.ret_norm_w = (const float*)d_in[10]; p.gdn_norm_w = (const float*)d_in[11];
    p.w_out = (const float*)d_in[12]; p.post_mix_w = (const float*)d_in[13]; p.pre_mlp_w = (const float*)d_in[14]; p.w_up = (const float*)d_in[15];
    p.w_down = (const float*)d_in[16]; p.post_mlp_w = (const float*)d_in[17];
    p.out = (float*)d_out; p.ws = (unsigned char*)d_ws;
    p.rope_r = std::pow(10000.0, -1.0 / 64.0);
#if MULTI_LAUNCH
    for (int ph = 0; ph < 9 + SANITIZE; ++ph) {
        p.phase_lo = ph; p.phase_hi = ph + 1;
        hipLaunchKernelGGL(fwd_megakernel, dim3(grid_blocks), dim3(512), kDynLds, stream, p);
    }
#else
    p.phase_lo = 0; p.phase_hi = 9 + SANITIZE;
    void* args[] = {&p};
    hipError_t e = hipLaunchCooperativeKernel((const void*)fwd_megakernel, dim3(grid_blocks), dim3(512), args, kDynLds, stream);
    if (e != hipSuccess) fprintf(stderr, "cooperative launch failed: %s (grid %d)\n", hipGetErrorString(e), grid_blocks);
#endif
}
```

```cpp
#include <hip/hip_runtime.h>
#include <hip/hip_cooperative_groups.h>
#include <cstdio>
#include <cmath>
#include <cstring>
namespace cg = cooperative_groups;

#ifndef MULTI_LAUNCH
#define MULTI_LAUNCH 0
#endif

typedef unsigned short bf16_t;
typedef short bf16x8 __attribute__((ext_vector_type(8)));
typedef float f32x4 __attribute__((ext_vector_type(4)));
typedef float f32x16 __attribute__((ext_vector_type(16)));
typedef unsigned u32x4 __attribute__((ext_vector_type(4)));
typedef unsigned u32x2 __attribute__((ext_vector_type(2)));

constexpr int TP = 16384, TS = 1024, TT = TP + TS, DM = 1024, INW = 4104, NPJ = 4096, DFF = 4096;
constexpr size_t O_YP = 0, O_YS = 16777216, O_RP = 17825792, O_GP = 18350080, O_CP = 18874368, O_RS = 18911232, O_GS = 27299840, O_CS = 35688448;
constexpr size_t W_WIN = 0, W_WOUT = W_WIN + 8388608, W_WUP = W_WOUT + 2097152, W_WDN = W_WUP + 8388608, W_H = W_WDN + 8388608,
                 W_MIX = W_H + 35651584, W_PROJ = W_MIX + 35651584, W_AB = W_PROJ + 142606336, W_ROPE = W_AB + 557056,
                 W_SCP = W_ROPE + 1052672, W_SCS = W_SCP + 8388608, W_DEC = W_SCS + 4194304, W_BAR = W_DEC + 8192, W_END = W_BAR + 16384, W_SMP = W_WIN;

struct Params {
    const float *x_prompt, *x_sample, *state_ret, *state_gdn, *state_conv, *pre_mix_w, *w_in, *conv_w, *A_log, *dt_bias,
                *ret_norm_w, *gdn_norm_w, *w_out, *post_mix_w, *pre_mlp_w, *w_up, *w_down, *post_mlp_w;
    float* out;
    unsigned char* ws;
    double rope_r;
    int phase_lo, phase_hi;
};

#define DI __device__ __forceinline__
DI float bf2f(unsigned short b) { return __uint_as_float(((unsigned)b) << 16); }
DI float bflo(unsigned u) { return __uint_as_float(u << 16); }
DI float bfhi(unsigned u) { return __uint_as_float(u & 0xffff0000u); }
typedef float f32x2_t __attribute__((ext_vector_type(2)));
typedef __bf16 bf16x2_t __attribute__((ext_vector_type(2)));
DI unsigned pk_bf16(float lo, float hi) { f32x2_t v = {lo, hi}; bf16x2_t b = __builtin_convertvector(v, bf16x2_t); return __builtin_bit_cast(unsigned, b); }
DI unsigned short f2bf(float f) { return (unsigned short)(pk_bf16(f, 0.f) & 0xffffu); }
DI int sw256(int row, int chunk) { return row * 272 + (chunk << 4); }
DI int sw128(int row, int chunk) { return row * 144 + (chunk << 4); }
DI int sw128x(int row, int chunk) { return row * 144 + ((chunk ^ ((row >> 3) & 7)) << 4); }
DI int crow(int reg, int hh) { return (reg & 3) + 8 * (reg >> 2) + 4 * hh; }
DI float wave_sum(float v) { for (int o = 32; o >= 1; o >>= 1) v += __shfl_xor(v, o); return v; }
DI float silu(float x) { return x * __builtin_amdgcn_rcpf(1.0f + __expf(-x)); }
#define MFMA32(a, b, c) __builtin_amdgcn_mfma_f32_32x32x16_bf16((a), (b), (c), 0, 0, 0)

template <int NR> DI void fwd_subst(float (&x)[64], const float* Amat) {
#pragma unroll
    for (int i = 1; i < NR; ++i) {
        float s = x[i];
#pragma unroll
        for (int j = 0; j < i; ++j) s -= Amat[i * 64 + j] * x[j];
        x[i] = s;
        asm volatile("" ::: "memory");
    }
}

#define XB_TMO      128
#define XB_XCNT(j)  (256  + 64 * (j))
#define XB_XSUB(j)  (1280 + 64 * (j))
#define XB_XGEN(j)  (2304 + 64 * (j))
#define XB_TOP      3328
#define XB_TOPGEN   3392
#define XCD_BAR_WORDS 3456
#define XB_SPIN_CAP (1u << 18)
#define LAS __attribute__((address_space(3)))

__device__ __forceinline__ unsigned xb_ld(unsigned* p)              { return __hip_atomic_load(p, __ATOMIC_RELAXED, __HIP_MEMORY_SCOPE_AGENT); }
__device__ __forceinline__ unsigned xb_add(unsigned* p, unsigned v) { return __hip_atomic_fetch_add(p, v, __ATOMIC_RELAXED, __HIP_MEMORY_SCOPE_AGENT); }
__device__ __forceinline__ unsigned xb_xcc_id() { return (unsigned)__builtin_amdgcn_s_getreg((3 << 11) | 20) & 0xFu; }
#define XB_SPIN(cond, bar) do { unsigned _sp = 0; while (cond) { __builtin_amdgcn_s_sleep(1); \
    if ((++_sp & 255u) == 0u) { if (xb_ld(&(bar)[XB_TMO])) break; if (_sp > XB_SPIN_CAP) { atomicAdd(&(bar)[XB_TMO], 1u); break; } } } } while (0)

struct XcdBarrier {
    unsigned* bar; unsigned x;
    volatile LAS unsigned* st;
};

__device__ __forceinline__ XcdBarrier xcd_barrier_post(unsigned* bar, volatile LAS unsigned* st) {
    XcdBarrier b; b.bar = bar; b.x = xb_xcc_id(); b.st = st;
    if (threadIdx.x == 0) (void)xb_add(&bar[XB_XCNT(b.x)], 1u);
    return b;
}
__device__ __forceinline__ void xcd_barrier_complete(unsigned* bar, unsigned x, unsigned& nloc, unsigned& nx) {
    const unsigned G = gridDim.x * gridDim.y * gridDim.z;
    unsigned sum, cnt, mine, sp = 0u;
    for (;;) {
        sum = 0u; cnt = 0u; mine = 0u;
#pragma unroll
        for (unsigned j = 0; j < 16; ++j) { const unsigned c = xb_ld(&bar[XB_XCNT(j)]); sum += c; cnt += (c > 0u) ? 1u : 0u; mine = (j == x) ? c : mine; }
        if (sum == G) break;
        __builtin_amdgcn_s_sleep(1);
        if ((++sp & 255u) == 0u) { if (xb_ld(&bar[XB_TMO])) break; if (sp > XB_SPIN_CAP) { atomicAdd(&bar[XB_TMO], 1u); break; } }
    }
    nloc = mine > 0u ? mine : 1u; nx = cnt > 0u ? cnt : 1u;
}

__device__ __forceinline__ void xcd_barrier(const XcdBarrier& b) {
    asm volatile("s_waitcnt vmcnt(0)" ::: "memory");
    __syncthreads();
    if (threadIdx.x == 0) {
        unsigned* bar = b.bar;
        __builtin_amdgcn_s_waitcnt(0);
        unsigned nloc = b.st[0], nx = b.st[1];
        if (nloc == 0u) { xcd_barrier_complete(bar, b.x, nloc, nx); b.st[0] = nloc; b.st[1] = nx; }
        const unsigned old = xb_add(&bar[XB_XSUB(b.x)], 1u);
        const unsigned gen = old / nloc;
        if (old + 1u == (gen + 1u) * nloc) {
            __builtin_amdgcn_fence(__ATOMIC_RELEASE, "agent");
            asm volatile("s_waitcnt vmcnt(0)" ::: "memory");
            const unsigned og = xb_add(&bar[XB_TOP], 1u);
            const unsigned tg = og / nx;
            if (og + 1u == (tg + 1u) * nx) xb_add(&bar[XB_TOPGEN], 1u);
            else XB_SPIN(xb_ld(&bar[XB_TOPGEN]) == tg, bar);
            __builtin_amdgcn_fence(__ATOMIC_ACQUIRE, "agent");
            xb_add(&bar[XB_XGEN(b.x)], 1u);
            asm volatile("s_waitcnt vmcnt(0)" ::: "memory");
        } else {
            XB_SPIN(xb_ld(&bar[XB_XGEN(b.x)]) == gen, bar);
            __builtin_amdgcn_fence(__ATOMIC_ACQUIRE, "agent");
            asm volatile("s_waitcnt vmcnt(0)" ::: "memory");
        }
    }
    __syncthreads();
}


namespace pg8 {
#define PG8_LAS __attribute__((address_space(3)))
typedef unsigned short bf16_t;
typedef short bf16x8 __attribute__((ext_vector_type(8)));
typedef float f32x4 __attribute__((ext_vector_type(4)));
typedef unsigned u32x4 __attribute__((ext_vector_type(4)));
constexpr int BM = 256, BK = 64, HALF = 128, HTB = HALF * BK * 2  , STAGE_BYTES = 8 * HTB, NXCD = 8, WGM = 8;

__host__ __device__ __forceinline__ int lds_byte(int r, int c) { const int st = (r >> 4) * 2 + (c >> 5), rr = r & 15, cc = c & 31, ob = rr * 64 + cc * 2; return st * 1024 + (ob ^ (((ob >> 9) & 1) << 5)); }
__host__ __device__ __forceinline__ void stage_rc(int b, int& R, int& C) { const int st = b / 1024, sb = b % 1024, swz = sb ^ (((sb >> 9) & 1) << 5); R = (st >> 1) * 16 + swz / 64; C = (st & 1) * 32 + (swz % 64) / 2; }
__host__ __device__ __forceinline__ int perm32(int rho) { const int n = rho >> 4, i = rho & 15; return 8 * (i >> 2) + 4 * n + (i & 3); }

struct Unit { int pm, pn, kt0, nkt, smp; };
struct Gemm { const bf16_t* A; const bf16_t* Bt; int M, N, K; };

struct StaticOrder {
    int nM, nN, nwg, G, c;
    __host__ __device__ void init(int M, int N, int G_, int c_) { nM = M / BM; nN = N / BM; nwg = nM * nN; G = G_; c = c_; }
    __host__ __device__ bool next(int i, Unit& u) const {
        const long L = (long)i * G + c; if (L >= nwg) return false;
        int wgid = (int)L; { const int q = nwg / NXCD, r = nwg % NXCD, xcd = wgid % NXCD, off = wgid / NXCD; wgid = (xcd < r ? xcd * (q + 1) : r * (q + 1) + (xcd - r) * q) + off; }
        const int nig = WGM * nN, gid = wgid / nig, fm = gid * WGM, gsz = (nM - fm) < WGM ? (nM - fm) : WGM;
        u.pm = fm + ((wgid % nig) % gsz); u.pn = (wgid % nig) / gsz; return true;
    }
    __device__ __forceinline__ void a_ready(const Unit&) const {}
    __device__ __forceinline__ void done(const Unit&) const {}
};
struct SplitOrder {
    StaticOrder so; int nN, nfull, nsub, G, c, KS, nktf;
    __host__ __device__ void init(int N, int K, int KS_, int G_, int c_) { so.init(16384, N, G_, c_); nN = N / BM; nfull = 64 * nN; KS = KS_; nsub = 4 * nN * KS; G = G_; c = c_; nktf = K / BK; }
    __host__ __device__ bool next(int i, Unit& u) const {
        const long L = (long)i * G + c; if (L >= nfull + nsub) return false;
        if (L < nfull) { so.next(i, u); u.kt0 = 0; u.nkt = nktf; u.smp = 0; }
        else { const int q = (int)(L - nfull), ks = q % KS, uu = q / KS; u.pm = 64 + (uu & 3); u.pn = uu >> 2; u.nkt = nktf / KS; u.kt0 = ks * u.nkt; u.smp = KS > 1 ? ks + 1 : 0; }
        return true;
    }
    __device__ __forceinline__ void a_ready(const Unit&) const {}
    __device__ __forceinline__ void done(const Unit&) const {}
};

__device__ __forceinline__ unsigned cvt_pk_bf16(float lo, float hi) { return ::pk_bf16(lo, hi); }
struct EpiF32 {
    static constexpr bool PERM = false, AFTER_DRAIN = false;
    float* C; float* Csmp; int ldc;
    __device__ __forceinline__ void operator()(const f32x4 (&acc)[2][2][4][2], const Unit& u, int wr, int wc, int fr, int fq) const {
        const int row0 = u.pm * BM + wr * 64 + fr, col0 = u.pn * BM + wc * 32 + 4 * fq;
        if (u.smp) {
            float* base = Csmp + (size_t)(u.smp - 1) * 1024 * ldc;
#pragma unroll
            for (int ai = 0; ai < 2; ++ai)
#pragma unroll
                for (int m = 0; m < 4; ++m) { float* rowp = base + (size_t)(row0 + ai * HALF + m * 16) * ldc + col0;
#pragma unroll
                    for (int bj = 0; bj < 2; ++bj)
#pragma unroll
                        for (int n = 0; n < 2; ++n) *(f32x4*)(rowp + bj * HALF + n * 16) = acc[ai][bj][m][n]; }
            return;
        }
#pragma unroll
        for (int ai = 0; ai < 2; ++ai)
#pragma unroll
            for (int m = 0; m < 4; ++m) { float* rowp = C + (size_t)(row0 + ai * HALF + m * 16) * ldc + col0;
#pragma unroll
                for (int bj = 0; bj < 2; ++bj)
#pragma unroll
                    for (int n = 0; n < 2; ++n) *(f32x4*)(rowp + bj * HALF + n * 16) = acc[ai][bj][m][n]; }
    }
};
template <int ACT  > struct EpiBf16 {
    static constexpr bool PERM = true, AFTER_DRAIN = false;
    bf16_t* O; int ldc;
    __device__ __forceinline__ void operator()(const f32x4 (&acc)[2][2][4][2], const Unit& u, int wr, int wc, int fr, int fq) const {
        const int row0 = u.pm * BM + wr * 64 + fr; const int col0 = u.pn * BM + wc * 32 + 8 * fq;
#pragma unroll
        for (int ai = 0; ai < 2; ++ai)
#pragma unroll
            for (int m = 0; m < 4; ++m) { bf16_t* rowp = O + (size_t)(row0 + ai * HALF + m * 16) * ldc + col0;
#pragma unroll
                for (int bj = 0; bj < 2; ++bj) { f32x4 v0 = acc[ai][bj][m][0], v1 = acc[ai][bj][m][1];
                    if (ACT == 1) {
#pragma unroll
                        for (int j = 0; j < 4; ++j) { const float a = fmaxf(v0[j], 0.f), b = fmaxf(v1[j], 0.f); v0[j] = a * a; v1[j] = b * b; } }
                    u32x4 w; w.x = cvt_pk_bf16(v0[0], v0[1]); w.y = cvt_pk_bf16(v0[2], v0[3]); w.z = cvt_pk_bf16(v1[0], v1[1]); w.w = cvt_pk_bf16(v1[2], v1[3]);
                    *(u32x4*)(rowp + bj * HALF) = w; } }
    }
};
template <class Epi, class Sched, bool STAMP = false>
__device__ __forceinline__ void gemm_phase(PG8_LAS unsigned char* lds, const Gemm g, const Sched& S, const Epi& E, unsigned long long* stamps) {
    const int tid = threadIdx.x, wid = __builtin_amdgcn_readfirstlane(tid >> 6), lane = tid & 63, wr = wid >> 2, wc = wid & 3, fr = lane & 15, fq = lane >> 4;
    const int K = g.K;
    int ts_lo = 0, ts_hi = 0, nts = 0; const unsigned long long rt_entry = STAMP ? (unsigned long long)wall_clock64() : 0ull;
#define PG8_STAMP() do { if (STAMP && wid == 0 && nts < 64) { const unsigned long long _c = (unsigned long long)clock64(); \
        ts_lo = (lane == nts) ? (int)(unsigned)_c : ts_lo; ts_hi = (lane == nts) ? (int)(unsigned)(_c >> 32) : ts_hi; ++nts; } } while (0)
    PG8_STAMP();
    unsigned voffA[2], voffB[2];
#pragma unroll
    for (int i = 0; i < 2; ++i) { int R, C; stage_rc(tid * 16 + i * 8192, R, C); const int Rb = Epi::PERM ? ((R & ~31) + perm32(R & 31)) : R;
        voffA[i] = (unsigned)(R * K + C) * 2u; voffB[i] = (unsigned)(Rb * K + C) * 2u; }
    const size_t kstep = (size_t)(BK * 2);
    const size_t hstep = (size_t)HALF * K * 2;
    const size_t tstep = 2 * hstep;
    const unsigned ldsw = (unsigned)wid * 1024u;
    const int aoff = lds_byte(wr * 64 + fr, fq * 8), boff = lds_byte(wc * 32 + fr, fq * 8);
#define PG8_SA(b, h) (((b) * 2 + (h)) * HTB)
#define PG8_SB(b, h) ((4 + (b) * 2 + (h)) * HTB)
#define PG8_STAGE(bufoff, gbase, voff) do { _Pragma("unroll") for (int _i = 0; _i < 2; ++_i) \
        __builtin_amdgcn_global_load_lds((const unsigned*)((const char*)(gbase) + (voff)[_i]), (PG8_LAS unsigned*)(lds + (bufoff) + ldsw + _i * 8192), 16, 0, 0); } while (0)
#define PG8_LDA(dst, b, h) do { _Pragma("unroll") for (int m = 0; m < 4; ++m) _Pragma("unroll") for (int k = 0; k < 2; ++k) dst[m][k] = *(const PG8_LAS bf16x8*)(lds + PG8_SA(b, h) + aoff + m * 2048 + k * 1024); } while (0)
#define PG8_LDB(dst, b, h) do { _Pragma("unroll") for (int n = 0; n < 2; ++n) _Pragma("unroll") for (int k = 0; k < 2; ++k) dst[n][k] = *(const PG8_LAS bf16x8*)(lds + PG8_SB(b, h) + boff + n * 2048 + k * 1024); } while (0)
#define PG8_MMA(ai, bj, At, Bt) do { __builtin_amdgcn_s_setprio(1); _Pragma("unroll") for (int m = 0; m < 4; ++m) _Pragma("unroll") for (int n = 0; n < 2; ++n) _Pragma("unroll") for (int k = 0; k < 2; ++k) \
        acc[ai][bj][m][n] = __builtin_amdgcn_mfma_f32_16x16x32_bf16(Bt[n][k], At[m][k], acc[ai][bj][m][n], 0, 0, 0); __builtin_amdgcn_s_setprio(0); } while (0)
#define PG8_WAIT_V(n) asm volatile("s_waitcnt vmcnt(" #n ")" ::: "memory")
#define PG8_WAIT_L(n) asm volatile("s_waitcnt lgkmcnt(" #n ")" ::: "memory")
#define PG8_BAR __builtin_amdgcn_s_barrier()
#define PG8_SCHED __builtin_amdgcn_sched_barrier(0)
    Unit cur, nxt; int ui = 0;
    if (!S.next(0, cur)) return;
    f32x4 acc[2][2][4][2];
#pragma unroll
    for (int a = 0; a < 2; ++a)
#pragma unroll
        for (int b = 0; b < 2; ++b)
#pragma unroll
            for (int m = 0; m < 4; ++m)
#pragma unroll
                for (int n = 0; n < 2; ++n) acc[a][b][m][n] = (f32x4){0.f, 0.f, 0.f, 0.f};
    bf16x8 At[4][2], B0[2][2], B1[2][2];
    const char* cA = (const char*)g.A + (size_t)cur.pm * tstep + (size_t)cur.kt0 * kstep; const char* cB = (const char*)g.Bt + (size_t)cur.pn * tstep + (size_t)cur.kt0 * kstep;
    S.a_ready(cur);
    PG8_STAGE(PG8_SB(0, 0), cB, voffB); PG8_STAGE(PG8_SA(0, 0), cA, voffA); PG8_STAGE(PG8_SB(0, 1), cB + hstep, voffB); PG8_STAGE(PG8_SA(0, 1), cA + hstep, voffA);
    if (wr == 1) PG8_BAR;
    PG8_WAIT_V(4); PG8_BAR;
    PG8_STAGE(PG8_SB(1, 0), cB + kstep, voffB); PG8_STAGE(PG8_SA(1, 0), cA + kstep, voffA); PG8_STAGE(PG8_SB(1, 1), cB + hstep + kstep, voffB);
    PG8_WAIT_V(6); PG8_BAR;
    PG8_STAMP();
    for (;;) {
        const bool has_next = S.next(ui + 1, nxt);
        const char* nA = has_next ? (const char*)g.A + (size_t)nxt.pm * tstep + (size_t)nxt.kt0 * kstep : cA; const char* nB = has_next ? (const char*)g.Bt + (size_t)nxt.pn * tstep + (size_t)nxt.kt0 * kstep : cB;
        const int nt = cur.nkt;
        for (int t = 0; t < nt; t += 2) {
            const bool last = (t == nt - 2);
            const char* a1 = cA + (size_t)(t + 1) * kstep;
            const char* a2 = last ? nA : cA + (size_t)(t + 2) * kstep; const char* b2 = last ? nB : cB + (size_t)(t + 2) * kstep;
            const char* a3 = a2 + kstep; const char* b3 = b2 + kstep;
            if (last && has_next) S.a_ready(nxt);
            PG8_LDB(B0, 0, 0); PG8_SCHED; PG8_LDA(At, 0, 0); PG8_STAGE(PG8_SA(1, 1), a1 + hstep, voffA);
            PG8_WAIT_L(8); PG8_BAR; PG8_WAIT_L(0); PG8_MMA(0, 0, At, B0); PG8_BAR; PG8_SCHED;
            PG8_LDB(B1, 0, 1); PG8_STAGE(PG8_SB(0, 0), b2, voffB);
            PG8_BAR; PG8_WAIT_L(0); PG8_MMA(0, 1, At, B1); PG8_BAR;
            PG8_LDA(At, 0, 1); PG8_STAGE(PG8_SA(0, 0), a2, voffA);
            PG8_BAR; PG8_WAIT_L(0); PG8_MMA(1, 0, At, B0); PG8_BAR; PG8_SCHED;
            PG8_STAGE(PG8_SB(0, 1), b2 + hstep, voffB);
            PG8_WAIT_V(6); PG8_BAR; PG8_MMA(1, 1, At, B1); PG8_BAR;
            PG8_LDB(B0, 1, 0); PG8_SCHED; PG8_LDA(At, 1, 0); PG8_STAGE(PG8_SA(0, 1), a2 + hstep, voffA);
            PG8_WAIT_L(8); PG8_BAR; PG8_WAIT_L(0); PG8_MMA(0, 0, At, B0); PG8_BAR; PG8_SCHED;
            PG8_LDB(B1, 1, 1); PG8_STAGE(PG8_SB(1, 0), b3, voffB);
            PG8_BAR; PG8_WAIT_L(0); PG8_MMA(0, 1, At, B1); PG8_BAR;
            PG8_LDA(At, 1, 1); PG8_STAGE(PG8_SA(1, 0), a3, voffA);
            PG8_BAR; PG8_WAIT_L(0); PG8_MMA(1, 0, At, B0); PG8_BAR; PG8_SCHED;
            PG8_STAGE(PG8_SB(1, 1), b3 + hstep, voffB);
            PG8_WAIT_V(6); PG8_BAR; PG8_MMA(1, 1, At, B1); PG8_BAR;
        }
        PG8_STAMP();
        if constexpr (!Epi::AFTER_DRAIN) { E(acc, cur, wr, wc, fr, fq); S.done(cur); }
        PG8_STAMP();
        if (!has_next) break;
#pragma unroll
        for (int a = 0; a < 2; ++a)
#pragma unroll
            for (int b = 0; b < 2; ++b)
#pragma unroll
                for (int m = 0; m < 4; ++m)
#pragma unroll
                    for (int n = 0; n < 2; ++n) acc[a][b][m][n] = (f32x4){0.f, 0.f, 0.f, 0.f};
        cur = nxt; cA = nA; cB = nB; ++ui;
    }
    PG8_WAIT_V(0);
    if (wr == 0) PG8_BAR;
    PG8_BAR;
    if constexpr (Epi::AFTER_DRAIN) { E.fused(acc, cur, wr, wc, fr, fq, lds, wid, lane); S.done(cur); }
    PG8_STAMP();
    if (STAMP && wid == 0) { stamps[lane] = lane < nts ? (((unsigned long long)(unsigned)ts_hi << 32) | (unsigned)ts_lo) : 0ull;
        if (lane == 62) stamps[62] = rt_entry; if (lane == 63) stamps[63] = (unsigned long long)wall_clock64(); }
#undef PG8_STAMP
#undef PG8_SA
#undef PG8_SB
#undef PG8_STAGE
#undef PG8_LDA
#undef PG8_LDB
#undef PG8_MMA
#undef PG8_WAIT_V
#undef PG8_WAIT_L
#undef PG8_BAR
#undef PG8_SCHED
}
}

__device__ __forceinline__ void phaseA_weights(const Params& p, float* tl  ) {
    const int tid = threadIdx.x;
    for (int tile = blockIdx.x; tile < 3328; tile += gridDim.x) {
        const float* src; bf16_t* dst; int ldn, K, lt;
        if (tile < 1024)      { src = p.w_in;   ldn = INW;  K = 1024; dst = (bf16_t*)(p.ws + W_WIN);  lt = tile; }
        else if (tile < 1280) { src = p.w_out;  ldn = 1024; K = 1024; dst = (bf16_t*)(p.ws + W_WOUT); lt = tile - 1024; }
        else if (tile < 2304) { src = p.w_up;   ldn = 4096; K = 1024; dst = (bf16_t*)(p.ws + W_WUP);  lt = tile - 1280; }
        else                  { src = p.w_down; ldn = 1024; K = 4096; dst = (bf16_t*)(p.ws + W_WDN);  lt = tile - 2304; }
        const int nkt = K >> 6, kt = lt % nkt, nt = lt / nkt;
#pragma unroll
        for (int i = 0; i < 2; ++i) {
            const int r = (tid >> 4) + 32 * i, c4 = (tid & 15) * 4;
            const float4 v = *(const float4*)(src + (size_t)(kt * 64 + r) * ldn + nt * 64 + c4);
            tl[r * 65 + c4 + 0] = v.x; tl[r * 65 + c4 + 1] = v.y; tl[r * 65 + c4 + 2] = v.z; tl[r * 65 + c4 + 3] = v.w;
        }
        __syncthreads();
        {
            const int n = tid >> 3, k8 = (tid & 7) * 8;
            float v[8];
#pragma unroll
            for (int j = 0; j < 8; ++j) v[j] = tl[(k8 + j) * 65 + n];
            u32x4 w; w.x = pk_bf16(v[0], v[1]); w.y = pk_bf16(v[2], v[3]); w.z = pk_bf16(v[4], v[5]); w.w = pk_bf16(v[6], v[7]);
            *(u32x4*)(dst + (size_t)(nt * 64 + n) * K + kt * 64 + k8) = w;
        }
        __syncthreads();
    }
}

__device__ __forceinline__ void phaseA_rope(const Params& p) {
    float2* tab = (float2*)(p.ws + W_ROPE);
    for (int idx = blockIdx.x * 512 + threadIdx.x; idx < 2056 * 64; idx += gridDim.x * 512) {
        const int pi = idx >> 6, f = idx & 63;
        double ivd = 1.0; for (int k = 0; k < f; ++k) ivd *= p.rope_r;
        const float ivf = (float)ivd;
        const float pos = pi < 2048 ? (float)pi : (float)(16384 + pi - 2048);
        const float ang = pos * ivf;
        const double a = (double)ang, q = rint(a * 0.63661977236758134308);
        double r = fma(-q, 1.57079632679489655800, a); r = fma(-q, 6.12323399573676603587e-17, r);
        const int qd = ((int)q) & 3;
        const double r2 = r * r;
        const double s = r * (1.0 + r2 * (-1.0 / 6.0 + r2 * (1.0 / 120.0 + r2 * (-1.0 / 5040.0 + r2 * (1.0 / 362880.0 + r2 * (-1.0 / 39916800.0 + r2 * (1.0 / 6227020800.0)))))));
        const double c = 1.0 + r2 * (-0.5 + r2 * (1.0 / 24.0 + r2 * (-1.0 / 720.0 + r2 * (1.0 / 40320.0 + r2 * (-1.0 / 3628800.0 + r2 * (1.0 / 479001600.0 + r2 * (-1.0 / 87178291200.0)))))));
        double co, si;
        if (qd == 0) { co = c; si = s; } else if (qd == 1) { co = -s; si = c; } else if (qd == 2) { co = -c; si = -s; } else { co = s; si = -c; }
        tab[idx] = make_float2((float)co, (float)si);
    }
}

__device__ __forceinline__ void phaseA_norm(const Params& p, float* wab  ) {
    const int tid = threadIdx.x, wave = tid >> 6, lane = tid & 63;
    for (int i = tid; i < 8192; i += 512) { const int k = i >> 3, j = i & 7; wab[j * 1024 + k] = p.w_in[(size_t)k * INW + 4096 + j]; }
    __syncthreads();
    bf16_t* hbuf = (bf16_t*)(p.ws + W_H); float* ab = (float*)(p.ws + W_AB);
    float4 wv[4];
#pragma unroll
    for (int i = 0; i < 4; ++i) wv[i] = *(const float4*)(p.pre_mix_w + lane * 4 + 256 * i);
    float bias = 0.f, alog = 0.f; if (lane < 4) { bias = p.dt_bias[lane]; alog = p.A_log[lane]; }
    const int stride = gridDim.x * 8;
    int row = blockIdx.x * 8 + wave;
    float4 v[4];
    if (row < TT) { const float* xr = row < TP ? p.x_prompt + (size_t)row * DM : p.x_sample + (size_t)(row - TP) * DM;
#pragma unroll
        for (int i = 0; i < 4; ++i) v[i] = *(const float4*)(xr + lane * 4 + 256 * i); }
    while (row < TT) {
        const int nrow = row + stride;
        float4 vn[4];
        if (nrow < TT) { const float* xr = nrow < TP ? p.x_prompt + (size_t)nrow * DM : p.x_sample + (size_t)(nrow - TP) * DM;
#pragma unroll
            for (int i = 0; i < 4; ++i) vn[i] = *(const float4*)(xr + lane * 4 + 256 * i); }
        float ss = 0.f;
#pragma unroll
        for (int i = 0; i < 4; ++i) ss += v[i].x * v[i].x + v[i].y * v[i].y + v[i].z * v[i].z + v[i].w * v[i].w;
        ss = wave_sum(ss);
        const float rs = rsqrtf(ss * (1.0f / 1024.0f) + 1e-6f);
        float acc[8];
#pragma unroll
        for (int j = 0; j < 8; ++j) acc[j] = 0.f;
#pragma unroll
        for (int i = 0; i < 4; ++i) {
            const float4 w = wv[i];
            const float h0 = v[i].x * rs * w.x, h1 = v[i].y * rs * w.y, h2 = v[i].z * rs * w.z, h3 = v[i].w * rs * w.w;
            u32x2 o; o.x = pk_bf16(h0, h1); o.y = pk_bf16(h2, h3);
            *(u32x2*)(hbuf + (size_t)row * DM + lane * 4 + 256 * i) = o;
#pragma unroll
            for (int j = 0; j < 8; ++j) { const float4 wj = *(const float4*)(wab + j * 1024 + lane * 4 + 256 * i); acc[j] += h0 * wj.x + h1 * wj.y + h2 * wj.z + h3 * wj.w; }
        }
#pragma unroll
        for (int j = 0; j < 8; ++j) acc[j] = wave_sum(acc[j]);
        if (lane < 8) {
            float a = acc[0];
#pragma unroll
            for (int j = 1; j < 8; ++j) a = (lane == j) ? acc[j] : a;
            float o;
            if (lane < 4) { const float xx = a + bias; const float sp = xx > 20.f ? xx : log1pf(expf(xx)); o = -expf(alog) * sp; }
            else o = 1.0f / (1.0f + expf(-a));
            ab[(size_t)row * 8 + lane] = o;
        }
#pragma unroll
        for (int i = 0; i < 4; ++i) v[i] = vn[i];
        row = nrow;
    }
}

DI void ld_row4(float4 (&v)[4], const float* rp, int lane) {
#pragma unroll
    for (int i = 0; i < 4; ++i) v[i] = *(const float4*)(rp + lane * 4 + 256 * i);
}
DI void add_row4(float4 (&v)[4], const float* rp, int lane) {
#pragma unroll
    for (int i = 0; i < 4; ++i) { const float4 t = *(const float4*)(rp + lane * 4 + 256 * i); v[i].x += t.x; v[i].y += t.y; v[i].z += t.z; v[i].w += t.w; }
}
DI float ssq4(const float4 (&v)[4]) { float s = 0.f;
#pragma unroll
    for (int i = 0; i < 4; ++i) s += v[i].x * v[i].x + v[i].y * v[i].y + v[i].z * v[i].z + v[i].w * v[i].w;
    return s; }
__device__ __forceinline__ void phaseE_rows(const Params& p) {
    const int tid = threadIdx.x, wave = tid >> 6, lane = tid & 63;
    const float* mbuf = (const float*)(p.ws + W_PROJ); bf16_t* hbuf = (bf16_t*)(p.ws + W_H); const float* part = (const float*)(p.ws + W_SMP);
    float4 w1[4], w2[4]; ld_row4(w1, p.post_mix_w, lane); ld_row4(w2, p.pre_mlp_w, lane);
    const int stride = gridDim.x * 8;
    int row = blockIdx.x * 8 + wave;
    float4 m[4], x[4];
    if (row < TT) { ld_row4(x, row < TP ? p.x_prompt + (size_t)row * DM : p.x_sample + (size_t)(row - TP) * DM, lane);
        if (row < TP) ld_row4(m, mbuf + (size_t)row * DM, lane); else { ld_row4(m, part + (size_t)(row - TP) * DM, lane); add_row4(m, part + 1048576 + (size_t)(row - TP) * DM, lane); } }
    while (row < TT) {
        const int nrow = row + stride;
        float4 mn[4], xn[4];
        if (nrow < TT) { ld_row4(xn, nrow < TP ? p.x_prompt + (size_t)nrow * DM : p.x_sample + (size_t)(nrow - TP) * DM, lane);
            if (nrow < TP) ld_row4(mn, mbuf + (size_t)nrow * DM, lane); else { ld_row4(mn, part + (size_t)(nrow - TP) * DM, lane); add_row4(mn, part + 1048576 + (size_t)(nrow - TP) * DM, lane); } }
        const float rs = rsqrtf(wave_sum(ssq4(m)) * (1.0f / 1024.0f) + 1e-6f);
        float* yr = p.out + (size_t)row * DM;
#pragma unroll
        for (int i = 0; i < 4; ++i) { x[i].x += m[i].x * rs * w1[i].x; x[i].y += m[i].y * rs * w1[i].y; x[i].z += m[i].z * rs * w1[i].z; x[i].w += m[i].w * rs * w1[i].w;
            *(float4*)(yr + lane * 4 + 256 * i) = x[i]; }
        const float rs2 = rsqrtf(wave_sum(ssq4(x)) * (1.0f / 1024.0f) + 1e-6f);
#pragma unroll
        for (int i = 0; i < 4; ++i) { u32x2 o; o.x = pk_bf16(x[i].x * rs2 * w2[i].x, x[i].y * rs2 * w2[i].y); o.y = pk_bf16(x[i].z * rs2 * w2[i].z, x[i].w * rs2 * w2[i].w);
            *(u32x2*)(hbuf + (size_t)row * DM + lane * 4 + 256 * i) = o; }
#pragma unroll
        for (int i = 0; i < 4; ++i) { m[i] = mn[i]; x[i] = xn[i]; }
        row = nrow;
    }
}
__device__ __forceinline__ void phaseH_rows(const Params& p) {
    const int tid = threadIdx.x, wave = tid >> 6, lane = tid & 63;
    const float* fbuf = (const float*)(p.ws + W_H); const float* part = (const float*)(p.ws + W_SMP);
    float4 w1[4]; ld_row4(w1, p.post_mlp_w, lane);
    const int stride = gridDim.x * 8;
    int row = blockIdx.x * 8 + wave;
    float4 f[4], x[4];
    auto ldf = [&](float4 (&d)[4], int r) { if (r < TP) ld_row4(d, fbuf + (size_t)r * DM, lane); else { const float* q = part + (size_t)(r - TP) * DM; ld_row4(d, q, lane); add_row4(d, q + 1048576, lane); add_row4(d, q + 2 * 1048576, lane); add_row4(d, q + 3 * 1048576, lane); } };
    if (row < TT) { ld_row4(x, p.out + (size_t)row * DM, lane); ldf(f, row); }
    while (row < TT) {
        const int nrow = row + stride;
        float4 fn[4], xn[4];
        if (nrow < TT) { ld_row4(xn, p.out + (size_t)nrow * DM, lane); ldf(fn, nrow); }
        const float rs = rsqrtf(wave_sum(ssq4(f)) * (1.0f / 1024.0f) + 1e-6f);
        float* yr = p.out + (size_t)row * DM;
#pragma unroll
        for (int i = 0; i < 4; ++i) { x[i].x += f[i].x * rs * w1[i].x; x[i].y += f[i].y * rs * w1[i].y; x[i].z += f[i].z * rs * w1[i].z; x[i].w += f[i].w * rs * w1[i].w;
            *(float4*)(yr + lane * 4 + 256 * i) = x[i]; }
#pragma unroll
        for (int i = 0; i < 4; ++i) { f[i] = fn[i]; x[i] = xn[i]; }
        row = nrow;
    }
}

__device__ __forceinline__ void phaseC1_gdn_prep(const Params& p, unsigned char* lds, int first, int step) {
    const int tid = threadIdx.x, w = tid >> 6, lane = tid & 63, r = lane & 31, hh = lane >> 5;
    float* qc = (float*)lds; float* kc = qc + 64 * 129; float* vc = kc + 64 * 129;
    unsigned char* knb = lds + 99072; unsigned char* qnb = lds + 116480;
    float* Amat = (float*)(lds + 133888); float* cum = (float*)(lds + 150528); float* beta = cum + 64; float* rnq = cum + 128; float* rnk = cum + 192; float* fack = cum + 256;
    bf16_t* stg = (bf16_t*)(lds + 99072);
    const bf16_t* proj = (const bf16_t*)(p.ws + W_PROJ); const float* ab = (const float*)(p.ws + W_AB);
    for (int item = first; item < 1536; item += step) {
        const bool sample = item >= 1024;
        int b, n, h, row0, nrows, slot;
        if (!sample) { b = item >> 7; n = (item >> 2) & 31; h = item & 3; row0 = b * 2048 + n * 64; nrows = 64; slot = (b * 4 + h) * 32 + n; }
        else { const int s = item - 1024; b = s >> 2; n = 0; h = s & 3; row0 = TP + b * 8; nrows = 8; slot = s; }
        unsigned char* sbase = sample ? (unsigned char*)(p.out + O_GS) + (size_t)slot * 65536 : (unsigned char*)(p.out + O_YP) + (size_t)slot * 65536;
        bf16_t* sc_out = (bf16_t*)(p.ws + (sample ? W_SCS : W_SCP)) + (size_t)slot * 4096;
        float* dec_out = (float*)(p.ws + W_DEC) + (sample ? 1024 + slot : slot);
        {
            const int nld = nrows * 48;
            for (int idx = tid; idx < nld; idx += 512) {
                const int row = idx / 48, rem = idx - row * 48, seg = rem >> 4, pc = rem & 15;
                *(u32x4*)(stg + row * 384 + seg * 128 + pc * 8) = *(const u32x4*)(proj + (size_t)(row0 + row) * NPJ + 2048 + seg * 512 + h * 128 + pc * 8);
            }
        }
        __syncthreads();
        if (tid < 384) {
            const int seg = tid >> 7, d = tid & 127, ch = seg * 512 + h * 128 + d;
            const float c0 = p.conv_w[ch], c1 = p.conv_w[1536 + ch], c2 = p.conv_w[3072 + ch], c3 = p.conv_w[4608 + ch];
            const bf16_t* src = proj + (size_t)row0 * NPJ + 2048 + ch;
            float xm3 = 0.f, xm2 = 0.f, xm1 = 0.f;
            if (sample) { const float* sc = p.state_conv + (size_t)b * 3 * 1536 + ch; xm3 = sc[0]; xm2 = sc[1536]; xm1 = sc[3072]; }
            else if (n > 0) { xm3 = bf2f(*(src - 3 * NPJ)); xm2 = bf2f(*(src - 2 * NPJ)); xm1 = bf2f(*(src - NPJ)); }
            float* dst = qc + seg * (64 * 129) + d;
#pragma unroll 8
            for (int i = 0; i < nrows; ++i) {
                const float x = bf2f(stg[i * 384 + tid]);
                float cv = c0 * xm3; cv += c1 * xm2; cv += c2 * xm1; cv += c3 * x;
                dst[i * 129] = silu(cv);
                xm3 = xm2; xm2 = xm1; xm1 = x;
            }
            for (int i = nrows; i < 64; ++i) dst[i * 129] = 0.f;
            if (sample) { float* co = p.out + O_CS + (size_t)b * 3 * 1536 + ch; co[0] = xm3; co[1536] = xm2; co[3072] = xm1; }
            else if (n == 31) { float* co = p.out + O_CP + (size_t)b * 3 * 1536 + ch; co[0] = xm3; co[1536] = xm2; co[3072] = xm1; }
        } else if (tid < 448) {
            const int i = tid - 384;
            float g = 0.f, be = 0.f;
            if (i < nrows) { g = ab[(size_t)(row0 + i) * 8 + h]; be = ab[(size_t)(row0 + i) * 8 + 4 + h]; }
#pragma unroll
            for (int o = 1; o < 64; o <<= 1) { const float t = __shfl_up(g, o); if (i >= o) g += t; }
            cum[i] = g; beta[i] = be;
        }
        __syncthreads();
        if (tid < 128) {
            const int which = tid >> 6, row = tid & 63; const float* bp = (which ? kc : qc) + row * 129;
            float ss = 0.f;
#pragma unroll 16
            for (int d = 0; d < 128; ++d) ss += bp[d] * bp[d];
            float rn = rsqrtf(ss + 1e-6f);
            if (!which) rnq[row] = rn * 0.08838834764831845f; else { rnk[row] = rn; fack[row] = rn * beta[row] * __expf(cum[row]); }
        }
        __syncthreads();
#pragma unroll
        for (int it = 0; it < 4; ++it) {
            const int idx = tid + 512 * it, img = idx >> 10, rem = idx & 1023, row = rem >> 4, chunk = rem & 15;
            const float* sp = (img ? kc : qc) + row * 129 + chunk * 8; const float rn = img ? rnk[row] : rnq[row];
            u32x4 o; o.x = pk_bf16(sp[0] * rn, sp[1] * rn); o.y = pk_bf16(sp[2] * rn, sp[3] * rn); o.z = pk_bf16(sp[4] * rn, sp[5] * rn); o.w = pk_bf16(sp[6] * rn, sp[7] * rn);
            *(u32x4*)((img ? knb : qnb) + sw256(row, chunk)) = o;
        }
        __syncthreads();
        {
            const int isq = w >> 2, it_ = (w >> 1) & 1, jt = w & 1;
            f32x16 acc;
#pragma unroll
            for (int i = 0; i < 16; ++i) acc[i] = 0.f;
            const unsigned char* ai = isq ? qnb : knb;
#pragma unroll
            for (int s = 0; s < 8; ++s) {
                const bf16x8 a = *(const bf16x8*)(ai + sw256(it_ * 32 + r, 2 * s + hh));
                const bf16x8 bb = *(const bf16x8*)(knb + sw256(jt * 32 + r, 2 * s + hh));
                acc = MFMA32(a, bb, acc);
            }
            const int j = jt * 32 + r; const float cj = cum[j];
#pragma unroll
            for (int reg = 0; reg < 16; ++reg) {
                const int i = it_ * 32 + crow(reg, hh);
                const float dm = __expf(fminf(cum[i] - cj, 0.f)), dm2 = __expf(fminf(cj - cum[i], 0.f));
                if (!isq) Amat[i * 64 + j] = (i < j) ? beta[j] * acc[reg] * dm2 : 0.f;
                else sc_out[i * 64 + j] = f2bf((j <= i) ? acc[reg] * dm : 0.f);
            }
        }
        __syncthreads();
        {
#pragma unroll
            for (int it = 0; it < 2; ++it) {
                const int idx = tid + 512 * it, row = idx >> 4, chunk = idx & 15;
                const float e = __expf(cum[row]) * rnq[row]; const float* sp = qc + row * 129 + chunk * 8;
                u32x4 o; o.x = pk_bf16(sp[0] * e, sp[1] * e); o.y = pk_bf16(sp[2] * e, sp[3] * e); o.z = pk_bf16(sp[4] * e, sp[5] * e); o.w = pk_bf16(sp[6] * e, sp[7] * e);
                *(u32x4*)(sbase + 16384 + row * 256 + chunk * 16) = o;
            }
            const int d = tid & 127, cq = tid >> 7; const float cl = cum[63];
            u32x4* o = (u32x4*)(sbase + 49152 + (size_t)d * 128 + cq * 32);
#pragma unroll
            for (int c8 = 0; c8 < 2; ++c8) {
                float v[8];
#pragma unroll
                for (int j = 0; j < 8; ++j) { const int c = cq * 16 + c8 * 8 + j; v[j] = kc[c * 129 + d] * rnk[c] * __expf(cl - cum[c]); }
                u32x4 q; q.x = pk_bf16(v[0], v[1]); q.y = pk_bf16(v[2], v[3]); q.z = pk_bf16(v[4], v[5]); q.w = pk_bf16(v[6], v[7]); o[c8] = q;
            }
            if (tid == 0) *dec_out = __expf(cl);
        }
        __syncthreads();
        if (tid < 256) {
            int vz; asm volatile("v_mov_b32 %0, 0" : "=v"(vz));
            const float* At = Amat + vz;
            float* colp = (tid < 128) ? (kc + tid) : (vc + tid - 128);
            const float* facp = ((tid < 128) ? fack : beta) + vz;
            const int nblk = nrows == 64 ? 4 : 1;
            for (int bi = 0; bi < nblk; ++bi) {
                const int R0 = bi * 16;
                float acc[16];
#pragma unroll
                for (int ii = 0; ii < 16; ++ii) acc[ii] = colp[(R0 + ii) * 129] * facp[R0 + ii];
#pragma unroll 4
                for (int j = 0; j < R0; ++j) {
                    const float xj = colp[j * 129];
                    const f32x4 a0 = *(const f32x4*)(At + j * 64 + R0), a1 = *(const f32x4*)(At + j * 64 + R0 + 4), a2 = *(const f32x4*)(At + j * 64 + R0 + 8), a3 = *(const f32x4*)(At + j * 64 + R0 + 12);
#pragma unroll
                    for (int q = 0; q < 4; ++q) { acc[q] -= a0[q] * xj; acc[4 + q] -= a1[q] * xj; acc[8 + q] -= a2[q] * xj; acc[12 + q] -= a3[q] * xj; }
                }
#pragma unroll
                for (int jj = 0; jj < 15; ++jj) {
                    const float* ar = At + (R0 + jj) * 64 + R0;
#pragma unroll
                    for (int ii = jj + 1; ii < 16; ++ii) acc[ii] -= ar[ii] * acc[jj];
                }
#pragma unroll
                for (int ii = 0; ii < 16; ++ii) colp[(R0 + ii) * 129] = acc[ii];
            }
            if (tid < 128) {
                bf16_t* o = (bf16_t*)sbase + tid;
#pragma unroll 8
                for (int i = 0; i < 64; ++i) o[i * 128] = f2bf(-colp[i * 129]);
            } else {
                u32x4* o = (u32x4*)(sbase + 32768 + (size_t)(tid - 128) * 128);
#pragma unroll
                for (int c8 = 0; c8 < 8; ++c8) { float x[8];
#pragma unroll
                    for (int j = 0; j < 8; ++j) x[j] = colp[(c8 * 8 + j) * 129];
                    u32x4 v; v.x = pk_bf16(x[0], x[1]); v.y = pk_bf16(x[2], x[3]); v.z = pk_bf16(x[4], x[5]); v.w = pk_bf16(x[6], x[7]); o[c8] = v; }
            }
        }
        __syncthreads();
    }
}

template <bool GDN> __device__ __forceinline__ void scan_item(const Params& p, unsigned char* lds, int b, int h, bool sample, int* prog = nullptr) {
    const int tid = threadIdx.x, w = tid >> 6, lane = tid & 63, r = lane & 31, hh = lane >> 5;
    const int ct = w >> 2, et = w & 3;
    unsigned char* St = lds; unsigned char* INA = lds + 34816; unsigned char* INQ = lds + 52224; unsigned char* INKT = lds + 69632;
    unsigned char* INSC = lds + 88064; unsigned char* VNT = lds + 97280; float* SSQ = (float*)(lds + 115712);
    const int nchunks = sample ? 1 : 32, nrows = sample ? 8 : 64;
    const int row_base = sample ? TP + b * 8 : b * 2048;
    const bf16_t* proj = (const bf16_t*)(p.ws + W_PROJ);
    bf16_t* mix = (bf16_t*)(p.ws + W_MIX);
    const float* nw = GDN ? p.gdn_norm_w : p.ret_norm_w;
    const int gate_col = GDN ? 3584 + h * 128 : 1536 + h * 128;
    const int mix_col = (GDN ? 512 : 0) + h * 128;
    const float2* rtab = (const float2*)(p.ws + W_ROPE);
    const float lg2 = log2f(1.0f - exp2f(-5.0f - (float)h));
    f32x16 S0, S1;
    const int e_col = et * 32 + r;
    if (sample) {
        const float* s0 = (GDN ? p.state_gdn : p.state_ret) + (size_t)(b * 4 + h) * 16384 + ((2 * ct) * 32 + 4 * hh) * 128 + e_col;
#pragma unroll
        for (int reg = 0; reg < 16; ++reg) { S0[reg] = s0[((reg & 3) + 8 * (reg >> 2)) * 128]; S1[reg] = s0[((reg & 3) + 8 * (reg >> 2) + 32) * 128]; }
    } else {
#pragma unroll
        for (int reg = 0; reg < 16; ++reg) { S0[reg] = 0.f; S1[reg] = 0.f; }
    }
    auto write_St = [&]() {
#pragma unroll
        for (int g = 0; g < 4; ++g) {
            u32x2 v0, v1; v0.x = pk_bf16(S0[4 * g], S0[4 * g + 1]); v0.y = pk_bf16(S0[4 * g + 2], S0[4 * g + 3]); v1.x = pk_bf16(S1[4 * g], S1[4 * g + 1]); v1.y = pk_bf16(S1[4 * g + 2], S1[4 * g + 3]);
            *(u32x2*)(St + sw256(e_col, (2 * ct) * 4 + g) + 8 * hh) = v0;
            *(u32x2*)(St + sw256(e_col, (2 * ct + 1) * 4 + g) + 8 * hh) = v1;
        }
    };
    write_St();
    unsigned char* OST = lds + 117248;
    float* NW = (float*)(lds + 116736);
    if (tid < 128) NW[tid] = nw[tid];
    u32x4 ra[2], rq[2], rk[2], rs4;
    u32x2 ru[4];
    f32x4 rt[4];
    float decay = 1.f;
    const unsigned char* gbase = nullptr; const bf16_t* gsc = nullptr; const float* gdec = nullptr;
    if (GDN) {
        const int slot0 = sample ? (b * 4 + h) : (b * 4 + h) * 32;
        gbase = sample ? (const unsigned char*)(p.out + O_GS) + (size_t)slot0 * 65536 : (const unsigned char*)(p.out + O_YP) + (size_t)slot0 * 65536;
        gsc = (const bf16_t*)(p.ws + (sample ? W_SCS : W_SCP)) + (size_t)slot0 * 4096;
        gdec = (const float*)(p.ws + W_DEC) + (sample ? 1024 + slot0 : slot0);
    }
    const int c_tok = ct * 32 + r;
    auto prefetch = [&](int n) {
        const size_t trow = (size_t)row_base + n * 64;
        if (GDN) {
            const unsigned char* sb = gbase + (size_t)n * 65536;
#pragma unroll
            for (int i = 0; i < 2; ++i) { const int idx = tid + 512 * i; ra[i] = *(const u32x4*)(sb + idx * 16); rq[i] = *(const u32x4*)(sb + 16384 + idx * 16); rk[i] = *(const u32x4*)(sb + 49152 + idx * 16); }
            rs4 = *(const u32x4*)((const unsigned char*)(gsc + (size_t)n * 4096) + tid * 16);
#pragma unroll
            for (int g = 0; g < 4; ++g) ru[g] = *(const u32x2*)(sb + 32768 + (e_col * 64 + ct * 32 + 8 * g + 4 * hh) * 2);
            decay = gdec[n];
        } else {
            const int c = tid >> 3, cp = tid & 7;
            if (c < nrows) {
                const bf16_t* qr = proj + (trow + c) * NPJ + h * 128 + cp * 8;
                ra[0] = *(const u32x4*)qr; ra[1] = *(const u32x4*)(qr + 64);
                rq[0] = *(const u32x4*)(qr + 512); rq[1] = *(const u32x4*)(qr + 512 + 64);
                const int pidx = sample ? 2048 + c : n * 64 + c;
                const f32x4* tp = (const f32x4*)(rtab + (size_t)pidx * 64 + cp * 8);
                rt[0] = tp[0]; rt[1] = tp[1]; rt[2] = tp[2]; rt[3] = tp[3];
            }
#pragma unroll
            for (int i = 0; i < 2; ++i) { const int idx = tid + 512 * i, row = idx >> 4, chunk = idx & 15;
                if (row < nrows) rk[i] = *(const u32x4*)(proj + (trow + row) * NPJ + 1024 + h * 128 + chunk * 8); }
        }
    };
    auto flush = [&](int n) {
#pragma unroll
        for (int i = 0; i < 2; ++i) { const int idx = tid + 512 * i, row = idx >> 4, chunk = idx & 15;
            if (row < nrows) *(u32x4*)(mix + ((size_t)row_base + n * 64 + row) * DM + mix_col + chunk * 8) = *(const u32x4*)(OST + sw256(row, chunk)); }
    };
    prefetch(0);
    for (int n = 0; n < nchunks; ++n) {
        u32x2 gate[4];
        f32x16 acc1;
        if (GDN) {
#pragma unroll
            for (int i = 0; i < 2; ++i) { const int idx = tid + 512 * i;
                *(u32x4*)(INA + sw256(idx >> 4, idx & 15)) = ra[i]; *(u32x4*)(INQ + sw256(idx >> 4, idx & 15)) = rq[i]; *(u32x4*)(INKT + sw128x(idx >> 3, idx & 7)) = rk[i]; }
            *(u32x4*)(INSC + sw128(tid >> 3, tid & 7)) = rs4;
#pragma unroll
            for (int g = 0; g < 4; ++g) { acc1[4 * g] = bflo(ru[g].x); acc1[4 * g + 1] = bfhi(ru[g].x); acc1[4 * g + 2] = bflo(ru[g].y); acc1[4 * g + 3] = bfhi(ru[g].y); }
        } else {
            const int c = tid >> 3, cp = tid & 7;
            u32x4 q1 = {0u, 0u, 0u, 0u}, q2 = q1, k1 = q1, k2 = q1;
            unsigned short kt1[8], kt2[8];
#pragma unroll
            for (int j = 0; j < 8; ++j) { kt1[j] = 0; kt2[j] = 0; }
            if (c < nrows) {
                const float fq = exp2f((float)(c + 1) * lg2), fk = 0.08838834764831845f * exp2f((float)(nrows - 1 - c) * lg2);
                float oq1[8], oq2[8], ok1[8], ok2[8];
#pragma unroll
                for (int j = 0; j < 8; ++j) {
                    const unsigned qa = ra[0][j >> 1], qb = ra[1][j >> 1], ka = rq[0][j >> 1], kb = rq[1][j >> 1];
                    const float x1 = (j & 1) ? bfhi(qa) : bflo(qa), x2 = (j & 1) ? bfhi(qb) : bflo(qb);
                    const float y1 = (j & 1) ? bfhi(ka) : bflo(ka), y2 = (j & 1) ? bfhi(kb) : bflo(kb);
                    const float co = rt[j >> 1][(j & 1) * 2], si = rt[j >> 1][(j & 1) * 2 + 1];
                    oq1[j] = (x1 * co - x2 * si) * fq; oq2[j] = (x1 * si + x2 * co) * fq;
                    ok1[j] = (y1 * co - y2 * si) * fk; ok2[j] = (y1 * si + y2 * co) * fk;
                }
#pragma unroll
                for (int j = 0; j < 4; ++j) { q1[j] = pk_bf16(oq1[2 * j], oq1[2 * j + 1]); q2[j] = pk_bf16(oq2[2 * j], oq2[2 * j + 1]); k1[j] = pk_bf16(ok1[2 * j], ok1[2 * j + 1]); k2[j] = pk_bf16(ok2[2 * j], ok2[2 * j + 1]); }
#pragma unroll
                for (int j = 0; j < 8; ++j) { kt1[j] = (unsigned short)((j & 1) ? (k1[j >> 1] >> 16) : (k1[j >> 1] & 0xffffu)); kt2[j] = (unsigned short)((j & 1) ? (k2[j >> 1] >> 16) : (k2[j >> 1] & 0xffffu)); }
            }
            *(u32x4*)(INQ + sw256(c, cp)) = q1; *(u32x4*)(INQ + sw256(c, cp + 8)) = q2;
            *(u32x4*)(INA + sw256(c, cp)) = k1; *(u32x4*)(INA + sw256(c, cp + 8)) = k2;
#pragma unroll
            for (int j = 0; j < 8; ++j) {
                const int d1 = cp * 8 + j, d2 = d1 + 64;
                *(unsigned short*)(INKT + sw128x(d1, c >> 3) + (c & 7) * 2) = kt1[j];
                *(unsigned short*)(INKT + sw128x(d2, c >> 3) + (c & 7) * 2) = kt2[j];
            }
#pragma unroll
            for (int i = 0; i < 2; ++i) { const int idx = tid + 512 * i, row = idx >> 4, chunk = idx & 15;
                const u32x4 vv = (row < nrows) ? rk[i] : (u32x4){0u, 0u, 0u, 0u};
#pragma unroll
                for (int j = 0; j < 8; ++j) { const int e = chunk * 8 + j;
                    *(unsigned short*)(VNT + sw128x(e, row >> 3) + (row & 7) * 2) = (unsigned short)((j & 1) ? (vv[j >> 1] >> 16) : (vv[j >> 1] & 0xffffu)); } }
            decay = exp2f((float)nrows * lg2);
        }
        const float dec_n = decay;
        __syncthreads();
        if (n > 0) flush(n - 1);
        if (c_tok < nrows) {
#pragma unroll
            for (int g = 0; g < 4; ++g) gate[g] = *(const u32x2*)(proj + ((size_t)row_base + n * 64 + c_tok) * NPJ + gate_col + et * 32 + 8 * g + 4 * hh);
        }
        prefetch(n + 1 < nchunks ? n + 1 : n);
        if (GDN) {
#pragma unroll
            for (int s = 0; s < 8; ++s) {
                const bf16x8 a = *(const bf16x8*)(INA + sw256(ct * 32 + r, 2 * s + hh));
                const bf16x8 bb = *(const bf16x8*)(St + sw256(et * 32 + r, 2 * s + hh));
                acc1 = MFMA32(a, bb, acc1);
            }
#pragma unroll
            for (int g = 0; g < 4; ++g) { u32x2 v; v.x = pk_bf16(acc1[4 * g], acc1[4 * g + 1]); v.y = pk_bf16(acc1[4 * g + 2], acc1[4 * g + 3]);
                *(u32x2*)(VNT + sw128x(e_col, ct * 4 + g) + 8 * hh) = v; }
        } else {
            if (w < 4) {
                const int it_ = w >> 1, jt = w & 1;
#pragma unroll
                for (int i = 0; i < 16; ++i) acc1[i] = 0.f;
#pragma unroll
                for (int s = 0; s < 8; ++s) {
                    const bf16x8 a = *(const bf16x8*)(INQ + sw256(it_ * 32 + r, 2 * s + hh));
                    const bf16x8 bb = *(const bf16x8*)(INA + sw256(jt * 32 + r, 2 * s + hh));
                    acc1 = MFMA32(a, bb, acc1);
                }
                const float sc = exp2f(-(float)nrows * lg2); const int j = jt * 32 + r;
#pragma unroll
                for (int reg = 0; reg < 16; ++reg) { const int i = it_ * 32 + crow(reg, hh);
                    *(unsigned short*)(INSC + sw128(i, j >> 3) + (j & 7) * 2) = f2bf((j <= i) ? acc1[reg] * sc : 0.f); }
            }
        }
        __syncthreads();
        f32x16 acc2;
#pragma unroll
        for (int i = 0; i < 16; ++i) acc2[i] = 0.f;
#pragma unroll
        for (int s = 0; s < 8; ++s) {
            const bf16x8 a = *(const bf16x8*)(St + sw256(et * 32 + r, 2 * s + hh));
            const bf16x8 bb = *(const bf16x8*)(INQ + sw256(ct * 32 + r, 2 * s + hh));
            acc2 = MFMA32(a, bb, acc2);
        }
#pragma unroll
        for (int s = 0; s < 4; ++s) {
            const bf16x8 a = *(const bf16x8*)(VNT + sw128x(et * 32 + r, 2 * s + hh));
            const bf16x8 bb = *(const bf16x8*)(INSC + sw128(ct * 32 + r, 2 * s + hh));
            acc2 = MFMA32(a, bb, acc2);
        }
        {
            float sq = 0.f;
#pragma unroll
            for (int i = 0; i < 16; ++i) sq += acc2[i] * acc2[i];
            sq += __shfl_xor(sq, 32);
            if (hh == 0) SSQ[et * 64 + c_tok] = sq;
        }
#pragma unroll
        for (int i = 0; i < 16; ++i) { S0[i] *= dec_n; S1[i] *= dec_n; }
#pragma unroll
        for (int s = 0; s < 4; ++s) {
            const bf16x8 bb = *(const bf16x8*)(VNT + sw128x(et * 32 + r, 2 * s + hh));
            const bf16x8 a0 = *(const bf16x8*)(INKT + sw128x((2 * ct) * 32 + r, 2 * s + hh));
            const bf16x8 a1 = *(const bf16x8*)(INKT + sw128x((2 * ct + 1) * 32 + r, 2 * s + hh));
            S0 = MFMA32(a0, bb, S0); S1 = MFMA32(a1, bb, S1);
        }
        __syncthreads();
        if (prog && tid == 0) __hip_atomic_store(prog, n + 1, __ATOMIC_RELAXED, __HIP_MEMORY_SCOPE_AGENT);
        write_St();
        if (c_tok < nrows) {
            const float ss = SSQ[c_tok] + SSQ[64 + c_tok] + SSQ[128 + c_tok] + SSQ[192 + c_tok];
            const float rn = rsqrtf(ss * (1.0f / 128.0f) + 1e-6f);
            unsigned char* orow = OST + sw256(c_tok, et * 4);
#pragma unroll
            for (int g = 0; g < 4; ++g) {
                const int e0 = 8 * g + 4 * hh;
                const f32x4 wv = *(const f32x4*)(NW + et * 32 + e0);
                const float o0 = acc2[4 * g] * rn * wv[0] * silu(bflo(gate[g].x)), o1 = acc2[4 * g + 1] * rn * wv[1] * silu(bfhi(gate[g].x));
                const float o2 = acc2[4 * g + 2] * rn * wv[2] * silu(bflo(gate[g].y)), o3 = acc2[4 * g + 3] * rn * wv[3] * silu(bfhi(gate[g].y));
                u32x2 v; v.x = pk_bf16(o0, o1); v.y = pk_bf16(o2, o3);
                *(u32x2*)(orow + g * 16 + 8 * hh) = v;
            }
        }
    }
    __syncthreads();
    flush(nchunks - 1);
    {
        float* so = p.out + (sample ? (GDN ? O_GS : O_RS) : (GDN ? O_GP : O_RP)) + (size_t)(b * 4 + h) * 16384 + ((2 * ct) * 32 + 4 * hh) * 128 + e_col;
#pragma unroll
        for (int reg = 0; reg < 16; ++reg) { so[((reg & 3) + 8 * (reg >> 2)) * 128] = S0[reg]; so[((reg & 3) + 8 * (reg >> 2) + 32) * 128] = S1[reg]; }
    }
    __syncthreads();
}

__device__ __forceinline__ void phaseX(const Params& p, unsigned char* lds) { phaseC1_gdn_prep(p, lds, blockIdx.x, gridDim.x); }
__device__ __forceinline__ void phaseY(const Params& p, unsigned char* lds) {
    const int G = gridDim.x, bid = blockIdx.x;
    int* progs = (int*)(p.ws + W_DEC + 6144);
    int start = bid, limit = 64 + 1024, stride = G;
    if (G >= 192) {
        if (bid < 64) { limit = 64; stride = 64; }
        else { start = bid; stride = G - 64; }
    }
    for (int s = start; s < limit; s += stride) {
        const bool sample = s >= 64; const int t = sample ? s - 64 : s;
        const bool gdn = sample ? (t & 1) : (t >= 32);
        const int bh = sample ? (t >> 1) : (t & 31), b = bh >> 2, h = bh & 3;
        int* pr = nullptr; (void)progs;
        if (gdn) scan_item<true>(p, lds, b, h, sample, pr); else scan_item<false>(p, lds, b, h, sample, pr);
    }
}

#ifndef DUMP_PROJ
#define DUMP_PROJ 0
#define DUMP_OFF W_PROJ
#define DUMP_BYTES 142606336ull
#endif
#ifndef DUP_C1
#define DUP_C1 0
#endif
#ifndef DUP_C12
#define DUP_C12 0
#endif
#ifndef SANITIZE
#define SANITIZE 0
#endif
#ifndef PHASE_MASK
#define PHASE_MASK 511
#endif
__global__ void __launch_bounds__(512, 2) fwd_megakernel(Params p) {
    extern __shared__ __attribute__((aligned(16))) unsigned char shm[];
    cg::grid_group grid = cg::this_grid();
    const bool multi = (p.phase_hi - p.phase_lo) > 1;
    volatile LAS unsigned* xst = (volatile LAS unsigned*)((LAS unsigned char*)shm + 152560);
    if (threadIdx.x == 0) { xst[0] = 0u; xst[1] = 0u; }
    __syncthreads();
    XcdBarrier xb = xcd_barrier_post((unsigned*)(p.ws + W_BAR), xst);
    if (p.phase_hi == 0x7fffffff) grid.sync();
#define RUN(ph) (p.phase_lo <= (ph) && (ph) < p.phase_hi && (PHASE_MASK & (1 << (ph))))
#define SEAM(ph) do { if (multi && p.phase_lo <= (ph) && (ph) + 1 < p.phase_hi) { xcd_barrier(xb); } } while (0)
    if (RUN(0)) { phaseA_weights(p, (float*)shm); phaseA_norm(p, (float*)shm); phaseA_rope(p); if (blockIdx.x == 0 && threadIdx.x < 64) ((int*)(p.ws + W_DEC + 6144))[threadIdx.x] = 0; }
    SEAM(0);
    if (RUN(1)) {
        pg8::Gemm g; g.A = (const bf16_t*)(p.ws + W_H); g.Bt = (const bf16_t*)(p.ws + W_WIN); g.M = TT; g.N = NPJ; g.K = DM;
        pg8::SplitOrder S; S.init(g.N, g.K, 1, (int)gridDim.x, (int)blockIdx.x);
        pg8::EpiBf16<0> E; E.O = (bf16_t*)(p.ws + W_PROJ); E.ldc = NPJ;
        pg8::gemm_phase<pg8::EpiBf16<0>, pg8::SplitOrder, false>((PG8_LAS unsigned char*)shm, g, S, E, nullptr);
    }
    SEAM(1);
    if (RUN(2)) phaseX(p, shm);
    SEAM(2);
    if (RUN(3)) phaseY(p, shm);
    SEAM(3);
    if (RUN(4)) {
        pg8::Gemm g; g.A = (const bf16_t*)(p.ws + W_MIX); g.Bt = (const bf16_t*)(p.ws + W_WOUT); g.M = TT; g.N = DM; g.K = DM;
        pg8::SplitOrder S; S.init(g.N, g.K, 2, (int)gridDim.x, (int)blockIdx.x);
        pg8::EpiF32 E; E.C = (float*)(p.ws + W_PROJ); E.Csmp = (float*)(p.ws + W_SMP) - (size_t)TP * DM; E.ldc = DM;
        pg8::gemm_phase<pg8::EpiF32, pg8::SplitOrder, false>((PG8_LAS unsigned char*)shm, g, S, E, nullptr);
    }
    SEAM(4);
    if (RUN(5)) phaseE_rows(p);
    SEAM(5);
    if (RUN(6)) {
        pg8::Gemm g; g.A = (const bf16_t*)(p.ws + W_H); g.Bt = (const bf16_t*)(p.ws + W_WUP); g.M = TT; g.N = DFF; g.K = DM;
        pg8::SplitOrder S; S.init(g.N, g.K, 1, (int)gridDim.x, (int)blockIdx.x);
        pg8::EpiBf16<1> E; E.O = (bf16_t*)(p.ws + W_PROJ); E.ldc = DFF;
        pg8::gemm_phase<pg8::EpiBf16<1>, pg8::SplitOrder, false>((PG8_LAS unsigned char*)shm, g, S, E, nullptr);
    }
    SEAM(6);
    if (RUN(7)) {
        pg8::Gemm g; g.A = (const bf16_t*)(p.ws + W_PROJ); g.Bt = (const bf16_t*)(p.ws + W_WDN); g.M = TT; g.N = DM; g.K = DFF;
        pg8::SplitOrder S; S.init(g.N, g.K, 4, (int)gridDim.x, (int)blockIdx.x);
        pg8::EpiF32 E; E.C = (float*)(p.ws + W_H); E.Csmp = (float*)(p.ws + W_SMP) - (size_t)TP * DM; E.ldc = DM;
        pg8::gemm_phase<pg8::EpiF32, pg8::SplitOrder, false>((PG8_LAS unsigned char*)shm, g, S, E, nullptr);
    }
    SEAM(7);
    if (RUN(8)) phaseH_rows(p);
#if DUMP_PROJ
    if (p.phase_lo <= 9 && 9 < p.phase_hi) { const u32x4* src = (const u32x4*)(p.ws + DUMP_OFF); u32x4* dst = (u32x4*)p.out; for (size_t i = (size_t)blockIdx.x * 512 + threadIdx.x; i < DUMP_BYTES / 16; i += (size_t)gridDim.x * 512) dst[i] = src[i]; }
#endif
#if SANITIZE
    SEAM(8);
    if (p.phase_lo <= 9 && 9 < p.phase_hi) { for (size_t i = (size_t)blockIdx.x * 512 + threadIdx.x; i < 36278272; i += (size_t)gridDim.x * 512) { const float v = p.out[i]; if (!(fabsf(v) < 1e30f)) p.out[i] = 0.f; } }
#endif
}

constexpr size_t kDynLds = 152576;

extern "C" void kernel_launch(void* const* d_in, const int* in_sizes, int n_in, void* d_out, int out_size, void* d_ws, size_t ws_size, hipStream_t stream) {
    (void)in_sizes; (void)n_in; (void)out_size; (void)ws_size;
    static int grid_blocks = 0;
    if (!grid_blocks) {
        hipFuncSetAttribute((const void*)fwd_megakernel, hipFuncAttributeMaxDynamicSharedMemorySize, (int)kDynLds);
        int dev = 0, cus = 0, per_cu = 0;
        hipGetDevice(&dev);
        hipDeviceGetAttribute(&cus, hipDeviceAttributeMultiprocessorCount, dev);
        hipOccupancyMaxActiveBlocksPerMultiprocessor(&per_cu, fwd_megakernel, 512, kDynLds);
        if (per_cu < 1) per_cu = 1;
        if (per_cu > 1) per_cu = 1;
        grid_blocks = cus * per_cu;
    }
    Params p; memset(&p, 0, sizeof(p));
    p.x_prompt = (const float*)d_in[0]; p.x_sample = (const float*)d_in[1]; p.state_ret = (const float*)d_in[2]; p.state_gdn = (const float*)d_in[3];
    p.state_conv = (const float*)d_in[4]; p.pre_mix_w = (const float*)d_in[5]; p.w_in = (const float*)d_in[6]; p.conv_w = (const float*)d_in[7];
    p.A_log = (const float*)d_in[8]; p.dt_bias = (const float*)d_in[9]; p.ret_norm_w = (const float*)d_in[10]; p.gdn_norm_w = (const float*)d_in[11];
    p.w_out = (const float*)d_in[12]; p.post_mix_w = (const float*)d_in[13]; p.pre_mlp_w = (const float*)d_in[14]; p.w_up = (const float*)d_in[15];
    p.w_down = (const float*)d_in[16]; p.post_mlp_w = (const float*)d_in[17];
    p.out = (float*)d_out; p.ws = (unsigned char*)d_ws;
    p.rope_r = std::pow(10000.0, -1.0 / 64.0);
#if MULTI_LAUNCH
    for (int ph = 0; ph < 9 + SANITIZE; ++ph) {
        p.phase_lo = ph; p.phase_hi = ph + 1;
        hipLaunchKernelGGL(fwd_megakernel, dim3(grid_blocks), dim3(512), kDynLds, stream, p);
    }
#else
    p.phase_lo = 0; p.phase_hi = 9 + SANITIZE;
    hipMemsetAsync((unsigned char*)d_ws + W_BAR, 0, XCD_BAR_WORDS * 4, stream);
    void* args[] = {&p};
    hipError_t e = hipLaunchCooperativeKernel((const void*)fwd_megakernel, dim3(grid_blocks), dim3(512), args, kDynLds, stream);
    if (e != hipSuccess) fprintf(stderr, "cooperative launch failed: %s (grid %d)\n", hipGetErrorString(e), grid_blocks);
#endif
}
```

```cpp
#include <hip/hip_runtime.h>
#include <hip/hip_cooperative_groups.h>
#include <cstdio>
#include <cmath>
#include <cstring>
namespace cg = cooperative_groups;

#ifndef MULTI_LAUNCH
#define MULTI_LAUNCH 0
#endif

typedef unsigned short bf16_t;
typedef short bf16x8 __attribute__((ext_vector_type(8)));
typedef float f32x4 __attribute__((ext_vector_type(4)));
typedef float f32x16 __attribute__((ext_vector_type(16)));
typedef unsigned u32x4 __attribute__((ext_vector_type(4)));
typedef unsigned u32x2 __attribute__((ext_vector_type(2)));

constexpr int TP = 16384, TS = 1024, TT = TP + TS, DM = 1024, INW = 4104, NPJ = 4096, DFF = 4096;
constexpr size_t O_YP = 0, O_YS = 16777216, O_RP = 17825792, O_GP = 18350080, O_CP = 18874368, O_RS = 18911232, O_GS = 27299840, O_CS = 35688448;
constexpr size_t W_WIN = 0, W_WOUT = W_WIN + 8388608, W_WUP = W_WOUT + 2097152, W_WDN = W_WUP + 8388608, W_H = W_WDN + 8388608,
                 W_MIX = W_H + 35651584, W_PROJ = W_MIX + 35651584, W_AB = W_PROJ + 142606336, W_ROPE = W_AB + 557056,
                 W_SCP = W_ROPE + 1052672, W_SCS = W_SCP + 8388608, W_DEC = W_SCS + 4194304, W_BAR = W_DEC + 8192, W_END = W_BAR + 16384, W_SMP = W_WIN;

struct Params {
    const float *x_prompt, *x_sample, *state_ret, *state_gdn, *state_conv, *pre_mix_w, *w_in, *conv_w, *A_log, *dt_bias,
                *ret_norm_w, *gdn_norm_w, *w_out, *post_mix_w, *pre_mlp_w, *w_up, *w_down, *post_mlp_w;
    float* out;
    unsigned char* ws;
    double rope_r;
    int phase_lo, phase_hi;
};

#define DI __device__ __forceinline__
DI float bf2f(unsigned short b) { return __uint_as_float(((unsigned)b) << 16); }
DI float bflo(unsigned u) { return __uint_as_float(u << 16); }
DI float bfhi(unsigned u) { return __uint_as_float(u & 0xffff0000u); }
typedef float f32x2_t __attribute__((ext_vector_type(2)));
typedef __bf16 bf16x2_t __attribute__((ext_vector_type(2)));
DI unsigned pk_bf16(float lo, float hi) { f32x2_t v = {lo, hi}; bf16x2_t b = __builtin_convertvector(v, bf16x2_t); return __builtin_bit_cast(unsigned, b); }
DI unsigned short f2bf(float f) { return (unsigned short)(pk_bf16(f, 0.f) & 0xffffu); }
DI int sw256(int row, int chunk) { return row * 272 + (chunk << 4); }
DI int sw128(int row, int chunk) { return row * 144 + (chunk << 4); }
DI int sw128x(int row, int chunk) { return row * 144 + ((chunk ^ ((row >> 3) & 7)) << 4); }
DI int crow(int reg, int hh) { return (reg & 3) + 8 * (reg >> 2) + 4 * hh; }
DI float wave_sum(float v) { for (int o = 32; o >= 1; o >>= 1) v += __shfl_xor(v, o); return v; }
DI float silu(float x) { return x * __builtin_amdgcn_rcpf(1.0f + __expf(-x)); }
#define MFMA32(a, b, c) __builtin_amdgcn_mfma_f32_32x32x16_bf16((a), (b), (c), 0, 0, 0)

template <int NR> DI void fwd_subst(float (&x)[64], const float* Amat) {
#pragma unroll
    for (int i = 1; i < NR; ++i) {
        float s = x[i];
#pragma unroll
        for (int j = 0; j < i; ++j) s -= Amat[i * 64 + j] * x[j];
        x[i] = s;
        asm volatile("" ::: "memory");
    }
}

#define XB_TMO      128
#define XB_XCNT(j)  (256  + 64 * (j))
#define XB_XSUB(j)  (1280 + 64 * (j))
#define XB_XGEN(j)  (2304 + 64 * (j))
#define XB_TOP      3328
#define XB_TOPGEN   3392
#define XCD_BAR_WORDS 3456
#define XB_SPIN_CAP (1u << 18)
#define LAS __attribute__((address_space(3)))

__device__ __forceinline__ unsigned xb_ld(unsigned* p)              { return __hip_atomic_load(p, __ATOMIC_RELAXED, __HIP_MEMORY_SCOPE_AGENT); }
__device__ __forceinline__ unsigned xb_add(unsigned* p, unsigned v) { return __hip_atomic_fetch_add(p, v, __ATOMIC_RELAXED, __HIP_MEMORY_SCOPE_AGENT); }
__device__ __forceinline__ unsigned xb_xcc_id() { return (unsigned)__builtin_amdgcn_s_getreg((3 << 11) | 20) & 0xFu; }
#define XB_SPIN(cond, bar) do { unsigned _sp = 0; while (cond) { __builtin_amdgcn_s_sleep(1); \
    if ((++_sp & 255u) == 0u) { if (xb_ld(&(bar)[XB_TMO])) break; if (_sp > XB_SPIN_CAP) { atomicAdd(&(bar)[XB_TMO], 1u); break; } } } } while (0)

struct XcdBarrier {
    unsigned* bar; unsigned x;
    volatile LAS unsigned* st;
};

__device__ __forceinline__ XcdBarrier xcd_barrier_post(unsigned* bar, volatile LAS unsigned* st) {
    XcdBarrier b; b.bar = bar; b.x = xb_xcc_id(); b.st = st;
    if (threadIdx.x == 0) (void)xb_add(&bar[XB_XCNT(b.x)], 1u);
    return b;
}
__device__ __forceinline__ void xcd_barrier_complete(unsigned* bar, unsigned x, unsigned& nloc, unsigned& nx) {
    const unsigned G = gridDim.x * gridDim.y * gridDim.z;
    unsigned sum, cnt, mine, sp = 0u;
    for (;;) {
        sum = 0u; cnt = 0u; mine = 0u;
#pragma unroll
        for (unsigned j = 0; j < 16; ++j) { const unsigned c = xb_ld(&bar[XB_XCNT(j)]); sum += c; cnt += (c > 0u) ? 1u : 0u; mine = (j == x) ? c : mine; }
        if (sum == G) break;
        __builtin_amdgcn_s_sleep(1);
        if ((++sp & 255u) == 0u) { if (xb_ld(&bar[XB_TMO])) break; if (sp > XB_SPIN_CAP) { atomicAdd(&bar[XB_TMO], 1u); break; } }
    }
    nloc = mine > 0u ? mine : 1u; nx = cnt > 0u ? cnt : 1u;
}

__device__ __forceinline__ void xcd_barrier(const XcdBarrier& b) {
    asm volatile("s_waitcnt vmcnt(0)" ::: "memory");
    __syncthreads();
    if (threadIdx.x == 0) {
        unsigned* bar = b.bar;
        __builtin_amdgcn_s_waitcnt(0);
        unsigned nloc = b.st[0], nx = b.st[1];
        if (nloc == 0u) { xcd_barrier_complete(bar, b.x, nloc, nx); b.st[0] = nloc; b.st[1] = nx; }
        const unsigned old = xb_add(&bar[XB_XSUB(b.x)], 1u);
        const unsigned gen = old / nloc;
        if (old + 1u == (gen + 1u) * nloc) {
            __builtin_amdgcn_fence(__ATOMIC_RELEASE, "agent");
            asm volatile("s_waitcnt vmcnt(0)" ::: "memory");
            const unsigned og = xb_add(&bar[XB_TOP], 1u);
            const unsigned tg = og / nx;
            if (og + 1u == (tg + 1u) * nx) xb_add(&bar[XB_TOPGEN], 1u);
            else XB_SPIN(xb_ld(&bar[XB_TOPGEN]) == tg, bar);
            __builtin_amdgcn_fence(__ATOMIC_ACQUIRE, "agent");
            xb_add(&bar[XB_XGEN(b.x)], 1u);
            asm volatile("s_waitcnt vmcnt(0)" ::: "memory");
        } else {
            XB_SPIN(xb_ld(&bar[XB_XGEN(b.x)]) == gen, bar);
            __builtin_amdgcn_fence(__ATOMIC_ACQUIRE, "agent");
            asm volatile("s_waitcnt vmcnt(0)" ::: "memory");
        }
    }
    __syncthreads();
}


namespace pg8 {
#define PG8_LAS __attribute__((address_space(3)))
typedef unsigned short bf16_t;
typedef short bf16x8 __attribute__((ext_vector_type(8)));
typedef float f32x4 __attribute__((ext_vector_type(4)));
typedef unsigned u32x4 __attribute__((ext_vector_type(4)));
constexpr int BM = 256, BK = 64, HALF = 128, HTB = HALF * BK * 2  , STAGE_BYTES = 8 * HTB, NXCD = 8, WGM = 8;

__host__ __device__ __forceinline__ int lds_byte(int r, int c) { const int st = (r >> 4) * 2 + (c >> 5), rr = r & 15, cc = c & 31, ob = rr * 64 + cc * 2; return st * 1024 + (ob ^ (((ob >> 9) & 1) << 5)); }
__host__ __device__ __forceinline__ void stage_rc(int b, int& R, int& C) { const int st = b / 1024, sb = b % 1024, swz = sb ^ (((sb >> 9) & 1) << 5); R = (st >> 1) * 16 + swz / 64; C = (st & 1) * 32 + (swz % 64) / 2; }
__host__ __device__ __forceinline__ int perm32(int rho) { const int n = rho >> 4, i = rho & 15; return 8 * (i >> 2) + 4 * n + (i & 3); }

struct Unit { int pm, pn, kt0, nkt, smp; };
struct Gemm { const bf16_t* A; const bf16_t* Bt; int M, N, K; };

struct StaticOrder {
    int nM, nN, nwg, G, c;
    __host__ __device__ void init(int M, int N, int G_, int c_) { nM = M / BM; nN = N / BM; nwg = nM * nN; G = G_; c = c_; }
    __host__ __device__ bool next(int i, Unit& u) const {
        const long L = (long)i * G + c; if (L >= nwg) return false;
        int wgid = (int)L; { const int q = nwg / NXCD, r = nwg % NXCD, xcd = wgid % NXCD, off = wgid / NXCD; wgid = (xcd < r ? xcd * (q + 1) : r * (q + 1) + (xcd - r) * q) + off; }
        const int nig = WGM * nN, gid = wgid / nig, fm = gid * WGM, gsz = (nM - fm) < WGM ? (nM - fm) : WGM;
        u.pm = fm + ((wgid % nig) % gsz); u.pn = (wgid % nig) / gsz; return true;
    }
    __device__ __forceinline__ void a_ready(const Unit&) const {}
    __device__ __forceinline__ void done(const Unit&) const {}
};
struct SplitOrder {
    StaticOrder so; int nN, nfull, nsub, G, c, KS, nktf;
    __host__ __device__ void init(int N, int K, int KS_, int G_, int c_) { so.init(16384, N, G_, c_); nN = N / BM; nfull = 64 * nN; KS = KS_; nsub = 4 * nN * KS; G = G_; c = c_; nktf = K / BK; }
    __host__ __device__ bool next(int i, Unit& u) const {
        const long L = (long)i * G + c; if (L >= nfull + nsub) return false;
        if (L < nfull) { so.next(i, u); u.kt0 = 0; u.nkt = nktf; u.smp = 0; }
        else { const int q = (int)(L - nfull), ks = q % KS, uu = q / KS; u.pm = 64 + (uu & 3); u.pn = uu >> 2; u.nkt = nktf / KS; u.kt0 = ks * u.nkt; u.smp = KS > 1 ? ks + 1 : 0; }
        return true;
    }
    __device__ __forceinline__ void a_ready(const Unit&) const {}
    __device__ __forceinline__ void done(const Unit&) const {}
};

__device__ __forceinline__ unsigned cvt_pk_bf16(float lo, float hi) { return ::pk_bf16(lo, hi); }
struct EpiF32 {
    static constexpr bool PERM = false, AFTER_DRAIN = false;
    float* C; float* Csmp; int ldc;
    __device__ __forceinline__ void operator()(const f32x4 (&acc)[2][2][4][2], const Unit& u, int wr, int wc, int fr, int fq) const {
        const int row0 = u.pm * BM + wr * 64 + fr, col0 = u.pn * BM + wc * 32 + 4 * fq;
        if (u.smp) {
            float* base = Csmp + (size_t)(u.smp - 1) * 1024 * ldc;
#pragma unroll
            for (int ai = 0; ai < 2; ++ai)
#pragma unroll
                for (int m = 0; m < 4; ++m) { float* rowp = base + (size_t)(row0 + ai * HALF + m * 16) * ldc + col0;
#pragma unroll
                    for (int bj = 0; bj < 2; ++bj)
#pragma unroll
                        for (int n = 0; n < 2; ++n) *(f32x4*)(rowp + bj * HALF + n * 16) = acc[ai][bj][m][n]; }
            return;
        }
#pragma unroll
        for (int ai = 0; ai < 2; ++ai)
#pragma unroll
            for (int m = 0; m < 4; ++m) { float* rowp = C + (size_t)(row0 + ai * HALF + m * 16) * ldc + col0;
#pragma unroll
                for (int bj = 0; bj < 2; ++bj)
#pragma unroll
                    for (int n = 0; n < 2; ++n) *(f32x4*)(rowp + bj * HALF + n * 16) = acc[ai][bj][m][n]; }
    }
};
template <int ACT  > struct EpiBf16 {
    static constexpr bool PERM = true, AFTER_DRAIN = false;
    bf16_t* O; int ldc;
    __device__ __forceinline__ void operator()(const f32x4 (&acc)[2][2][4][2], const Unit& u, int wr, int wc, int fr, int fq) const {
        const int row0 = u.pm * BM + wr * 64 + fr; const int col0 = u.pn * BM + wc * 32 + 8 * fq;
#pragma unroll
        for (int ai = 0; ai < 2; ++ai)
#pragma unroll
            for (int m = 0; m < 4; ++m) { bf16_t* rowp = O + (size_t)(row0 + ai * HALF + m * 16) * ldc + col0;
#pragma unroll
                for (int bj = 0; bj < 2; ++bj) { f32x4 v0 = acc[ai][bj][m][0], v1 = acc[ai][bj][m][1];
                    if (ACT == 1) {
#pragma unroll
                        for (int j = 0; j < 4; ++j) { const float a = fmaxf(v0[j], 0.f), b = fmaxf(v1[j], 0.f); v0[j] = a * a; v1[j] = b * b; } }
                    u32x4 w; w.x = cvt_pk_bf16(v0[0], v0[1]); w.y = cvt_pk_bf16(v0[2], v0[3]); w.z = cvt_pk_bf16(v1[0], v1[1]); w.w = cvt_pk_bf16(v1[2], v1[3]);
                    *(u32x4*)(rowp + bj * HALF) = w; } }
    }
};
template <class Epi, class Sched, bool STAMP = false>
__device__ __forceinline__ void gemm_phase(PG8_LAS unsigned char* lds, const Gemm g, const Sched& S, const Epi& E, unsigned long long* stamps) {
    const int tid = threadIdx.x, wid = __builtin_amdgcn_readfirstlane(tid >> 6), lane = tid & 63, wr = wid >> 2, wc = wid & 3, fr = lane & 15, fq = lane >> 4;
    const int K = g.K;
    int ts_lo = 0, ts_hi = 0, nts = 0; const unsigned long long rt_entry = STAMP ? (unsigned long long)wall_clock64() : 0ull;
#define PG8_STAMP() do { if (STAMP && wid == 0 && nts < 64) { const unsigned long long _c = (unsigned long long)clock64(); \
        ts_lo = (lane == nts) ? (int)(unsigned)_c : ts_lo; ts_hi = (lane == nts) ? (int)(unsigned)(_c >> 32) : ts_hi; ++nts; } } while (0)
    PG8_STAMP();
    unsigned voffA[2], voffB[2];
#pragma unroll
    for (int i = 0; i < 2; ++i) { int R, C; stage_rc(tid * 16 + i * 8192, R, C); const int Rb = Epi::PERM ? ((R & ~31) + perm32(R & 31)) : R;
        voffA[i] = (unsigned)(R * K + C) * 2u; voffB[i] = (unsigned)(Rb * K + C) * 2u; }
    const size_t kstep = (size_t)(BK * 2);
    const size_t hstep = (size_t)HALF * K * 2;
    const size_t tstep = 2 * hstep;
    const unsigned ldsw = (unsigned)wid * 1024u;
    const int aoff = lds_byte(wr * 64 + fr, fq * 8), boff = lds_byte(wc * 32 + fr, fq * 8);
#define PG8_SA(b, h) (((b) * 2 + (h)) * HTB)
#define PG8_SB(b, h) ((4 + (b) * 2 + (h)) * HTB)
#define PG8_STAGE(bufoff, gbase, voff) do { _Pragma("unroll") for (int _i = 0; _i < 2; ++_i) \
        __builtin_amdgcn_global_load_lds((const unsigned*)((const char*)(gbase) + (voff)[_i]), (PG8_LAS unsigned*)(lds + (bufoff) + ldsw + _i * 8192), 16, 0, 0); } while (0)
#define PG8_LDA(dst, b, h) do { _Pragma("unroll") for (int m = 0; m < 4; ++m) _Pragma("unroll") for (int k = 0; k < 2; ++k) dst[m][k] = *(const PG8_LAS bf16x8*)(lds + PG8_SA(b, h) + aoff + m * 2048 + k * 1024); } while (0)
#define PG8_LDB(dst, b, h) do { _Pragma("unroll") for (int n = 0; n < 2; ++n) _Pragma("unroll") for (int k = 0; k < 2; ++k) dst[n][k] = *(const PG8_LAS bf16x8*)(lds + PG8_SB(b, h) + boff + n * 2048 + k * 1024); } while (0)
#define PG8_MMA(ai, bj, At, Bt) do { __builtin_amdgcn_s_setprio(1); _Pragma("unroll") for (int m = 0; m < 4; ++m) _Pragma("unroll") for (int n = 0; n < 2; ++n) _Pragma("unroll") for (int k = 0; k < 2; ++k) \
        acc[ai][bj][m][n] = __builtin_amdgcn_mfma_f32_16x16x32_bf16(Bt[n][k], At[m][k], acc[ai][bj][m][n], 0, 0, 0); __builtin_amdgcn_s_setprio(0); } while (0)
#define PG8_WAIT_V(n) asm volatile("s_waitcnt vmcnt(" #n ")" ::: "memory")
#define PG8_WAIT_L(n) asm volatile("s_waitcnt lgkmcnt(" #n ")" ::: "memory")
#define PG8_BAR __builtin_amdgcn_s_barrier()
#define PG8_SCHED __builtin_amdgcn_sched_barrier(0)
    Unit cur, nxt; int ui = 0;
    if (!S.next(0, cur)) return;
    f32x4 acc[2][2][4][2];
#pragma unroll
    for (int a = 0; a < 2; ++a)
#pragma unroll
        for (int b = 0; b < 2; ++b)
#pragma unroll
            for (int m = 0; m < 4; ++m)
#pragma unroll
                for (int n = 0; n < 2; ++n) acc[a][b][m][n] = (f32x4){0.f, 0.f, 0.f, 0.f};
    bf16x8 At[4][2], B0[2][2], B1[2][2];
    const char* cA = (const char*)g.A + (size_t)cur.pm * tstep + (size_t)cur.kt0 * kstep; const char* cB = (const char*)g.Bt + (size_t)cur.pn * tstep + (size_t)cur.kt0 * kstep;
    S.a_ready(cur);
    PG8_STAGE(PG8_SB(0, 0), cB, voffB); PG8_STAGE(PG8_SA(0, 0), cA, voffA); PG8_STAGE(PG8_SB(0, 1), cB + hstep, voffB); PG8_STAGE(PG8_SA(0, 1), cA + hstep, voffA);
    if (wr == 1) PG8_BAR;
    PG8_WAIT_V(4); PG8_BAR;
    PG8_STAGE(PG8_SB(1, 0), cB + kstep, voffB); PG8_STAGE(PG8_SA(1, 0), cA + kstep, voffA); PG8_STAGE(PG8_SB(1, 1), cB + hstep + kstep, voffB);
    PG8_WAIT_V(6); PG8_BAR;
    PG8_STAMP();
    for (;;) {
        const bool has_next = S.next(ui + 1, nxt);
        const char* nA = has_next ? (const char*)g.A + (size_t)nxt.pm * tstep + (size_t)nxt.kt0 * kstep : cA; const char* nB = has_next ? (const char*)g.Bt + (size_t)nxt.pn * tstep + (size_t)nxt.kt0 * kstep : cB;
        const int nt = cur.nkt;
        for (int t = 0; t < nt; t += 2) {
            const bool last = (t == nt - 2);
            const char* a1 = cA + (size_t)(t + 1) * kstep;
            const char* a2 = last ? nA : cA + (size_t)(t + 2) * kstep; const char* b2 = last ? nB : cB + (size_t)(t + 2) * kstep;
            const char* a3 = a2 + kstep; const char* b3 = b2 + kstep;
            if (last && has_next) S.a_ready(nxt);
            PG8_LDB(B0, 0, 0); PG8_SCHED; PG8_LDA(At, 0, 0); PG8_STAGE(PG8_SA(1, 1), a1 + hstep, voffA);
            PG8_WAIT_L(8); PG8_BAR; PG8_WAIT_L(0); PG8_MMA(0, 0, At, B0); PG8_BAR; PG8_SCHED;
            PG8_LDB(B1, 0, 1); PG8_STAGE(PG8_SB(0, 0), b2, voffB);
            PG8_BAR; PG8_WAIT_L(0); PG8_MMA(0, 1, At, B1); PG8_BAR;
            PG8_LDA(At, 0, 1); PG8_STAGE(PG8_SA(0, 0), a2, voffA);
            PG8_BAR; PG8_WAIT_L(0); PG8_MMA(1, 0, At, B0); PG8_BAR; PG8_SCHED;
            PG8_STAGE(PG8_SB(0, 1), b2 + hstep, voffB);
            PG8_WAIT_V(6); PG8_BAR; PG8_MMA(1, 1, At, B1); PG8_BAR;
            PG8_LDB(B0, 1, 0); PG8_SCHED; PG8_LDA(At, 1, 0); PG8_STAGE(PG8_SA(0, 1), a2 + hstep, voffA);
            PG8_WAIT_L(8); PG8_BAR; PG8_WAIT_L(0); PG8_MMA(0, 0, At, B0); PG8_BAR; PG8_SCHED;
            PG8_LDB(B1, 1, 1); PG8_STAGE(PG8_SB(1, 0), b3, voffB);
            PG8_BAR; PG8_WAIT_L(0); PG8_MMA(0, 1, At, B1); PG8_BAR;
            PG8_LDA(At, 1, 1); PG8_STAGE(PG8_SA(1, 0), a3, voffA);
            PG8_BAR; PG8_WAIT_L(0); PG8_MMA(1, 0, At, B0); PG8_BAR; PG8_SCHED;
            PG8_STAGE(PG8_SB(1, 1), b3 + hstep, voffB);
            PG8_WAIT_V(6); PG8_BAR; PG8_MMA(1, 1, At, B1); PG8_BAR;
        }
        PG8_STAMP();
        if constexpr (!Epi::AFTER_DRAIN) { E(acc, cur, wr, wc, fr, fq); S.done(cur); }
        PG8_STAMP();
        if (!has_next) break;
#pragma unroll
        for (int a = 0; a < 2; ++a)
#pragma unroll
            for (int b = 0; b < 2; ++b)
#pragma unroll
                for (int m = 0; m < 4; ++m)
#pragma unroll
                    for (int n = 0; n < 2; ++n) acc[a][b][m][n] = (f32x4){0.f, 0.f, 0.f, 0.f};
        cur = nxt; cA = nA; cB = nB; ++ui;
    }
    PG8_WAIT_V(0);
    if (wr == 0) PG8_BAR;
    PG8_BAR;
    if constexpr (Epi::AFTER_DRAIN) { E.fused(acc, cur, wr, wc, fr, fq, lds, wid, lane); S.done(cur); }
    PG8_STAMP();
    if (STAMP && wid == 0) { stamps[lane] = lane < nts ? (((unsigned long long)(unsigned)ts_hi << 32) | (unsigned)ts_lo) : 0ull;
        if (lane == 62) stamps[62] = rt_entry; if (lane == 63) stamps[63] = (unsigned long long)wall_clock64(); }
#undef PG8_STAMP
#undef PG8_SA
#undef PG8_SB
#undef PG8_STAGE
#undef PG8_LDA
#undef PG8_LDB
#undef PG8_MMA
#undef PG8_WAIT_V
#undef PG8_WAIT_L
#undef PG8_BAR
#undef PG8_SCHED
}
}

__device__ __forceinline__ void phaseA_weights(const Params& p, float* tl  , int tile0, int tile1, int step) {
    const int tid = threadIdx.x;
    for (int tile = tile0; tile < tile1; tile += step) {
        const float* src; bf16_t* dst; int ldn, K, lt;
        if (tile < 1024)      { src = p.w_in;   ldn = INW;  K = 1024; dst = (bf16_t*)(p.ws + W_WIN);  lt = tile; }
        else if (tile < 1280) { src = p.w_out;  ldn = 1024; K = 1024; dst = (bf16_t*)(p.ws + W_WOUT); lt = tile - 1024; }
        else if (tile < 2304) { src = p.w_up;   ldn = 4096; K = 1024; dst = (bf16_t*)(p.ws + W_WUP);  lt = tile - 1280; }
        else                  { src = p.w_down; ldn = 1024; K = 4096; dst = (bf16_t*)(p.ws + W_WDN);  lt = tile - 2304; }
        const int nkt = K >> 6, kt = lt % nkt, nt = lt / nkt;
#pragma unroll
        for (int i = 0; i < 2; ++i) {
            const int r = (tid >> 4) + 32 * i, c4 = (tid & 15) * 4;
            const float4 v = *(const float4*)(src + (size_t)(kt * 64 + r) * ldn + nt * 64 + c4);
            tl[r * 65 + c4 + 0] = v.x; tl[r * 65 + c4 + 1] = v.y; tl[r * 65 + c4 + 2] = v.z; tl[r * 65 + c4 + 3] = v.w;
        }
        __syncthreads();
        {
            const int n = tid >> 3, k8 = (tid & 7) * 8;
            float v[8];
#pragma unroll
            for (int j = 0; j < 8; ++j) v[j] = tl[(k8 + j) * 65 + n];
            u32x4 w; w.x = pk_bf16(v[0], v[1]); w.y = pk_bf16(v[2], v[3]); w.z = pk_bf16(v[4], v[5]); w.w = pk_bf16(v[6], v[7]);
            *(u32x4*)(dst + (size_t)(nt * 64 + n) * K + kt * 64 + k8) = w;
        }
        __syncthreads();
    }
}

__device__ __forceinline__ void phaseA_rope(const Params& p) {
    float2* tab = (float2*)(p.ws + W_ROPE);
    for (int idx = blockIdx.x * 512 + threadIdx.x; idx < 2056 * 64; idx += gridDim.x * 512) {
        const int pi = idx >> 6, f = idx & 63;
        double ivd = 1.0; for (int k = 0; k < f; ++k) ivd *= p.rope_r;
        const float ivf = (float)ivd;
        const float pos = pi < 2048 ? (float)pi : (float)(16384 + pi - 2048);
        const float ang = pos * ivf;
        const double a = (double)ang, q = rint(a * 0.63661977236758134308);
        double r = fma(-q, 1.57079632679489655800, a); r = fma(-q, 6.12323399573676603587e-17, r);
        const int qd = ((int)q) & 3;
        const double r2 = r * r;
        const double s = r * (1.0 + r2 * (-1.0 / 6.0 + r2 * (1.0 / 120.0 + r2 * (-1.0 / 5040.0 + r2 * (1.0 / 362880.0 + r2 * (-1.0 / 39916800.0 + r2 * (1.0 / 6227020800.0)))))));
        const double c = 1.0 + r2 * (-0.5 + r2 * (1.0 / 24.0 + r2 * (-1.0 / 720.0 + r2 * (1.0 / 40320.0 + r2 * (-1.0 / 3628800.0 + r2 * (1.0 / 479001600.0 + r2 * (-1.0 / 87178291200.0)))))));
        double co, si;
        if (qd == 0) { co = c; si = s; } else if (qd == 1) { co = -s; si = c; } else if (qd == 2) { co = -c; si = -s; } else { co = s; si = -c; }
        tab[idx] = make_float2((float)co, (float)si);
    }
}

__device__ __forceinline__ void phaseA_norm(const Params& p, float* wab  ) {
    const int tid = threadIdx.x, wave = tid >> 6, lane = tid & 63;
    for (int i = tid; i < 8192; i += 512) { const int k = i >> 3, j = i & 7; wab[j * 1024 + k] = p.w_in[(size_t)k * INW + 4096 + j]; }
    __syncthreads();
    bf16_t* hbuf = (bf16_t*)(p.ws + W_H); float* ab = (float*)(p.ws + W_AB);
    float4 wv[4];
#pragma unroll
    for (int i = 0; i < 4; ++i) wv[i] = *(const float4*)(p.pre_mix_w + lane * 4 + 256 * i);
    float bias = 0.f, alog = 0.f; if (lane < 4) { bias = p.dt_bias[lane]; alog = p.A_log[lane]; }
    const int stride = gridDim.x * 8;
    int row = blockIdx.x * 8 + wave;
    float4 v[4];
    if (row < TT) { const float* xr = row < TP ? p.x_prompt + (size_t)row * DM : p.x_sample + (size_t)(row - TP) * DM;
#pragma unroll
        for (int i = 0; i < 4; ++i) v[i] = *(const float4*)(xr + lane * 4 + 256 * i); }
    while (row < TT) {
        const int nrow = row + stride;
        float4 vn[4];
        if (nrow < TT) { const float* xr = nrow < TP ? p.x_prompt + (size_t)nrow * DM : p.x_sample + (size_t)(nrow - TP) * DM;
#pragma unroll
            for (int i = 0; i < 4; ++i) vn[i] = *(const float4*)(xr + lane * 4 + 256 * i); }
        float ss = 0.f;
#pragma unroll
        for (int i = 0; i < 4; ++i) ss += v[i].x * v[i].x + v[i].y * v[i].y + v[i].z * v[i].z + v[i].w * v[i].w;
        ss = wave_sum(ss);
        const float rs = rsqrtf(ss * (1.0f / 1024.0f) + 1e-6f);
        float acc[8];
#pragma unroll
        for (int j = 0; j < 8; ++j) acc[j] = 0.f;
#pragma unroll
        for (int i = 0; i < 4; ++i) {
            const float4 w = wv[i];
            const float h0 = v[i].x * rs * w.x, h1 = v[i].y * rs * w.y, h2 = v[i].z * rs * w.z, h3 = v[i].w * rs * w.w;
            u32x2 o; o.x = pk_bf16(h0, h1); o.y = pk_bf16(h2, h3);
            *(u32x2*)(hbuf + (size_t)row * DM + lane * 4 + 256 * i) = o;
#pragma unroll
            for (int j = 0; j < 8; ++j) { const float4 wj = *(const float4*)(wab + j * 1024 + lane * 4 + 256 * i); acc[j] += h0 * wj.x + h1 * wj.y + h2 * wj.z + h3 * wj.w; }
        }
#pragma unroll
        for (int j = 0; j < 8; ++j) acc[j] = wave_sum(acc[j]);
        if (lane < 8) {
            float a = acc[0];
#pragma unroll
            for (int j = 1; j < 8; ++j) a = (lane == j) ? acc[j] : a;
            float o;
            if (lane < 4) { const float xx = a + bias; const float sp = xx > 20.f ? xx : log1pf(expf(xx)); o = -expf(alog) * sp; }
            else o = 1.0f / (1.0f + expf(-a));
            ab[(size_t)row * 8 + lane] = o;
        }
#pragma unroll
        for (int i = 0; i < 4; ++i) v[i] = vn[i];
        row = nrow;
    }
}

DI void ld_row4(float4 (&v)[4], const float* rp, int lane) {
#pragma unroll
    for (int i = 0; i < 4; ++i) v[i] = *(const float4*)(rp + lane * 4 + 256 * i);
}
DI void add_row4(float4 (&v)[4], const float* rp, int lane) {
#pragma unroll
    for (int i = 0; i < 4; ++i) { const float4 t = *(const float4*)(rp + lane * 4 + 256 * i); v[i].x += t.x; v[i].y += t.y; v[i].z += t.z; v[i].w += t.w; }
}
DI float ssq4(const float4 (&v)[4]) { float s = 0.f;
#pragma unroll
    for (int i = 0; i < 4; ++i) s += v[i].x * v[i].x + v[i].y * v[i].y + v[i].z * v[i].z + v[i].w * v[i].w;
    return s; }
__device__ __forceinline__ void phaseE_rows(const Params& p) {
    const int tid = threadIdx.x, wave = tid >> 6, lane = tid & 63;
    const float* mbuf = (const float*)(p.ws + W_PROJ); bf16_t* hbuf = (bf16_t*)(p.ws + W_H); const float* part = (const float*)(p.ws + W_SMP);
    float4 w1[4], w2[4]; ld_row4(w1, p.post_mix_w, lane); ld_row4(w2, p.pre_mlp_w, lane);
    const int stride = gridDim.x * 8;
    int row = blockIdx.x * 8 + wave;
    float4 m[4], x[4];
    if (row < TT) { ld_row4(x, row < TP ? p.x_prompt + (size_t)row * DM : p.x_sample + (size_t)(row - TP) * DM, lane);
        if (row < TP) ld_row4(m, mbuf + (size_t)row * DM, lane); else { ld_row4(m, part + (size_t)(row - TP) * DM, lane); add_row4(m, part + 1048576 + (size_t)(row - TP) * DM, lane); } }
    while (row < TT) {
        const int nrow = row + stride;
        float4 mn[4], xn[4];
        if (nrow < TT) { ld_row4(xn, nrow < TP ? p.x_prompt + (size_t)nrow * DM : p.x_sample + (size_t)(nrow - TP) * DM, lane);
            if (nrow < TP) ld_row4(mn, mbuf + (size_t)nrow * DM, lane); else { ld_row4(mn, part + (size_t)(nrow - TP) * DM, lane); add_row4(mn, part + 1048576 + (size_t)(nrow - TP) * DM, lane); } }
        const float rs = rsqrtf(wave_sum(ssq4(m)) * (1.0f / 1024.0f) + 1e-6f);
        float* yr = p.out + (size_t)row * DM;
#pragma unroll
        for (int i = 0; i < 4; ++i) { x[i].x += m[i].x * rs * w1[i].x; x[i].y += m[i].y * rs * w1[i].y; x[i].z += m[i].z * rs * w1[i].z; x[i].w += m[i].w * rs * w1[i].w;
            *(float4*)(yr + lane * 4 + 256 * i) = x[i]; }
        const float rs2 = rsqrtf(wave_sum(ssq4(x)) * (1.0f / 1024.0f) + 1e-6f);
#pragma unroll
        for (int i = 0; i < 4; ++i) { u32x2 o; o.x = pk_bf16(x[i].x * rs2 * w2[i].x, x[i].y * rs2 * w2[i].y); o.y = pk_bf16(x[i].z * rs2 * w2[i].z, x[i].w * rs2 * w2[i].w);
            *(u32x2*)(hbuf + (size_t)row * DM + lane * 4 + 256 * i) = o; }
#pragma unroll
        for (int i = 0; i < 4; ++i) { m[i] = mn[i]; x[i] = xn[i]; }
        row = nrow;
    }
}
__device__ __forceinline__ void phaseH_rows(const Params& p) {
    const int tid = threadIdx.x, wave = tid >> 6, lane = tid & 63;
    const float* fbuf = (const float*)(p.ws + W_H); const float* part = (const float*)(p.ws + W_SMP);
    float4 w1[4]; ld_row4(w1, p.post_mlp_w, lane);
    const int stride = gridDim.x * 8;
    int row = blockIdx.x * 8 + wave;
    float4 f[4], x[4];
    auto ldf = [&](float4 (&d)[4], int r) { if (r < TP) ld_row4(d, fbuf + (size_t)r * DM, lane); else { const float* q = part + (size_t)(r - TP) * DM; ld_row4(d, q, lane); add_row4(d, q + 1048576, lane); add_row4(d, q + 2 * 1048576, lane); add_row4(d, q + 3 * 1048576, lane); } };
    if (row < TT) { ld_row4(x, p.out + (size_t)row * DM, lane); ldf(f, row); }
    while (row < TT) {
        const int nrow = row + stride;
        float4 fn[4], xn[4];
        if (nrow < TT) { ld_row4(xn, p.out + (size_t)nrow * DM, lane); ldf(fn, nrow); }
        const float rs = rsqrtf(wave_sum(ssq4(f)) * (1.0f / 1024.0f) + 1e-6f);
        float* yr = p.out + (size_t)row * DM;
#pragma unroll
        for (int i = 0; i < 4; ++i) { x[i].x += f[i].x * rs * w1[i].x; x[i].y += f[i].y * rs * w1[i].y; x[i].z += f[i].z * rs * w1[i].z; x[i].w += f[i].w * rs * w1[i].w;
            *(float4*)(yr + lane * 4 + 256 * i) = x[i]; }
#pragma unroll
        for (int i = 0; i < 4; ++i) { f[i] = fn[i]; x[i] = xn[i]; }
        row = nrow;
    }
}

__device__ __forceinline__ void phaseC1_gdn_prep(const Params& p, unsigned char* lds, int first, int step) {
    const int tid = threadIdx.x, w = tid >> 6, lane = tid & 63, r = lane & 31, hh = lane >> 5;
    float* qc = (float*)lds; float* kc = qc + 64 * 129; float* vc = kc + 64 * 129;
    unsigned char* knb = lds + 99072; unsigned char* qnb = lds + 116480;
    float* Amat = (float*)(lds + 133888); float* cum = (float*)(lds + 150528); float* beta = cum + 64; float* rnq = cum + 128; float* rnk = cum + 192; float* fack = cum + 256;
    bf16_t* stg = (bf16_t*)(lds + 99072);
    const bf16_t* proj = (const bf16_t*)(p.ws + W_PROJ); const float* ab = (const float*)(p.ws + W_AB);
    for (int item = first; item < 1536; item += step) {
        const bool sample = item >= 1024;
        int b, n, h, row0, nrows, slot;
        if (!sample) { b = item >> 7; n = (item >> 2) & 31; h = item & 3; row0 = b * 2048 + n * 64; nrows = 64; slot = (b * 4 + h) * 32 + n; }
        else { const int s = item - 1024; b = s >> 2; n = 0; h = s & 3; row0 = TP + b * 8; nrows = 8; slot = s; }
        unsigned char* sbase = sample ? (unsigned char*)(p.out + O_GS) + (size_t)slot * 65536 : (unsigned char*)(p.out + O_YP) + (size_t)slot * 65536;
        bf16_t* sc_out = (bf16_t*)(p.ws + (sample ? W_SCS : W_SCP)) + (size_t)slot * 4096;
        float* dec_out = (float*)(p.ws + W_DEC) + (sample ? 1024 + slot : slot);
        float c0 = 0.f, c1 = 0.f, c2 = 0.f, c3 = 0.f, xm3 = 0.f, xm2 = 0.f, xm1 = 0.f, g_in = 0.f, be_in = 0.f;
        if (tid < 384) {
            const int seg = tid >> 7, d = tid & 127, ch = seg * 512 + h * 128 + d;
            c0 = p.conv_w[ch]; c1 = p.conv_w[1536 + ch]; c2 = p.conv_w[3072 + ch]; c3 = p.conv_w[4608 + ch];
            const bf16_t* src = proj + (size_t)row0 * NPJ + 2048 + ch;
            if (sample) { const float* sc = p.state_conv + (size_t)b * 3 * 1536 + ch; xm3 = sc[0]; xm2 = sc[1536]; xm1 = sc[3072]; }
            else if (n > 0) { xm3 = bf2f(*(src - 3 * NPJ)); xm2 = bf2f(*(src - 2 * NPJ)); xm1 = bf2f(*(src - NPJ)); }
        } else if (tid < 448) {
            const int i = tid - 384;
            if (i < nrows) { g_in = ab[(size_t)(row0 + i) * 8 + h]; be_in = ab[(size_t)(row0 + i) * 8 + 4 + h]; }
        }
        {
            const int nld = nrows * 48;
            for (int idx = tid; idx < nld; idx += 512) {
                const int row = idx / 48, rem = idx - row * 48, seg = rem >> 4, pc = rem & 15;
                *(u32x4*)(stg + row * 384 + seg * 128 + pc * 8) = *(const u32x4*)(proj + (size_t)(row0 + row) * NPJ + 2048 + seg * 512 + h * 128 + pc * 8);
            }
        }
        __syncthreads();
        if (tid < 384) {
            const int seg = tid >> 7, d = tid & 127, ch = seg * 512 + h * 128 + d;
            float* dst = qc + seg * (64 * 129) + d;
#pragma unroll 8
            for (int i = 0; i < nrows; ++i) {
                const float x = bf2f(stg[i * 384 + tid]);
                float cv = c0 * xm3; cv += c1 * xm2; cv += c2 * xm1; cv += c3 * x;
                dst[i * 129] = silu(cv);
                xm3 = xm2; xm2 = xm1; xm1 = x;
            }
            for (int i = nrows; i < 64; ++i) dst[i * 129] = 0.f;
            if (sample) { float* co = p.out + O_CS + (size_t)b * 3 * 1536 + ch; co[0] = xm3; co[1536] = xm2; co[3072] = xm1; }
            else if (n == 31) { float* co = p.out + O_CP + (size_t)b * 3 * 1536 + ch; co[0] = xm3; co[1536] = xm2; co[3072] = xm1; }
        } else if (tid < 448) {
            const int i = tid - 384;
            float g = g_in; const float be = be_in;
#pragma unroll
            for (int o = 1; o < 64; o <<= 1) { const float t = __shfl_up(g, o); if (i >= o) g += t; }
            cum[i] = g; beta[i] = be;
        }
        __syncthreads();
        if (tid < 128) {
            const int which = tid >> 6, row = tid & 63; const float* bp = (which ? kc : qc) + row * 129;
            float ss = 0.f;
#pragma unroll 16
            for (int d = 0; d < 128; ++d) ss += bp[d] * bp[d];
            float rn = rsqrtf(ss + 1e-6f);
            if (!which) rnq[row] = rn * 0.08838834764831845f; else { rnk[row] = rn; fack[row] = rn * beta[row] * __expf(cum[row]); }
        }
        __syncthreads();
#pragma unroll
        for (int it = 0; it < 4; ++it) {
            const int idx = tid + 512 * it, img = idx >> 10, rem = idx & 1023, row = rem >> 4, chunk = rem & 15;
            const float* sp = (img ? kc : qc) + row * 129 + chunk * 8; const float rn = img ? rnk[row] : rnq[row];
            u32x4 o; o.x = pk_bf16(sp[0] * rn, sp[1] * rn); o.y = pk_bf16(sp[2] * rn, sp[3] * rn); o.z = pk_bf16(sp[4] * rn, sp[5] * rn); o.w = pk_bf16(sp[6] * rn, sp[7] * rn);
            *(u32x4*)((img ? knb : qnb) + sw256(row, chunk)) = o;
        }
        __syncthreads();
        {
            const int isq = w >> 2, it_ = (w >> 1) & 1, jt = w & 1;
            f32x16 acc;
#pragma unroll
            for (int i = 0; i < 16; ++i) acc[i] = 0.f;
            const unsigned char* ai = isq ? qnb : knb;
#pragma unroll
            for (int s = 0; s < 8; ++s) {
                const bf16x8 a = *(const bf16x8*)(ai + sw256(it_ * 32 + r, 2 * s + hh));
                const bf16x8 bb = *(const bf16x8*)(knb + sw256(jt * 32 + r, 2 * s + hh));
                acc = MFMA32(a, bb, acc);
            }
            const int j = jt * 32 + r; const float cj = cum[j];
#pragma unroll
            for (int reg = 0; reg < 16; ++reg) {
                const int i = it_ * 32 + crow(reg, hh);
                const float dm = __expf(fminf(cum[i] - cj, 0.f)), dm2 = __expf(fminf(cj - cum[i], 0.f));
                if (!isq) Amat[i * 64 + j] = (i < j) ? beta[j] * acc[reg] * dm2 : 0.f;
                else sc_out[i * 64 + j] = f2bf((j <= i) ? acc[reg] * dm : 0.f);
            }
        }
        __syncthreads();
        {
#pragma unroll
            for (int it = 0; it < 2; ++it) {
                const int idx = tid + 512 * it, row = idx >> 4, chunk = idx & 15;
                const float e = __expf(cum[row]) * rnq[row]; const float* sp = qc + row * 129 + chunk * 8;
                u32x4 o; o.x = pk_bf16(sp[0] * e, sp[1] * e); o.y = pk_bf16(sp[2] * e, sp[3] * e); o.z = pk_bf16(sp[4] * e, sp[5] * e); o.w = pk_bf16(sp[6] * e, sp[7] * e);
                *(u32x4*)(sbase + 16384 + row * 256 + chunk * 16) = o;
            }
            const int d = tid & 127, cq = tid >> 7; const float cl = cum[63];
            u32x4* o = (u32x4*)(sbase + 49152 + (size_t)d * 128 + cq * 32);
#pragma unroll
            for (int c8 = 0; c8 < 2; ++c8) {
                float v[8];
#pragma unroll
                for (int j = 0; j < 8; ++j) { const int c = cq * 16 + c8 * 8 + j; v[j] = kc[c * 129 + d] * rnk[c] * __expf(cl - cum[c]); }
                u32x4 q; q.x = pk_bf16(v[0], v[1]); q.y = pk_bf16(v[2], v[3]); q.z = pk_bf16(v[4], v[5]); q.w = pk_bf16(v[6], v[7]); o[c8] = q;
            }
            if (tid == 0) *dec_out = __expf(cl);
        }
        __syncthreads();
        if (tid < 256) {
            int vz; asm volatile("v_mov_b32 %0, 0" : "=v"(vz));
            const float* At = Amat + vz;
            float* colp = (tid < 128) ? (kc + tid) : (vc + tid - 128);
            const float* facp = ((tid < 128) ? fack : beta) + vz;
            const int nblk = nrows == 64 ? 4 : 1;
            for (int bi = 0; bi < nblk; ++bi) {
                const int R0 = bi * 16;
                float acc[16];
#pragma unroll
                for (int ii = 0; ii < 16; ++ii) acc[ii] = colp[(R0 + ii) * 129] * facp[R0 + ii];
#pragma unroll 4
                for (int j = 0; j < R0; ++j) {
                    const float xj = colp[j * 129];
                    const f32x4 a0 = *(const f32x4*)(At + j * 64 + R0), a1 = *(const f32x4*)(At + j * 64 + R0 + 4), a2 = *(const f32x4*)(At + j * 64 + R0 + 8), a3 = *(const f32x4*)(At + j * 64 + R0 + 12);
#pragma unroll
                    for (int q = 0; q < 4; ++q) { acc[q] -= a0[q] * xj; acc[4 + q] -= a1[q] * xj; acc[8 + q] -= a2[q] * xj; acc[12 + q] -= a3[q] * xj; }
                }
#pragma unroll
                for (int jj = 0; jj < 15; ++jj) {
                    const float* ar = At + (R0 + jj) * 64 + R0;
#pragma unroll
                    for (int ii = jj + 1; ii < 16; ++ii) acc[ii] -= ar[ii] * acc[jj];
                }
#pragma unroll
                for (int ii = 0; ii < 16; ++ii) colp[(R0 + ii) * 129] = acc[ii];
            }
            if (tid < 128) {
                bf16_t* o = (bf16_t*)sbase + tid;
#pragma unroll 8
                for (int i = 0; i < 64; ++i) o[i * 128] = f2bf(-colp[i * 129]);
            } else {
                u32x4* o = (u32x4*)(sbase + 32768 + (size_t)(tid - 128) * 128);
#pragma unroll
                for (int c8 = 0; c8 < 8; ++c8) { float x[8];
#pragma unroll
                    for (int j = 0; j < 8; ++j) x[j] = colp[(c8 * 8 + j) * 129];
                    u32x4 v; v.x = pk_bf16(x[0], x[1]); v.y = pk_bf16(x[2], x[3]); v.z = pk_bf16(x[4], x[5]); v.w = pk_bf16(x[6], x[7]); o[c8] = v; }
            }
        }
        __syncthreads();
    }
}

template <bool GDN> __device__ __forceinline__ void scan_item(const Params& p, unsigned char* lds, int b, int h, bool sample, int* prog = nullptr) {
    const int tid = threadIdx.x, w = tid >> 6, lane = tid & 63, r = lane & 31, hh = lane >> 5;
    const int ct = w >> 2, et = w & 3;
    unsigned char* St = lds; unsigned char* INA = lds + 34816; unsigned char* INQ = lds + 52224; unsigned char* INKT = lds + 69632;
    unsigned char* INSC = lds + 88064; unsigned char* VNT = lds + 97280; float* SSQ = (float*)(lds + 115712);
    const int nchunks = sample ? 1 : 32, nrows = sample ? 8 : 64;
    const int row_base = sample ? TP + b * 8 : b * 2048;
    const bf16_t* proj = (const bf16_t*)(p.ws + W_PROJ);
    bf16_t* mix = (bf16_t*)(p.ws + W_MIX);
    const float* nw = GDN ? p.gdn_norm_w : p.ret_norm_w;
    const int gate_col = GDN ? 3584 + h * 128 : 1536 + h * 128;
    const int mix_col = (GDN ? 512 : 0) + h * 128;
    const float2* rtab = (const float2*)(p.ws + W_ROPE);
    const float lg2 = log2f(1.0f - exp2f(-5.0f - (float)h));
    f32x16 S0, S1;
    const int e_col = et * 32 + r;
    if (sample) {
        const float* s0 = (GDN ? p.state_gdn : p.state_ret) + (size_t)(b * 4 + h) * 16384 + ((2 * ct) * 32 + 4 * hh) * 128 + e_col;
#pragma unroll
        for (int reg = 0; reg < 16; ++reg) { S0[reg] = s0[((reg & 3) + 8 * (reg >> 2)) * 128]; S1[reg] = s0[((reg & 3) + 8 * (reg >> 2) + 32) * 128]; }
    } else {
#pragma unroll
        for (int reg = 0; reg < 16; ++reg) { S0[reg] = 0.f; S1[reg] = 0.f; }
    }
    auto write_St = [&]() {
#pragma unroll
        for (int g = 0; g < 4; ++g) {
            u32x2 v0, v1; v0.x = pk_bf16(S0[4 * g], S0[4 * g + 1]); v0.y = pk_bf16(S0[4 * g + 2], S0[4 * g + 3]); v1.x = pk_bf16(S1[4 * g], S1[4 * g + 1]); v1.y = pk_bf16(S1[4 * g + 2], S1[4 * g + 3]);
            *(u32x2*)(St + sw256(e_col, (2 * ct) * 4 + g) + 8 * hh) = v0;
            *(u32x2*)(St + sw256(e_col, (2 * ct + 1) * 4 + g) + 8 * hh) = v1;
        }
    };
    unsigned char* OST = lds + 117248;
    float* NW = (float*)(lds + 116736);
    if (tid < 128) NW[tid] = nw[tid];
    u32x4 ra[2], rq[2], rk[2], rs4;
    u32x2 ru[4];
    f32x4 rt[4];
    float decay = 1.f;
    const unsigned char* gbase = nullptr; const bf16_t* gsc = nullptr; const float* gdec = nullptr;
    if (GDN) {
        const int slot0 = sample ? (b * 4 + h) : (b * 4 + h) * 32;
        gbase = sample ? (const unsigned char*)(p.out + O_GS) + (size_t)slot0 * 65536 : (const unsigned char*)(p.out + O_YP) + (size_t)slot0 * 65536;
        gsc = (const bf16_t*)(p.ws + (sample ? W_SCS : W_SCP)) + (size_t)slot0 * 4096;
        gdec = (const float*)(p.ws + W_DEC) + (sample ? 1024 + slot0 : slot0);
    }
    const int c_tok = ct * 32 + r;
    auto prefetch = [&](int n) {
        const size_t trow = (size_t)row_base + n * 64;
        if (GDN) {
            const unsigned char* sb = gbase + (size_t)n * 65536;
#pragma unroll
            for (int i = 0; i < 2; ++i) { const int idx = tid + 512 * i; ra[i] = *(const u32x4*)(sb + idx * 16); rq[i] = *(const u32x4*)(sb + 16384 + idx * 16); rk[i] = *(const u32x4*)(sb + 49152 + idx * 16); }
            rs4 = *(const u32x4*)((const unsigned char*)(gsc + (size_t)n * 4096) + tid * 16);
#pragma unroll
            for (int g = 0; g < 4; ++g) ru[g] = *(const u32x2*)(sb + 32768 + (e_col * 64 + ct * 32 + 8 * g + 4 * hh) * 2);
            decay = gdec[n];
        } else {
            const int c = tid >> 3, cp = tid & 7;
            if (c < nrows) {
                const bf16_t* qr = proj + (trow + c) * NPJ + h * 128 + cp * 8;
                ra[0] = *(const u32x4*)qr; ra[1] = *(const u32x4*)(qr + 64);
                rq[0] = *(const u32x4*)(qr + 512); rq[1] = *(const u32x4*)(qr + 512 + 64);
                const int pidx = sample ? 2048 + c : n * 64 + c;
                const f32x4* tp = (const f32x4*)(rtab + (size_t)pidx * 64 + cp * 8);
                rt[0] = tp[0]; rt[1] = tp[1]; rt[2] = tp[2]; rt[3] = tp[3];
            }
#pragma unroll
            for (int i = 0; i < 2; ++i) { const int idx = tid + 512 * i, row = idx >> 4, chunk = idx & 15;
                if (row < nrows) rk[i] = *(const u32x4*)(proj + (trow + row) * NPJ + 1024 + h * 128 + chunk * 8); }
        }
    };
    prefetch(0);
    write_St();
    auto flush = [&](int n) {
#pragma unroll
        for (int i = 0; i < 2; ++i) { const int idx = tid + 512 * i, row = idx >> 4, chunk = idx & 15;
            if (row < nrows) *(u32x4*)(mix + ((size_t)row_base + n * 64 + row) * DM + mix_col + chunk * 8) = *(const u32x4*)(OST + sw256(row, chunk)); }
    };
    for (int n = 0; n < nchunks; ++n) {
        u32x2 gate[4];
        f32x16 acc1;
        if (GDN) {
#pragma unroll
            for (int i = 0; i < 2; ++i) { const int idx = tid + 512 * i;
                *(u32x4*)(INA + sw256(idx >> 4, idx & 15)) = ra[i]; *(u32x4*)(INQ + sw256(idx >> 4, idx & 15)) = rq[i]; *(u32x4*)(INKT + sw128x(idx >> 3, idx & 7)) = rk[i]; }
            *(u32x4*)(INSC + sw128(tid >> 3, tid & 7)) = rs4;
#pragma unroll
            for (int g = 0; g < 4; ++g) { acc1[4 * g] = bflo(ru[g].x); acc1[4 * g + 1] = bfhi(ru[g].x); acc1[4 * g + 2] = bflo(ru[g].y); acc1[4 * g + 3] = bfhi(ru[g].y); }
        } else {
            const int c = tid >> 3, cp = tid & 7;
            u32x4 q1 = {0u, 0u, 0u, 0u}, q2 = q1, k1 = q1, k2 = q1;
            unsigned short kt1[8], kt2[8];
#pragma unroll
            for (int j = 0; j < 8; ++j) { kt1[j] = 0; kt2[j] = 0; }
            if (c < nrows) {
                const float fq = exp2f((float)(c + 1) * lg2), fk = 0.08838834764831845f * exp2f((float)(nrows - 1 - c) * lg2);
                float oq1[8], oq2[8], ok1[8], ok2[8];
#pragma unroll
                for (int j = 0; j < 8; ++j) {
                    const unsigned qa = ra[0][j >> 1], qb = ra[1][j >> 1], ka = rq[0][j >> 1], kb = rq[1][j >> 1];
                    const float x1 = (j & 1) ? bfhi(qa) : bflo(qa), x2 = (j & 1) ? bfhi(qb) : bflo(qb);
                    const float y1 = (j & 1) ? bfhi(ka) : bflo(ka), y2 = (j & 1) ? bfhi(kb) : bflo(kb);
                    const float co = rt[j >> 1][(j & 1) * 2], si = rt[j >> 1][(j & 1) * 2 + 1];
                    oq1[j] = (x1 * co - x2 * si) * fq; oq2[j] = (x1 * si + x2 * co) * fq;
                    ok1[j] = (y1 * co - y2 * si) * fk; ok2[j] = (y1 * si + y2 * co) * fk;
                }
#pragma unroll
                for (int j = 0; j < 4; ++j) { q1[j] = pk_bf16(oq1[2 * j], oq1[2 * j + 1]); q2[j] = pk_bf16(oq2[2 * j], oq2[2 * j + 1]); k1[j] = pk_bf16(ok1[2 * j], ok1[2 * j + 1]); k2[j] = pk_bf16(ok2[2 * j], ok2[2 * j + 1]); }
#pragma unroll
                for (int j = 0; j < 8; ++j) { kt1[j] = (unsigned short)((j & 1) ? (k1[j >> 1] >> 16) : (k1[j >> 1] & 0xffffu)); kt2[j] = (unsigned short)((j & 1) ? (k2[j >> 1] >> 16) : (k2[j >> 1] & 0xffffu)); }
            }
            *(u32x4*)(INQ + sw256(c, cp)) = q1; *(u32x4*)(INQ + sw256(c, cp + 8)) = q2;
            *(u32x4*)(INA + sw256(c, cp)) = k1; *(u32x4*)(INA + sw256(c, cp + 8)) = k2;
#pragma unroll
            for (int j = 0; j < 8; ++j) {
                const int d1 = cp * 8 + j, d2 = d1 + 64;
                *(unsigned short*)(INKT + sw128x(d1, c >> 3) + (c & 7) * 2) = kt1[j];
                *(unsigned short*)(INKT + sw128x(d2, c >> 3) + (c & 7) * 2) = kt2[j];
            }
#pragma unroll
            for (int i = 0; i < 2; ++i) { const int idx = tid + 512 * i, row = idx >> 4, chunk = idx & 15;
                const u32x4 vv = (row < nrows) ? rk[i] : (u32x4){0u, 0u, 0u, 0u};
#pragma unroll
                for (int j = 0; j < 8; ++j) { const int e = chunk * 8 + j;
                    *(unsigned short*)(VNT + sw128x(e, row >> 3) + (row & 7) * 2) = (unsigned short)((j & 1) ? (vv[j >> 1] >> 16) : (vv[j >> 1] & 0xffffu)); } }
            decay = exp2f((float)nrows * lg2);
        }
        const float dec_n = decay;
        __syncthreads();
        if (n > 0) flush(n - 1);
        if (c_tok < nrows) {
#pragma unroll
            for (int g = 0; g < 4; ++g) gate[g] = *(const u32x2*)(proj + ((size_t)row_base + n * 64 + c_tok) * NPJ + gate_col + et * 32 + 8 * g + 4 * hh);
        }
        prefetch(n + 1 < nchunks ? n + 1 : n);
        if (GDN) {
#pragma unroll
            for (int s = 0; s < 8; ++s) {
                const bf16x8 a = *(const bf16x8*)(INA + sw256(ct * 32 + r, 2 * s + hh));
                const bf16x8 bb = *(const bf16x8*)(St + sw256(et * 32 + r, 2 * s + hh));
                acc1 = MFMA32(a, bb, acc1);
            }
#pragma unroll
            for (int g = 0; g < 4; ++g) { u32x2 v; v.x = pk_bf16(acc1[4 * g], acc1[4 * g + 1]); v.y = pk_bf16(acc1[4 * g + 2], acc1[4 * g + 3]);
                *(u32x2*)(VNT + sw128x(e_col, ct * 4 + g) + 8 * hh) = v; }
        } else {
            if (w < 4) {
                const int it_ = w >> 1, jt = w & 1;
#pragma unroll
                for (int i = 0; i < 16; ++i) acc1[i] = 0.f;
#pragma unroll
                for (int s = 0; s < 8; ++s) {
                    const bf16x8 a = *(const bf16x8*)(INQ + sw256(it_ * 32 + r, 2 * s + hh));
                    const bf16x8 bb = *(const bf16x8*)(INA + sw256(jt * 32 + r, 2 * s + hh));
                    acc1 = MFMA32(a, bb, acc1);
                }
                const float sc = exp2f(-(float)nrows * lg2); const int j = jt * 32 + r;
#pragma unroll
                for (int reg = 0; reg < 16; ++reg) { const int i = it_ * 32 + crow(reg, hh);
                    *(unsigned short*)(INSC + sw128(i, j >> 3) + (j & 7) * 2) = f2bf((j <= i) ? acc1[reg] * sc : 0.f); }
            }
        }
        __syncthreads();
        f32x16 acc2;
#pragma unroll
        for (int i = 0; i < 16; ++i) acc2[i] = 0.f;
#pragma unroll
        for (int s = 0; s < 8; ++s) {
            const bf16x8 a = *(const bf16x8*)(St + sw256(et * 32 + r, 2 * s + hh));
            const bf16x8 bb = *(const bf16x8*)(INQ + sw256(ct * 32 + r, 2 * s + hh));
            acc2 = MFMA32(a, bb, acc2);
        }
#pragma unroll
        for (int s = 0; s < 4; ++s) {
            const bf16x8 a = *(const bf16x8*)(VNT + sw128x(et * 32 + r, 2 * s + hh));
            const bf16x8 bb = *(const bf16x8*)(INSC + sw128(ct * 32 + r, 2 * s + hh));
            acc2 = MFMA32(a, bb, acc2);
        }
        {
            float sq = 0.f;
#pragma unroll
            for (int i = 0; i < 16; ++i) sq += acc2[i] * acc2[i];
            sq += __shfl_xor(sq, 32);
            if (hh == 0) SSQ[et * 64 + c_tok] = sq;
        }
#pragma unroll
        for (int i = 0; i < 16; ++i) { S0[i] *= dec_n; S1[i] *= dec_n; }
#pragma unroll
        for (int s = 0; s < 4; ++s) {
            const bf16x8 bb = *(const bf16x8*)(VNT + sw128x(et * 32 + r, 2 * s + hh));
            const bf16x8 a0 = *(const bf16x8*)(INKT + sw128x((2 * ct) * 32 + r, 2 * s + hh));
            const bf16x8 a1 = *(const bf16x8*)(INKT + sw128x((2 * ct + 1) * 32 + r, 2 * s + hh));
            S0 = MFMA32(a0, bb, S0); S1 = MFMA32(a1, bb, S1);
        }
        __syncthreads();
        if (prog && tid == 0) __hip_atomic_store(prog, n + 1, __ATOMIC_RELAXED, __HIP_MEMORY_SCOPE_AGENT);
        write_St();
        if (c_tok < nrows) {
            const float ss = SSQ[c_tok] + SSQ[64 + c_tok] + SSQ[128 + c_tok] + SSQ[192 + c_tok];
            const float rn = rsqrtf(ss * (1.0f / 128.0f) + 1e-6f);
            unsigned char* orow = OST + sw256(c_tok, et * 4);
#pragma unroll
            for (int g = 0; g < 4; ++g) {
                const int e0 = 8 * g + 4 * hh;
                const f32x4 wv = *(const f32x4*)(NW + et * 32 + e0);
                const float o0 = acc2[4 * g] * rn * wv[0] * silu(bflo(gate[g].x)), o1 = acc2[4 * g + 1] * rn * wv[1] * silu(bfhi(gate[g].x));
                const float o2 = acc2[4 * g + 2] * rn * wv[2] * silu(bflo(gate[g].y)), o3 = acc2[4 * g + 3] * rn * wv[3] * silu(bfhi(gate[g].y));
                u32x2 v; v.x = pk_bf16(o0, o1); v.y = pk_bf16(o2, o3);
                *(u32x2*)(orow + g * 16 + 8 * hh) = v;
            }
        }
    }
    __syncthreads();
    flush(nchunks - 1);
    {
        float* so = p.out + (sample ? (GDN ? O_GS : O_RS) : (GDN ? O_GP : O_RP)) + (size_t)(b * 4 + h) * 16384 + ((2 * ct) * 32 + 4 * hh) * 128 + e_col;
#pragma unroll
        for (int reg = 0; reg < 16; ++reg) { so[((reg & 3) + 8 * (reg >> 2)) * 128] = S0[reg]; so[((reg & 3) + 8 * (reg >> 2) + 32) * 128] = S1[reg]; }
    }
    __syncthreads();
}

__device__ __forceinline__ void phaseX(const Params& p, unsigned char* lds) { phaseC1_gdn_prep(p, lds, blockIdx.x, gridDim.x); }
__device__ __forceinline__ void phaseY(const Params& p, unsigned char* lds) {
    const int G = gridDim.x, bid = blockIdx.x;
    int* progs = (int*)(p.ws + W_DEC + 6144);
    int start = bid, limit = 64 + 1024, stride = G;
    if (G >= 192) {
        if (bid < 64) { limit = 64; stride = 64; }
        else { start = bid; stride = G - 64; }
    }
    for (int s = start; s < limit; s += stride) {
        const bool sample = s >= 64; const int t = sample ? s - 64 : s;
        const bool gdn = sample ? (t & 1) : (t >= 32);
        const int bh = sample ? (t >> 1) : (t & 31), b = bh >> 2, h = bh & 3;
        int* pr = nullptr; (void)progs;
        if (gdn) scan_item<true>(p, lds, b, h, sample, pr); else scan_item<false>(p, lds, b, h, sample, pr);
    }
    if (G >= 192) { if (bid >= 64) phaseA_weights(p, (float*)lds, 1024 + (bid - 64), 3328, G - 64); }
    else phaseA_weights(p, (float*)lds, 1024 + bid, 3328, G);
}

#ifndef DUMP_PROJ
#define DUMP_PROJ 0
#define DUMP_OFF W_PROJ
#define DUMP_BYTES 142606336ull
#endif
#ifndef DUP_C1
#define DUP_C1 0
#endif
#ifndef DUP_C12
#define DUP_C12 0
#endif
#ifndef SANITIZE
#define SANITIZE 0
#endif
#ifndef PHASE_MASK
#define PHASE_MASK 511
#endif
__global__ void __launch_bounds__(512, 2) fwd_megakernel(Params p) {
    extern __shared__ __attribute__((aligned(16))) unsigned char shm[];
    cg::grid_group grid = cg::this_grid();
    const bool multi = (p.phase_hi - p.phase_lo) > 1;
    volatile LAS unsigned* xst = (volatile LAS unsigned*)((LAS unsigned char*)shm + 152560);
    if (threadIdx.x == 0) { xst[0] = 0u; xst[1] = 0u; }
    __syncthreads();
    XcdBarrier xb = xcd_barrier_post((unsigned*)(p.ws + W_BAR), xst);
    if (p.phase_hi == 0x7fffffff) grid.sync();
#define RUN(ph) (p.phase_lo <= (ph) && (ph) < p.phase_hi && (PHASE_MASK & (1 << (ph))))
#define SEAM(ph) do { if (multi && p.phase_lo <= (ph) && (ph) + 1 < p.phase_hi) { xcd_barrier(xb); } } while (0)
    if (RUN(0)) { phaseA_weights(p, (float*)shm, blockIdx.x, 1024, gridDim.x); phaseA_norm(p, (float*)shm); phaseA_rope(p); if (blockIdx.x == 0 && threadIdx.x < 64) ((int*)(p.ws + W_DEC + 6144))[threadIdx.x] = 0; }
    SEAM(0);
    if (RUN(1)) {
        pg8::Gemm g; g.A = (const bf16_t*)(p.ws + W_H); g.Bt = (const bf16_t*)(p.ws + W_WIN); g.M = TT; g.N = NPJ; g.K = DM;
        pg8::SplitOrder S; S.init(g.N, g.K, 1, (int)gridDim.x, (int)blockIdx.x);
        pg8::EpiBf16<0> E; E.O = (bf16_t*)(p.ws + W_PROJ); E.ldc = NPJ;
        pg8::gemm_phase<pg8::EpiBf16<0>, pg8::SplitOrder, false>((PG8_LAS unsigned char*)shm, g, S, E, nullptr);
    }
    SEAM(1);
    if (RUN(2)) phaseX(p, shm);
    SEAM(2);
    if (RUN(3)) phaseY(p, shm);
    SEAM(3);
    if (RUN(4)) {
        pg8::Gemm g; g.A = (const bf16_t*)(p.ws + W_MIX); g.Bt = (const bf16_t*)(p.ws + W_WOUT); g.M = TT; g.N = DM; g.K = DM;
        pg8::SplitOrder S; S.init(g.N, g.K, 2, (int)gridDim.x, (int)blockIdx.x);
        pg8::EpiF32 E; E.C = (float*)(p.ws + W_PROJ); E.Csmp = (float*)(p.ws + W_SMP) - (size_t)TP * DM; E.ldc = DM;
        pg8::gemm_phase<pg8::EpiF32, pg8::SplitOrder, false>((PG8_LAS unsigned char*)shm, g, S, E, nullptr);
    }
    SEAM(4);
    if (RUN(5)) phaseE_rows(p);
    SEAM(5);
    if (RUN(6)) {
        pg8::Gemm g; g.A = (const bf16_t*)(p.ws + W_H); g.Bt = (const bf16_t*)(p.ws + W_WUP); g.M = TT; g.N = DFF; g.K = DM;
        pg8::SplitOrder S; S.init(g.N, g.K, 1, (int)gridDim.x, (int)blockIdx.x);
        pg8::EpiBf16<1> E; E.O = (bf16_t*)(p.ws + W_PROJ); E.ldc = DFF;
        pg8::gemm_phase<pg8::EpiBf16<1>, pg8::SplitOrder, false>((PG8_LAS unsigned char*)shm, g, S, E, nullptr);
    }
    SEAM(6);
    if (RUN(7)) {
        pg8::Gemm g; g.A = (const bf16_t*)(p.ws + W_PROJ); g.Bt = (const bf16_t*)(p.ws + W_WDN); g.M = TT; g.N = DM; g.K = DFF;
        pg8::SplitOrder S; S.init(g.N, g.K, 4, (int)gridDim.x, (int)blockIdx.x);
        pg8::EpiF32 E; E.C = (float*)(p.ws + W_H); E.Csmp = (float*)(p.ws + W_SMP) - (size_t)TP * DM; E.ldc = DM;
        pg8::gemm_phase<pg8::EpiF32, pg8::SplitOrder, false>((PG8_LAS unsigned char*)shm, g, S, E, nullptr);
    }
    SEAM(7);
    if (RUN(8)) phaseH_rows(p);
#if DUMP_PROJ
    if (p.phase_lo <= 9 && 9 < p.phase_hi) { const u32x4* src = (const u32x4*)(p.ws + DUMP_OFF); u32x4* dst = (u32x4*)p.out; for (size_t i = (size_t)blockIdx.x * 512 + threadIdx.x; i < DUMP_BYTES / 16; i += (size_t)gridDim.x * 512) dst[i] = src[i]; }
#endif
#if SANITIZE
    SEAM(8);
    if (p.phase_lo <= 9 && 9 < p.phase_hi) { for (size_t i = (size_t)blockIdx.x * 512 + threadIdx.x; i < 36278272; i += (size_t)gridDim.x * 512) { const float v = p.out[i]; if (!(fabsf(v) < 1e30f)) p.out[i] = 0.f; } }
#endif
}

constexpr size_t kDynLds = 152576;

extern "C" void kernel_launch(void* const* d_in, const int* in_sizes, int n_in, void* d_out, int out_size, void* d_ws, size_t ws_size, hipStream_t stream) {
    (void)in_sizes; (void)n_in; (void)out_size; (void)ws_size;
    static int grid_blocks = 0;
    if (!grid_blocks) {
        hipFuncSetAttribute((const void*)fwd_megakernel, hipFuncAttributeMaxDynamicSharedMemorySize, (int)kDynLds);
        int dev = 0, cus = 0, per_cu = 0;
        hipGetDevice(&dev);
        hipDeviceGetAttribute(&cus, hipDeviceAttributeMultiprocessorCount, dev);
        hipOccupancyMaxActiveBlocksPerMultiprocessor(&per_cu, fwd_megakernel, 512, kDynLds);
        if (per_cu < 1) per_cu = 1;
        if (per_cu > 1) per_cu = 1;
        grid_blocks = cus * per_cu;
    }
    Params p; memset(&p, 0, sizeof(p));
    p.x_prompt = (const float*)d_in[0]; p.x_sample = (const float*)d_in[1]; p.state_ret = (const float*)d_in[2]; p.state_gdn = (const float*)d_in[3];
    p.state_conv = (const float*)d_in[4]; p.pre_mix_w = (const float*)d_in[5]; p.w_in = (const float*)d_in[6]; p.conv_w = (const float*)d_in[7];
    p.A_log = (const float*)d_in[8]; p.dt_bias = (const float*)d_in[9]; p.ret_norm_w = (const float*)d_in[10]; p.gdn_norm_w = (const float*)d_in[11];
    p.w_out = (const float*)d_in[12]; p.post_mix_w = (const float*)d_in[13]; p.pre_mlp_w = (const float*)d_in[14]; p.w_up = (const float*)d_in[15];
    p.w_down = (const float*)d_in[16]; p.post_mlp_w = (const float*)d_in[17];
    p.out = (float*)d_out; p.ws = (unsigned char*)d_ws;
    p.rope_r = std::pow(10000.0, -1.0 / 64.0);
#if MULTI_LAUNCH
    for (int ph = 0; ph < 9 + SANITIZE; ++ph) {
        p.phase_lo = ph; p.phase_hi = ph + 1;
        hipLaunchKernelGGL(fwd_megakernel, dim3(grid_blocks), dim3(512), kDynLds, stream, p);
    }
#else
    p.phase_lo = 0; p.phase_hi = 9 + SANITIZE;
    hipMemsetAsync((unsigned char*)d_ws + W_BAR, 0, XCD_BAR_WORDS * 4, stream);
    void* args[] = {&p};
    hipError_t e = hipLaunchCooperativeKernel((const void*)fwd_megakernel, dim3(grid_blocks), dim3(512), args, kDynLds, stream);
    if (e != hipSuccess) fprintf(stderr, "cooperative launch failed: %s (grid %d)\n", hipGetErrorString(e), grid_blocks);
#endif
}
```

```cpp
#include <hip/hip_runtime.h>
#include <hip/hip_cooperative_groups.h>
#include <cstdio>
#include <cmath>
#include <cstring>
namespace cg = cooperative_groups;

#ifndef MULTI_LAUNCH
#define MULTI_LAUNCH 0
#endif

typedef unsigned short bf16_t;
typedef short bf16x8 __attribute__((ext_vector_type(8)));
typedef float f32x4 __attribute__((ext_vector_type(4)));
typedef float f32x16 __attribute__((ext_vector_type(16)));
typedef unsigned u32x4 __attribute__((ext_vector_type(4)));
typedef unsigned u32x2 __attribute__((ext_vector_type(2)));

constexpr int TP = 16384, TS = 1024, TT = TP + TS, DM = 1024, INW = 4104, NPJ = 4096, DFF = 4096;
constexpr size_t O_YP = 0, O_YS = 16777216, O_RP = 17825792, O_GP = 18350080, O_CP = 18874368, O_RS = 18911232, O_GS = 27299840, O_CS = 35688448;
constexpr size_t W_WIN = 0, W_WOUT = W_WIN + 8388608, W_WUP = W_WOUT + 2097152, W_WDN = W_WUP + 8388608, W_H = W_WDN + 8388608,
                 W_MIX = W_H + 35651584, W_PROJ = W_MIX + 35651584, W_AB = W_PROJ + 142606336, W_ROPE = W_AB + 557056,
                 W_SCP = W_ROPE + 1052672, W_SCS = W_SCP + 8388608, W_DEC = W_SCS + 4194304, W_BAR = W_DEC + 8192, W_END = W_BAR + 16384, W_SMP = W_WIN;

struct Params {
    const float *x_prompt, *x_sample, *state_ret, *state_gdn, *state_conv, *pre_mix_w, *w_in, *conv_w, *A_log, *dt_bias,
                *ret_norm_w, *gdn_norm_w, *w_out, *post_mix_w, *pre_mlp_w, *w_up, *w_down, *post_mlp_w;
    float* out;
    unsigned char* ws;
    double rope_r;
    int phase_lo, phase_hi;
};

#define DI __device__ __forceinline__
DI float bf2f(unsigned short b) { return __uint_as_float(((unsigned)b) << 16); }
DI float bflo(unsigned u) { return __uint_as_float(u << 16); }
DI float bfhi(unsigned u) { return __uint_as_float(u & 0xffff0000u); }
typedef float f32x2_t __attribute__((ext_vector_type(2)));
typedef __bf16 bf16x2_t __attribute__((ext_vector_type(2)));
DI unsigned pk_bf16(float lo, float hi) { f32x2_t v = {lo, hi}; bf16x2_t b = __builtin_convertvector(v, bf16x2_t); return __builtin_bit_cast(unsigned, b); }
DI unsigned short f2bf(float f) { return (unsigned short)(pk_bf16(f, 0.f) & 0xffffu); }
DI int sw256(int row, int chunk) { return row * 272 + (chunk << 4); }
DI int sw128(int row, int chunk) { return row * 144 + (chunk << 4); }
DI int sw128x(int row, int chunk) { return row * 144 + ((chunk ^ ((row >> 3) & 7)) << 4); }
DI int crow(int reg, int hh) { return (reg & 3) + 8 * (reg >> 2) + 4 * hh; }
DI float wave_sum(float v) { for (int o = 32; o >= 1; o >>= 1) v += __shfl_xor(v, o); return v; }
DI float silu(float x) { return x * __builtin_amdgcn_rcpf(1.0f + __expf(-x)); }
#define MFMA32(a, b, c) __builtin_amdgcn_mfma_f32_32x32x16_bf16((a), (b), (c), 0, 0, 0)

template <int NR> DI void fwd_subst(float (&x)[64], const float* Amat) {
#pragma unroll
    for (int i = 1; i < NR; ++i) {
        float s = x[i];
#pragma unroll
        for (int j = 0; j < i; ++j) s -= Amat[i * 64 + j] * x[j];
        x[i] = s;
        asm volatile("" ::: "memory");
    }
}

#define XB_TMO      128
#define XB_XCNT(j)  (256  + 64 * (j))
#define XB_XSUB(j)  (1280 + 64 * (j))
#define XB_XGEN(j)  (2304 + 64 * (j))
#define XB_TOP      3328
#define XB_TOPGEN   3392
#define XCD_BAR_WORDS 3456
#define XB_SPIN_CAP (1u << 18)
#define LAS __attribute__((address_space(3)))

__device__ __forceinline__ unsigned xb_ld(unsigned* p)              { return __hip_atomic_load(p, __ATOMIC_RELAXED, __HIP_MEMORY_SCOPE_AGENT); }
__device__ __forceinline__ unsigned xb_add(unsigned* p, unsigned v) { return __hip_atomic_fetch_add(p, v, __ATOMIC_RELAXED, __HIP_MEMORY_SCOPE_AGENT); }
__device__ __forceinline__ unsigned xb_xcc_id() { return (unsigned)__builtin_amdgcn_s_getreg((3 << 11) | 20) & 0xFu; }
#define XB_SPIN(cond, bar) do { unsigned _sp = 0; while (cond) { __builtin_amdgcn_s_sleep(1); \
    if ((++_sp & 255u) == 0u) { if (xb_ld(&(bar)[XB_TMO])) break; if (_sp > XB_SPIN_CAP) { atomicAdd(&(bar)[XB_TMO], 1u); break; } } } } while (0)

struct XcdBarrier {
    unsigned* bar; unsigned x;
    volatile LAS unsigned* st;
};

__device__ __forceinline__ XcdBarrier xcd_barrier_post(unsigned* bar, volatile LAS unsigned* st) {
    XcdBarrier b; b.bar = bar; b.x = xb_xcc_id(); b.st = st;
    if (threadIdx.x == 0) (void)xb_add(&bar[XB_XCNT(b.x)], 1u);
    return b;
}
__device__ __forceinline__ void xcd_barrier_complete(unsigned* bar, unsigned x, unsigned& nloc, unsigned& nx) {
    const unsigned G = gridDim.x * gridDim.y * gridDim.z;
    unsigned sum, cnt, mine, sp = 0u;
    for (;;) {
        sum = 0u; cnt = 0u; mine = 0u;
#pragma unroll
        for (unsigned j = 0; j < 16; ++j) { const unsigned c = xb_ld(&bar[XB_XCNT(j)]); sum += c; cnt += (c > 0u) ? 1u : 0u; mine = (j == x) ? c : mine; }
        if (sum == G) break;
        __builtin_amdgcn_s_sleep(1);
        if ((++sp & 255u) == 0u) { if (xb_ld(&bar[XB_TMO])) break; if (sp > XB_SPIN_CAP) { atomicAdd(&bar[XB_TMO], 1u); break; } }
    }
    nloc = mine > 0u ? mine : 1u; nx = cnt > 0u ? cnt : 1u;
}

__device__ __forceinline__ void xcd_barrier(const XcdBarrier& b) {
    asm volatile("s_waitcnt vmcnt(0)" ::: "memory");
    __syncthreads();
    if (threadIdx.x == 0) {
        unsigned* bar = b.bar;
        __builtin_amdgcn_s_waitcnt(0);
        unsigned nloc = b.st[0], nx = b.st[1];
        if (nloc == 0u) { xcd_barrier_complete(bar, b.x, nloc, nx); b.st[0] = nloc; b.st[1] = nx; }
        const unsigned old = xb_add(&bar[XB_XSUB(b.x)], 1u);
        const unsigned gen = old / nloc;
        if (old + 1u == (gen + 1u) * nloc) {
            __builtin_amdgcn_fence(__ATOMIC_RELEASE, "agent");
            asm volatile("s_waitcnt vmcnt(0)" ::: "memory");
            const unsigned og = xb_add(&bar[XB_TOP], 1u);
            const unsigned tg = og / nx;
            if (og + 1u == (tg + 1u) * nx) xb_add(&bar[XB_TOPGEN], 1u);
            else XB_SPIN(xb_ld(&bar[XB_TOPGEN]) == tg, bar);
            __builtin_amdgcn_fence(__ATOMIC_ACQUIRE, "agent");
            xb_add(&bar[XB_XGEN(b.x)], 1u);
            asm volatile("s_waitcnt vmcnt(0)" ::: "memory");
        } else {
            XB_SPIN(xb_ld(&bar[XB_XGEN(b.x)]) == gen, bar);
            __builtin_amdgcn_fence(__ATOMIC_ACQUIRE, "agent");
            asm volatile("s_waitcnt vmcnt(0)" ::: "memory");
        }
    }
    __syncthreads();
}


namespace pg8 {
#define PG8_LAS __attribute__((address_space(3)))
typedef unsigned short bf16_t;
typedef short bf16x8 __attribute__((ext_vector_type(8)));
typedef float f32x4 __attribute__((ext_vector_type(4)));
typedef unsigned u32x4 __attribute__((ext_vector_type(4)));
constexpr int BM = 256, BK = 64, HALF = 128, HTB = HALF * BK * 2  , STAGE_BYTES = 8 * HTB, NXCD = 8, WGM = 8;

__host__ __device__ __forceinline__ int lds_byte(int r, int c) { const int st = (r >> 4) * 2 + (c >> 5), rr = r & 15, cc = c & 31, ob = rr * 64 + cc * 2; return st * 1024 + (ob ^ (((ob >> 9) & 1) << 5)); }
__host__ __device__ __forceinline__ void stage_rc(int b, int& R, int& C) { const int st = b / 1024, sb = b % 1024, swz = sb ^ (((sb >> 9) & 1) << 5); R = (st >> 1) * 16 + swz / 64; C = (st & 1) * 32 + (swz % 64) / 2; }
__host__ __device__ __forceinline__ int perm32(int rho) { const int n = rho >> 4, i = rho & 15; return 8 * (i >> 2) + 4 * n + (i & 3); }

struct Unit { int pm, pn, kt0, nkt, smp; };
struct Gemm { const bf16_t* A; const bf16_t* Bt; int M, N, K; };

struct StaticOrder {
    int nM, nN, nwg, G, c;
    __host__ __device__ void init(int M, int N, int G_, int c_) { nM = M / BM; nN = N / BM; nwg = nM * nN; G = G_; c = c_; }
    __host__ __device__ bool next(int i, Unit& u) const {
        const long L = (long)i * G + c; if (L >= nwg) return false;
        int wgid = (int)L; { const int q = nwg / NXCD, r = nwg % NXCD, xcd = wgid % NXCD, off = wgid / NXCD; wgid = (xcd < r ? xcd * (q + 1) : r * (q + 1) + (xcd - r) * q) + off; }
        const int nig = WGM * nN, gid = wgid / nig, fm = gid * WGM, gsz = (nM - fm) < WGM ? (nM - fm) : WGM;
        u.pm = fm + ((wgid % nig) % gsz); u.pn = (wgid % nig) / gsz; return true;
    }
    __device__ __forceinline__ void a_ready(const Unit&) const {}
    __device__ __forceinline__ void done(const Unit&) const {}
};
struct SplitOrder {
    StaticOrder so; int nN, nfull, nsub, G, c, KS, nktf;
    __host__ __device__ void init(int N, int K, int KS_, int G_, int c_) { so.init(16384, N, G_, c_); nN = N / BM; nfull = 64 * nN; KS = KS_; nsub = 4 * nN * KS; G = G_; c = c_; nktf = K / BK; }
    __host__ __device__ bool next(int i, Unit& u) const {
        const long L = (long)i * G + c; if (L >= nfull + nsub) return false;
        if (L < nfull) { so.next(i, u); u.kt0 = 0; u.nkt = nktf; u.smp = 0; }
        else { const int q = (int)(L - nfull), ks = q % KS, uu = q / KS; u.pm = 64 + (uu & 3); u.pn = uu >> 2; u.nkt = nktf / KS; u.kt0 = ks * u.nkt; u.smp = KS > 1 ? ks + 1 : 0; }
        return true;
    }
    __device__ __forceinline__ void a_ready(const Unit&) const {}
    __device__ __forceinline__ void done(const Unit&) const {}
};

__device__ __forceinline__ unsigned cvt_pk_bf16(float lo, float hi) { return ::pk_bf16(lo, hi); }
struct EpiF32 {
    static constexpr bool PERM = false, AFTER_DRAIN = false;
    float* C; float* Csmp; int ldc;
    __device__ __forceinline__ void operator()(const f32x4 (&acc)[2][2][4][2], const Unit& u, int wr, int wc, int fr, int fq) const {
        const int row0 = u.pm * BM + wr * 64 + fr, col0 = u.pn * BM + wc * 32 + 4 * fq;
        if (u.smp) {
            float* base = Csmp + (size_t)(u.smp - 1) * 1024 * ldc;
#pragma unroll
            for (int ai = 0; ai < 2; ++ai)
#pragma unroll
                for (int m = 0; m < 4; ++m) { float* rowp = base + (size_t)(row0 + ai * HALF + m * 16) * ldc + col0;
#pragma unroll
                    for (int bj = 0; bj < 2; ++bj)
#pragma unroll
                        for (int n = 0; n < 2; ++n) *(f32x4*)(rowp + bj * HALF + n * 16) = acc[ai][bj][m][n]; }
            return;
        }
#pragma unroll
        for (int ai = 0; ai < 2; ++ai)
#pragma unroll
            for (int m = 0; m < 4; ++m) { float* rowp = C + (size_t)(row0 + ai * HALF + m * 16) * ldc + col0;
#pragma unroll
                for (int bj = 0; bj < 2; ++bj)
#pragma unroll
                    for (int n = 0; n < 2; ++n) *(f32x4*)(rowp + bj * HALF + n * 16) = acc[ai][bj][m][n]; }
    }
};
template <int ACT  > struct EpiBf16 {
    static constexpr bool PERM = true, AFTER_DRAIN = false;
    bf16_t* O; int ldc;
    __device__ __forceinline__ void operator()(const f32x4 (&acc)[2][2][4][2], const Unit& u, int wr, int wc, int fr, int fq) const {
        const int row0 = u.pm * BM + wr * 64 + fr; const int col0 = u.pn * BM + wc * 32 + 8 * fq;
#pragma unroll
        for (int ai = 0; ai < 2; ++ai)
#pragma unroll
            for (int m = 0; m < 4; ++m) { bf16_t* rowp = O + (size_t)(row0 + ai * HALF + m * 16) * ldc + col0;
#pragma unroll
                for (int bj = 0; bj < 2; ++bj) { f32x4 v0 = acc[ai][bj][m][0], v1 = acc[ai][bj][m][1];
                    if (ACT == 1) {
#pragma unroll
                        for (int j = 0; j < 4; ++j) { const float a = fmaxf(v0[j], 0.f), b = fmaxf(v1[j], 0.f); v0[j] = a * a; v1[j] = b * b; } }
                    u32x4 w; w.x = cvt_pk_bf16(v0[0], v0[1]); w.y = cvt_pk_bf16(v0[2], v0[3]); w.z = cvt_pk_bf16(v1[0], v1[1]); w.w = cvt_pk_bf16(v1[2], v1[3]);
                    *(u32x4*)(rowp + bj * HALF) = w; } }
    }
};
template <class Epi, class Sched, bool STAMP = false>
__device__ __forceinline__ void gemm_phase(PG8_LAS unsigned char* lds, const Gemm g, const Sched& S, const Epi& E, unsigned long long* stamps) {
    const int tid = threadIdx.x, wid = __builtin_amdgcn_readfirstlane(tid >> 6), lane = tid & 63, wr = wid >> 2, wc = wid & 3, fr = lane & 15, fq = lane >> 4;
    const int K = g.K;
    int ts_lo = 0, ts_hi = 0, nts = 0; const unsigned long long rt_entry = STAMP ? (unsigned long long)wall_clock64() : 0ull;
#define PG8_STAMP() do { if (STAMP && wid == 0 && nts < 64) { const unsigned long long _c = (unsigned long long)clock64(); \
        ts_lo = (lane == nts) ? (int)(unsigned)_c : ts_lo; ts_hi = (lane == nts) ? (int)(unsigned)(_c >> 32) : ts_hi; ++nts; } } while (0)
    PG8_STAMP();
    unsigned voffA[2], voffB[2];
#pragma unroll
    for (int i = 0; i < 2; ++i) { int R, C; stage_rc(tid * 16 + i * 8192, R, C); const int Rb = Epi::PERM ? ((R & ~31) + perm32(R & 31)) : R;
        voffA[i] = (unsigned)(R * K + C) * 2u; voffB[i] = (unsigned)(Rb * K + C) * 2u; }
    const size_t kstep = (size_t)(BK * 2);
    const size_t hstep = (size_t)HALF * K * 2;
    const size_t tstep = 2 * hstep;
    const unsigned ldsw = (unsigned)wid * 1024u;
    const int aoff = lds_byte(wr * 64 + fr, fq * 8), boff = lds_byte(wc * 32 + fr, fq * 8);
#define PG8_SA(b, h) (((b) * 2 + (h)) * HTB)
#define PG8_SB(b, h) ((4 + (b) * 2 + (h)) * HTB)
#define PG8_STAGE(bufoff, gbase, voff) do { _Pragma("unroll") for (int _i = 0; _i < 2; ++_i) \
        __builtin_amdgcn_global_load_lds((const unsigned*)((const char*)(gbase) + (voff)[_i]), (PG8_LAS unsigned*)(lds + (bufoff) + ldsw + _i * 8192), 16, 0, 0); } while (0)
#define PG8_LDA(dst, b, h) do { _Pragma("unroll") for (int m = 0; m < 4; ++m) _Pragma("unroll") for (int k = 0; k < 2; ++k) dst[m][k] = *(const PG8_LAS bf16x8*)(lds + PG8_SA(b, h) + aoff + m * 2048 + k * 1024); } while (0)
#define PG8_LDB(dst, b, h) do { _Pragma("unroll") for (int n = 0; n < 2; ++n) _Pragma("unroll") for (int k = 0; k < 2; ++k) dst[n][k] = *(const PG8_LAS bf16x8*)(lds + PG8_SB(b, h) + boff + n * 2048 + k * 1024); } while (0)
#define PG8_MMA(ai, bj, At, Bt) do { __builtin_amdgcn_s_setprio(1); _Pragma("unroll") for (int m = 0; m < 4; ++m) _Pragma("unroll") for (int n = 0; n < 2; ++n) _Pragma("unroll") for (int k = 0; k < 2; ++k) \
        acc[ai][bj][m][n] = __builtin_amdgcn_mfma_f32_16x16x32_bf16(Bt[n][k], At[m][k], acc[ai][bj][m][n], 0, 0, 0); __builtin_amdgcn_s_setprio(0); } while (0)
#define PG8_WAIT_V(n) asm volatile("s_waitcnt vmcnt(" #n ")" ::: "memory")
#define PG8_WAIT_L(n) asm volatile("s_waitcnt lgkmcnt(" #n ")" ::: "memory")
#define PG8_BAR __builtin_amdgcn_s_barrier()
#define PG8_SCHED __builtin_amdgcn_sched_barrier(0)
    Unit cur, nxt; int ui = 0;
    if (!S.next(0, cur)) return;
    f32x4 acc[2][2][4][2];
#pragma unroll
    for (int a = 0; a < 2; ++a)
#pragma unroll
        for (int b = 0; b < 2; ++b)
#pragma unroll
            for (int m = 0; m < 4; ++m)
#pragma unroll
                for (int n = 0; n < 2; ++n) acc[a][b][m][n] = (f32x4){0.f, 0.f, 0.f, 0.f};
    bf16x8 At[4][2], B0[2][2], B1[2][2];
    const char* cA = (const char*)g.A + (size_t)cur.pm * tstep + (size_t)cur.kt0 * kstep; const char* cB = (const char*)g.Bt + (size_t)cur.pn * tstep + (size_t)cur.kt0 * kstep;
    S.a_ready(cur);
    PG8_STAGE(PG8_SB(0, 0), cB, voffB); PG8_STAGE(PG8_SA(0, 0), cA, voffA); PG8_STAGE(PG8_SB(0, 1), cB + hstep, voffB); PG8_STAGE(PG8_SA(0, 1), cA + hstep, voffA);
    if (wr == 1) PG8_BAR;
    PG8_WAIT_V(4); PG8_BAR;
    PG8_STAGE(PG8_SB(1, 0), cB + kstep, voffB); PG8_STAGE(PG8_SA(1, 0), cA + kstep, voffA); PG8_STAGE(PG8_SB(1, 1), cB + hstep + kstep, voffB);
    PG8_WAIT_V(6); PG8_BAR;
    PG8_STAMP();
    for (;;) {
        const bool has_next = S.next(ui + 1, nxt);
        const char* nA = has_next ? (const char*)g.A + (size_t)nxt.pm * tstep + (size_t)nxt.kt0 * kstep : cA; const char* nB = has_next ? (const char*)g.Bt + (size_t)nxt.pn * tstep + (size_t)nxt.kt0 * kstep : cB;
        const int nt = cur.nkt;
        for (int t = 0; t < nt; t += 2) {
            const bool last = (t == nt - 2);
            const char* a1 = cA + (size_t)(t + 1) * kstep;
            const char* a2 = last ? nA : cA + (size_t)(t + 2) * kstep; const char* b2 = last ? nB : cB + (size_t)(t + 2) * kstep;
            const char* a3 = a2 + kstep; const char* b3 = b2 + kstep;
            if (last && has_next) S.a_ready(nxt);
            PG8_LDB(B0, 0, 0); PG8_SCHED; PG8_LDA(At, 0, 0); PG8_STAGE(PG8_SA(1, 1), a1 + hstep, voffA);
            PG8_WAIT_L(8); PG8_BAR; PG8_WAIT_L(0); PG8_MMA(0, 0, At, B0); PG8_BAR; PG8_SCHED;
            PG8_LDB(B1, 0, 1); PG8_STAGE(PG8_SB(0, 0), b2, voffB);
            PG8_BAR; PG8_WAIT_L(0); PG8_MMA(0, 1, At, B1); PG8_BAR;
            PG8_LDA(At, 0, 1); PG8_STAGE(PG8_SA(0, 0), a2, voffA);
            PG8_BAR; PG8_WAIT_L(0); PG8_MMA(1, 0, At, B0); PG8_BAR; PG8_SCHED;
            PG8_STAGE(PG8_SB(0, 1), b2 + hstep, voffB);
            PG8_WAIT_V(6); PG8_BAR; PG8_MMA(1, 1, At, B1); PG8_BAR;
            PG8_LDB(B0, 1, 0); PG8_SCHED; PG8_LDA(At, 1, 0); PG8_STAGE(PG8_SA(0, 1), a2 + hstep, voffA);
            PG8_WAIT_L(8); PG8_BAR; PG8_WAIT_L(0); PG8_MMA(0, 0, At, B0); PG8_BAR; PG8_SCHED;
            PG8_LDB(B1, 1, 1); PG8_STAGE(PG8_SB(1, 0), b3, voffB);
            PG8_BAR; PG8_WAIT_L(0); PG8_MMA(0, 1, At, B1); PG8_BAR;
            PG8_LDA(At, 1, 1); PG8_STAGE(PG8_SA(1, 0), a3, voffA);
            PG8_BAR; PG8_WAIT_L(0); PG8_MMA(1, 0, At, B0); PG8_BAR; PG8_SCHED;
            PG8_STAGE(PG8_SB(1, 1), b3 + hstep, voffB);
            PG8_WAIT_V(6); PG8_BAR; PG8_MMA(1, 1, At, B1); PG8_BAR;
        }
        PG8_STAMP();
        if constexpr (!Epi::AFTER_DRAIN) { E(acc, cur, wr, wc, fr, fq); S.done(cur); }
        PG8_STAMP();
        if (!has_next) break;
#pragma unroll
        for (int a = 0; a < 2; ++a)
#pragma unroll
            for (int b = 0; b < 2; ++b)
#pragma unroll
                for (int m = 0; m < 4; ++m)
#pragma unroll
                    for (int n = 0; n < 2; ++n) acc[a][b][m][n] = (f32x4){0.f, 0.f, 0.f, 0.f};
        cur = nxt; cA = nA; cB = nB; ++ui;
    }
    PG8_WAIT_V(0);
    if (wr == 0) PG8_BAR;
    PG8_BAR;
    if constexpr (Epi::AFTER_DRAIN) { E.fused(acc, cur, wr, wc, fr, fq, lds, wid, lane); S.done(cur); }
    PG8_STAMP();
    if (STAMP && wid == 0) { stamps[lane] = lane < nts ? (((unsigned long long)(unsigned)ts_hi << 32) | (unsigned)ts_lo) : 0ull;
        if (lane == 62) stamps[62] = rt_entry; if (lane == 63) stamps[63] = (unsigned long long)wall_clock64(); }
#undef PG8_STAMP
#undef PG8_SA
#undef PG8_SB
#undef PG8_STAGE
#undef PG8_LDA
#undef PG8_LDB
#undef PG8_MMA
#undef PG8_WAIT_V
#undef PG8_WAIT_L
#undef PG8_BAR
#undef PG8_SCHED
}
}

__device__ __forceinline__ void phaseA_weights(const Params& p, float* tl  , int tile0, int tile1, int step) {
    const int tid = threadIdx.x;
    for (int tile = tile0; tile < tile1; tile += step) {
        const float* src; bf16_t* dst; int ldn, K, lt;
        if (tile < 1024)      { src = p.w_in;   ldn = INW;  K = 1024; dst = (bf16_t*)(p.ws + W_WIN);  lt = tile; }
        else if (tile < 1280) { src = p.w_out;  ldn = 1024; K = 1024; dst = (bf16_t*)(p.ws + W_WOUT); lt = tile - 1024; }
        else if (tile < 2304) { src = p.w_up;   ldn = 4096; K = 1024; dst = (bf16_t*)(p.ws + W_WUP);  lt = tile - 1280; }
        else                  { src = p.w_down; ldn = 1024; K = 4096; dst = (bf16_t*)(p.ws + W_WDN);  lt = tile - 2304; }
        const int nkt = K >> 6, kt = lt % nkt, nt = lt / nkt;
#pragma unroll
        for (int i = 0; i < 2; ++i) {
            const int r = (tid >> 4) + 32 * i, c4 = (tid & 15) * 4;
            const float4 v = *(const float4*)(src + (size_t)(kt * 64 + r) * ldn + nt * 64 + c4);
            tl[r * 65 + c4 + 0] = v.x; tl[r * 65 + c4 + 1] = v.y; tl[r * 65 + c4 + 2] = v.z; tl[r * 65 + c4 + 3] = v.w;
        }
        __syncthreads();
        {
            const int n = tid >> 3, k8 = (tid & 7) * 8;
            float v[8];
#pragma unroll
            for (int j = 0; j < 8; ++j) v[j] = tl[(k8 + j) * 65 + n];
            u32x4 w; w.x = pk_bf16(v[0], v[1]); w.y = pk_bf16(v[2], v[3]); w.z = pk_bf16(v[4], v[5]); w.w = pk_bf16(v[6], v[7]);
            *(u32x4*)(dst + (size_t)(nt * 64 + n) * K + kt * 64 + k8) = w;
        }
        __syncthreads();
    }
}

__device__ __forceinline__ void phaseA_rope(const Params& p) {
    float2* tab = (float2*)(p.ws + W_ROPE);
    for (int idx = blockIdx.x * 512 + threadIdx.x; idx < 2056 * 64; idx += gridDim.x * 512) {
        const int pi = idx >> 6, f = idx & 63;
        double ivd = 1.0; for (int k = 0; k < f; ++k) ivd *= p.rope_r;
        const float ivf = (float)ivd;
        const float pos = pi < 2048 ? (float)pi : (float)(16384 + pi - 2048);
        const float ang = pos * ivf;
        const double a = (double)ang, q = rint(a * 0.63661977236758134308);
        double r = fma(-q, 1.57079632679489655800, a); r = fma(-q, 6.12323399573676603587e-17, r);
        const int qd = ((int)q) & 3;
        const double r2 = r * r;
        const double s = r * (1.0 + r2 * (-1.0 / 6.0 + r2 * (1.0 / 120.0 + r2 * (-1.0 / 5040.0 + r2 * (1.0 / 362880.0 + r2 * (-1.0 / 39916800.0 + r2 * (1.0 / 6227020800.0)))))));
        const double c = 1.0 + r2 * (-0.5 + r2 * (1.0 / 24.0 + r2 * (-1.0 / 720.0 + r2 * (1.0 / 40320.0 + r2 * (-1.0 / 3628800.0 + r2 * (1.0 / 479001600.0 + r2 * (-1.0 / 87178291200.0)))))));
        double co, si;
        if (qd == 0) { co = c; si = s; } else if (qd == 1) { co = -s; si = c; } else if (qd == 2) { co = -c; si = -s; } else { co = s; si = -c; }
        tab[idx] = make_float2((float)co, (float)si);
    }
}

__device__ __forceinline__ void phaseA_norm(const Params& p, float* wab  ) {
    const int tid = threadIdx.x, wave = tid >> 6, lane = tid & 63;
    for (int i = tid; i < 8192; i += 512) { const int k = i >> 3, j = i & 7; wab[j * 1024 + k] = p.w_in[(size_t)k * INW + 4096 + j]; }
    __syncthreads();
    bf16_t* hbuf = (bf16_t*)(p.ws + W_H); float* ab = (float*)(p.ws + W_AB);
    float4 wv[4];
#pragma unroll
    for (int i = 0; i < 4; ++i) wv[i] = *(const float4*)(p.pre_mix_w + lane * 4 + 256 * i);
    float bias = 0.f, alog = 0.f; if (lane < 4) { bias = p.dt_bias[lane]; alog = p.A_log[lane]; }
    const int stride = gridDim.x * 8;
    int row = blockIdx.x * 8 + wave;
    float4 v[4];
    if (row < TT) { const float* xr = row < TP ? p.x_prompt + (size_t)row * DM : p.x_sample + (size_t)(row - TP) * DM;
#pragma unroll
        for (int i = 0; i < 4; ++i) v[i] = *(const float4*)(xr + lane * 4 + 256 * i); }
    while (row < TT) {
        const int nrow = row + stride;
        float4 vn[4];
        if (nrow < TT) { const float* xr = nrow < TP ? p.x_prompt + (size_t)nrow * DM : p.x_sample + (size_t)(nrow - TP) * DM;
#pragma unroll
            for (int i = 0; i < 4; ++i) vn[i] = *(const float4*)(xr + lane * 4 + 256 * i); }
        float ss = 0.f;
#pragma unroll
        for (int i = 0; i < 4; ++i) ss += v[i].x * v[i].x + v[i].y * v[i].y + v[i].z * v[i].z + v[i].w * v[i].w;
        ss = wave_sum(ss);
        const float rs = rsqrtf(ss * (1.0f / 1024.0f) + 1e-6f);
        float acc[8];
#pragma unroll
        for (int j = 0; j < 8; ++j) acc[j] = 0.f;
#pragma unroll
        for (int i = 0; i < 4; ++i) {
            const float4 w = wv[i];
            const float h0 = v[i].x * rs * w.x, h1 = v[i].y * rs * w.y, h2 = v[i].z * rs * w.z, h3 = v[i].w * rs * w.w;
            u32x2 o; o.x = pk_bf16(h0, h1); o.y = pk_bf16(h2, h3);
            *(u32x2*)(hbuf + (size_t)row * DM + lane * 4 + 256 * i) = o;
#pragma unroll
            for (int j = 0; j < 8; ++j) { const float4 wj = *(const float4*)(wab + j * 1024 + lane * 4 + 256 * i); acc[j] += h0 * wj.x + h1 * wj.y + h2 * wj.z + h3 * wj.w; }
        }
#pragma unroll
        for (int j = 0; j < 8; ++j) acc[j] = wave_sum(acc[j]);
        if (lane < 8) {
            float a = acc[0];
#pragma unroll
            for (int j = 1; j < 8; ++j) a = (lane == j) ? acc[j] : a;
            float o;
            if (lane < 4) { const float xx = a + bias; const float sp = xx > 20.f ? xx : log1pf(expf(xx)); o = -expf(alog) * sp; }
            else o = 1.0f / (1.0f + expf(-a));
            ab[(size_t)row * 8 + lane] = o;
        }
#pragma unroll
        for (int i = 0; i < 4; ++i) v[i] = vn[i];
        row = nrow;
    }
}

DI void ld_row4(float4 (&v)[4], const float* rp, int lane) {
#pragma unroll
    for (int i = 0; i < 4; ++i) v[i] = *(const float4*)(rp + lane * 4 + 256 * i);
}
DI void add_row4(float4 (&v)[4], const float* rp, int lane) {
#pragma unroll
    for (int i = 0; i < 4; ++i) { const float4 t = *(const float4*)(rp + lane * 4 + 256 * i); v[i].x += t.x; v[i].y += t.y; v[i].z += t.z; v[i].w += t.w; }
}
DI float ssq4(const float4 (&v)[4]) { float s = 0.f;
#pragma unroll
    for (int i = 0; i < 4; ++i) s += v[i].x * v[i].x + v[i].y * v[i].y + v[i].z * v[i].z + v[i].w * v[i].w;
    return s; }
__device__ __forceinline__ void phaseE_rows(const Params& p) {
    const int tid = threadIdx.x, wave = tid >> 6, lane = tid & 63;
    const float* mbuf = (const float*)(p.ws + W_PROJ); bf16_t* hbuf = (bf16_t*)(p.ws + W_H); const float* part = (const float*)(p.ws + W_SMP);
    float4 w1[4], w2[4]; ld_row4(w1, p.post_mix_w, lane); ld_row4(w2, p.pre_mlp_w, lane);
    const int stride = gridDim.x * 8;
    int row = blockIdx.x * 8 + wave;
    float4 m[4], x[4];
    if (row < TT) { ld_row4(x, row < TP ? p.x_prompt + (size_t)row * DM : p.x_sample + (size_t)(row - TP) * DM, lane);
        if (row < TP) ld_row4(m, mbuf + (size_t)row * DM, lane); else { ld_row4(m, part + (size_t)(row - TP) * DM, lane); add_row4(m, part + 1048576 + (size_t)(row - TP) * DM, lane); } }
    while (row < TT) {
        const int nrow = row + stride;
        float4 mn[4], xn[4];
        if (nrow < TT) { ld_row4(xn, nrow < TP ? p.x_prompt + (size_t)nrow * DM : p.x_sample + (size_t)(nrow - TP) * DM, lane);
            if (nrow < TP) ld_row4(mn, mbuf + (size_t)nrow * DM, lane); else { ld_row4(mn, part + (size_t)(nrow - TP) * DM, lane); add_row4(mn, part + 1048576 + (size_t)(nrow - TP) * DM, lane); } }
        const float rs = rsqrtf(wave_sum(ssq4(m)) * (1.0f / 1024.0f) + 1e-6f);
        float* yr = p.out + (size_t)row * DM;
#pragma unroll
        for (int i = 0; i < 4; ++i) { x[i].x += m[i].x * rs * w1[i].x; x[i].y += m[i].y * rs * w1[i].y; x[i].z += m[i].z * rs * w1[i].z; x[i].w += m[i].w * rs * w1[i].w;
            *(float4*)(yr + lane * 4 + 256 * i) = x[i]; }
        const float rs2 = rsqrtf(wave_sum(ssq4(x)) * (1.0f / 1024.0f) + 1e-6f);
#pragma unroll
        for (int i = 0; i < 4; ++i) { u32x2 o; o.x = pk_bf16(x[i].x * rs2 * w2[i].x, x[i].y * rs2 * w2[i].y); o.y = pk_bf16(x[i].z * rs2 * w2[i].z, x[i].w * rs2 * w2[i].w);
            *(u32x2*)(hbuf + (size_t)row * DM + lane * 4 + 256 * i) = o; }
#pragma unroll
        for (int i = 0; i < 4; ++i) { m[i] = mn[i]; x[i] = xn[i]; }
        row = nrow;
    }
}
__device__ __forceinline__ void phaseH_rows(const Params& p) {
    const int tid = threadIdx.x, wave = tid >> 6, lane = tid & 63;
    const float* fbuf = (const float*)(p.ws + W_H); const float* part = (const float*)(p.ws + W_SMP);
    float4 w1[4]; ld_row4(w1, p.post_mlp_w, lane);
    const int stride = gridDim.x * 8;
    int row = blockIdx.x * 8 + wave;
    float4 f[4], x[4];
    auto ldf = [&](float4 (&d)[4], int r) { if (r < TP) ld_row4(d, fbuf + (size_t)r * DM, lane); else { const float* q = part + (size_t)(r - TP) * DM; ld_row4(d, q, lane); add_row4(d, q + 1048576, lane); add_row4(d, q + 2 * 1048576, lane); add_row4(d, q + 3 * 1048576, lane); } };
    if (row < TT) { ld_row4(x, p.out + (size_t)row * DM, lane); ldf(f, row); }
    while (row < TT) {
        const int nrow = row + stride;
        float4 fn[4], xn[4];
        if (nrow < TT) { ld_row4(xn, p.out + (size_t)nrow * DM, lane); ldf(fn, nrow); }
        const float rs = rsqrtf(wave_sum(ssq4(f)) * (1.0f / 1024.0f) + 1e-6f);
        float* yr = p.out + (size_t)row * DM;
#pragma unroll
        for (int i = 0; i < 4; ++i) { x[i].x += f[i].x * rs * w1[i].x; x[i].y += f[i].y * rs * w1[i].y; x[i].z += f[i].z * rs * w1[i].z; x[i].w += f[i].w * rs * w1[i].w;
            *(float4*)(yr + lane * 4 + 256 * i) = x[i]; }
#pragma unroll
        for (int i = 0; i < 4; ++i) { f[i] = fn[i]; x[i] = xn[i]; }
        row = nrow;
    }
}

__device__ __forceinline__ void phaseC1_gdn_prep(const Params& p, unsigned char* lds, int first, int step, int limit) {
    const int tid = threadIdx.x, w = tid >> 6, lane = tid & 63, r = lane & 31, hh = lane >> 5;
    float* qc = (float*)lds; float* kc = qc + 64 * 129; float* vc = kc + 64 * 129;
    unsigned char* knb = lds + 99072; unsigned char* qnb = lds + 116480;
    float* Amat = (float*)(lds + 133888); float* cum = (float*)(lds + 150528); float* beta = cum + 64; float* rnq = cum + 128; float* rnk = cum + 192; float* fack = cum + 256;
    bf16_t* stg = (bf16_t*)(lds + 99072);
    const bf16_t* proj = (const bf16_t*)(p.ws + W_PROJ); const float* ab = (const float*)(p.ws + W_AB);
    u32x4 pre[6]; float c0 = 0.f, c1 = 0.f, c2 = 0.f, c3 = 0.f, hx3 = 0.f, hx2 = 0.f, hx1 = 0.f, g_in = 0.f, be_in = 0.f;
    auto issue = [&](int it) {
        const bool smp = it >= 1024;
        int b_, n_, h_, row0_, nrows_;
        if (!smp) { b_ = it >> 7; n_ = (it >> 2) & 31; h_ = it & 3; row0_ = b_ * 2048 + n_ * 64; nrows_ = 64; }
        else { const int q = it - 1024; b_ = q >> 2; n_ = 0; h_ = q & 3; row0_ = TP + b_ * 8; nrows_ = 8; }
        const int nld = nrows_ * 48;
#pragma unroll
        for (int k = 0; k < 6; ++k) { const int idx = tid + 512 * k;
            if (idx < nld) { const int row = idx / 48, rem = idx - row * 48, seg = rem >> 4, pc = rem & 15;
                pre[k] = *(const u32x4*)(proj + (size_t)(row0_ + row) * NPJ + 2048 + seg * 512 + h_ * 128 + pc * 8); } }
        hx3 = 0.f; hx2 = 0.f; hx1 = 0.f; g_in = 0.f; be_in = 0.f;
        if (tid < 384) {
            const int seg = tid >> 7, d = tid & 127, ch = seg * 512 + h_ * 128 + d;
            c0 = p.conv_w[ch]; c1 = p.conv_w[1536 + ch]; c2 = p.conv_w[3072 + ch]; c3 = p.conv_w[4608 + ch];
            const bf16_t* src = proj + (size_t)row0_ * NPJ + 2048 + ch;
            if (smp) { const float* sc = p.state_conv + (size_t)b_ * 3 * 1536 + ch; hx3 = sc[0]; hx2 = sc[1536]; hx1 = sc[3072]; }
            else if (n_ > 0) { hx3 = bf2f(*(src - 3 * NPJ)); hx2 = bf2f(*(src - 2 * NPJ)); hx1 = bf2f(*(src - NPJ)); }
        } else if (tid < 448) {
            const int i = tid - 384;
            if (i < nrows_) { g_in = ab[(size_t)(row0_ + i) * 8 + h_]; be_in = ab[(size_t)(row0_ + i) * 8 + 4 + h_]; }
        }
    };
    if (first < limit) issue(first);
    for (int item = first; item < limit; item += step) {
        const bool sample = item >= 1024;
        int b, n, h, row0, nrows, slot;
        if (!sample) { b = item >> 7; n = (item >> 2) & 31; h = item & 3; row0 = b * 2048 + n * 64; nrows = 64; slot = (b * 4 + h) * 32 + n; }
        else { const int s = item - 1024; b = s >> 2; n = 0; h = s & 3; row0 = TP + b * 8; nrows = 8; slot = s; }
        unsigned char* sbase = sample ? (unsigned char*)(p.out + O_GS) + (size_t)slot * 65536 : (unsigned char*)(p.out + O_YP) + (size_t)slot * 65536;
        bf16_t* sc_out = (bf16_t*)(p.ws + (sample ? W_SCS : W_SCP)) + (size_t)slot * 4096;
        float* dec_out = (float*)(p.ws + W_DEC) + (sample ? 1024 + slot : slot);
        {
            const int nld = nrows * 48;
#pragma unroll
            for (int k = 0; k < 6; ++k) { const int idx = tid + 512 * k;
                if (idx < nld) { const int row = idx / 48, rem = idx - row * 48, seg = rem >> 4, pc = rem & 15; *(u32x4*)(stg + row * 384 + seg * 128 + pc * 8) = pre[k]; } }
        }
        float xm3 = hx3, xm2 = hx2, xm1 = hx1;
        __syncthreads();
        if (tid < 384) {
            const int seg = tid >> 7, d = tid & 127, ch = seg * 512 + h * 128 + d;
            float* dst = qc + seg * (64 * 129) + d;
#pragma unroll 8
            for (int i = 0; i < nrows; ++i) {
                const float x = bf2f(stg[i * 384 + tid]);
                float cv = c0 * xm3; cv += c1 * xm2; cv += c2 * xm1; cv += c3 * x;
                dst[i * 129] = silu(cv);
                xm3 = xm2; xm2 = xm1; xm1 = x;
            }
            for (int i = nrows; i < 64; ++i) dst[i * 129] = 0.f;
            if (sample) { float* co = p.out + O_CS + (size_t)b * 3 * 1536 + ch; co[0] = xm3; co[1536] = xm2; co[3072] = xm1; }
            else if (n == 31) { float* co = p.out + O_CP + (size_t)b * 3 * 1536 + ch; co[0] = xm3; co[1536] = xm2; co[3072] = xm1; }
        } else if (tid < 448) {
            const int i = tid - 384;
            float g = g_in; const float be = be_in;
#pragma unroll
            for (int o = 1; o < 64; o <<= 1) { const float t = __shfl_up(g, o); if (i >= o) g += t; }
            cum[i] = g; beta[i] = be;
        }
        __syncthreads();
        if (tid < 128) {
            const int which = tid >> 6, row = tid & 63; const float* bp = (which ? kc : qc) + row * 129;
            float ss = 0.f;
#pragma unroll 16
            for (int d = 0; d < 128; ++d) ss += bp[d] * bp[d];
            float rn = rsqrtf(ss + 1e-6f);
            if (!which) rnq[row] = rn * 0.08838834764831845f; else { rnk[row] = rn; fack[row] = rn * beta[row] * __expf(cum[row]); }
        }
        __syncthreads();
#pragma unroll
        for (int it = 0; it < 4; ++it) {
            const int idx = tid + 512 * it, img = idx >> 10, rem = idx & 1023, row = rem >> 4, chunk = rem & 15;
            const float* sp = (img ? kc : qc) + row * 129 + chunk * 8; const float rn = img ? rnk[row] : rnq[row];
            u32x4 o; o.x = pk_bf16(sp[0] * rn, sp[1] * rn); o.y = pk_bf16(sp[2] * rn, sp[3] * rn); o.z = pk_bf16(sp[4] * rn, sp[5] * rn); o.w = pk_bf16(sp[6] * rn, sp[7] * rn);
            *(u32x4*)((img ? knb : qnb) + sw256(row, chunk)) = o;
        }
        __syncthreads();
        {
            const int isq = w >> 2, it_ = (w >> 1) & 1, jt = w & 1;
            f32x16 acc;
#pragma unroll
            for (int i = 0; i < 16; ++i) acc[i] = 0.f;
            const unsigned char* ai = isq ? qnb : knb;
#pragma unroll
            for (int s = 0; s < 8; ++s) {
                const bf16x8 a = *(const bf16x8*)(ai + sw256(it_ * 32 + r, 2 * s + hh));
                const bf16x8 bb = *(const bf16x8*)(knb + sw256(jt * 32 + r, 2 * s + hh));
                acc = MFMA32(a, bb, acc);
            }
            const int j = jt * 32 + r; const float cj = cum[j];
#pragma unroll
            for (int reg = 0; reg < 16; ++reg) {
                const int i = it_ * 32 + crow(reg, hh);
                const float dm = __expf(fminf(cum[i] - cj, 0.f)), dm2 = __expf(fminf(cj - cum[i], 0.f));
                if (!isq) Amat[i * 64 + j] = (i < j) ? beta[j] * acc[reg] * dm2 : 0.f;
                else sc_out[i * 64 + j] = f2bf((j <= i) ? acc[reg] * dm : 0.f);
            }
        }
        __syncthreads();
        {
#pragma unroll
            for (int it = 0; it < 2; ++it) {
                const int idx = tid + 512 * it, row = idx >> 4, chunk = idx & 15;
                const float e = __expf(cum[row]) * rnq[row]; const float* sp = qc + row * 129 + chunk * 8;
                u32x4 o; o.x = pk_bf16(sp[0] * e, sp[1] * e); o.y = pk_bf16(sp[2] * e, sp[3] * e); o.z = pk_bf16(sp[4] * e, sp[5] * e); o.w = pk_bf16(sp[6] * e, sp[7] * e);
                *(u32x4*)(sbase + 16384 + row * 256 + chunk * 16) = o;
            }
            const int d = tid & 127, cq = tid >> 7; const float cl = cum[63];
            u32x4* o = (u32x4*)(sbase + 49152 + (size_t)d * 128 + cq * 32);
#pragma unroll
            for (int c8 = 0; c8 < 2; ++c8) {
                float v[8];
#pragma unroll
                for (int j = 0; j < 8; ++j) { const int c = cq * 16 + c8 * 8 + j; v[j] = kc[c * 129 + d] * rnk[c] * __expf(cl - cum[c]); }
                u32x4 q; q.x = pk_bf16(v[0], v[1]); q.y = pk_bf16(v[2], v[3]); q.z = pk_bf16(v[4], v[5]); q.w = pk_bf16(v[6], v[7]); o[c8] = q;
            }
            if (tid == 0) *dec_out = __expf(cl);
        }
        __syncthreads();
        if (item + step < limit) issue(item + step);
        if (tid < 256) {
            int vz; asm volatile("v_mov_b32 %0, 0" : "=v"(vz));
            const float* At = Amat + vz;
            float* colp = (tid < 128) ? (kc + tid) : (vc + tid - 128);
            const float* facp = ((tid < 128) ? fack : beta) + vz;
            const int nblk = nrows == 64 ? 4 : 1;
            for (int bi = 0; bi < nblk; ++bi) {
                const int R0 = bi * 16;
                float acc[16];
#pragma unroll
                for (int ii = 0; ii < 16; ++ii) acc[ii] = colp[(R0 + ii) * 129] * facp[R0 + ii];
#pragma unroll 4
                for (int j = 0; j < R0; ++j) {
                    const float xj = colp[j * 129];
                    const f32x4 a0 = *(const f32x4*)(At + j * 64 + R0), a1 = *(const f32x4*)(At + j * 64 + R0 + 4), a2 = *(const f32x4*)(At + j * 64 + R0 + 8), a3 = *(const f32x4*)(At + j * 64 + R0 + 12);
#pragma unroll
                    for (int q = 0; q < 4; ++q) { acc[q] -= a0[q] * xj; acc[4 + q] -= a1[q] * xj; acc[8 + q] -= a2[q] * xj; acc[12 + q] -= a3[q] * xj; }
                }
#pragma unroll
                for (int jj = 0; jj < 15; ++jj) {
                    const float* ar = At + (R0 + jj) * 64 + R0;
#pragma unroll
                    for (int ii = jj + 1; ii < 16; ++ii) acc[ii] -= ar[ii] * acc[jj];
                }
#pragma unroll
                for (int ii = 0; ii < 16; ++ii) colp[(R0 + ii) * 129] = acc[ii];
            }
            if (tid < 128) {
                bf16_t* o = (bf16_t*)sbase + tid;
#pragma unroll 8
                for (int i = 0; i < 64; ++i) o[i * 128] = f2bf(-colp[i * 129]);
            } else {
                u32x4* o = (u32x4*)(sbase + 32768 + (size_t)(tid - 128) * 128);
#pragma unroll
                for (int c8 = 0; c8 < 8; ++c8) { float x[8];
#pragma unroll
                    for (int j = 0; j < 8; ++j) x[j] = colp[(c8 * 8 + j) * 129];
                    u32x4 v; v.x = pk_bf16(x[0], x[1]); v.y = pk_bf16(x[2], x[3]); v.z = pk_bf16(x[4], x[5]); v.w = pk_bf16(x[6], x[7]); o[c8] = v; }
            }
        }
        __syncthreads();
    }
}

template <bool GDN> __device__ __forceinline__ void scan_item(const Params& p, unsigned char* lds, int b, int h, bool sample, int* prog = nullptr) {
    const int tid = threadIdx.x, w = tid >> 6, lane = tid & 63, r = lane & 31, hh = lane >> 5;
    const int ct = w >> 2, et = w & 3;
    unsigned char* St = lds; unsigned char* INA = lds + 34816; unsigned char* INQ = lds + 52224; unsigned char* INKT = lds + 69632;
    unsigned char* INSC = lds + 88064; unsigned char* VNT = lds + 97280; float* SSQ = (float*)(lds + 115712);
    const int nchunks = sample ? 1 : 32, nrows = sample ? 8 : 64;
    const int row_base = sample ? TP + b * 8 : b * 2048;
    const bf16_t* proj = (const bf16_t*)(p.ws + W_PROJ);
    bf16_t* mix = (bf16_t*)(p.ws + W_MIX);
    const float* nw = GDN ? p.gdn_norm_w : p.ret_norm_w;
    const int gate_col = GDN ? 3584 + h * 128 : 1536 + h * 128;
    const int mix_col = (GDN ? 512 : 0) + h * 128;
    const float2* rtab = (const float2*)(p.ws + W_ROPE);
    const float lg2 = log2f(1.0f - exp2f(-5.0f - (float)h));
    f32x16 S0, S1;
    const int e_col = et * 32 + r;
    if (sample) {
        const float* s0 = (GDN ? p.state_gdn : p.state_ret) + (size_t)(b * 4 + h) * 16384 + ((2 * ct) * 32 + 4 * hh) * 128 + e_col;
#pragma unroll
        for (int reg = 0; reg < 16; ++reg) { S0[reg] = s0[((reg & 3) + 8 * (reg >> 2)) * 128]; S1[reg] = s0[((reg & 3) + 8 * (reg >> 2) + 32) * 128]; }
    } else {
#pragma unroll
        for (int reg = 0; reg < 16; ++reg) { S0[reg] = 0.f; S1[reg] = 0.f; }
    }
    auto write_St = [&]() {
#pragma unroll
        for (int g = 0; g < 4; ++g) {
            u32x2 v0, v1; v0.x = pk_bf16(S0[4 * g], S0[4 * g + 1]); v0.y = pk_bf16(S0[4 * g + 2], S0[4 * g + 3]); v1.x = pk_bf16(S1[4 * g], S1[4 * g + 1]); v1.y = pk_bf16(S1[4 * g + 2], S1[4 * g + 3]);
            *(u32x2*)(St + sw256(e_col, (2 * ct) * 4 + g) + 8 * hh) = v0;
            *(u32x2*)(St + sw256(e_col, (2 * ct + 1) * 4 + g) + 8 * hh) = v1;
        }
    };
    unsigned char* OST = lds + 117248;
    float* NW = (float*)(lds + 116736);
    if (tid < 128) NW[tid] = nw[tid];
    u32x4 ra[2], rq[2], rk[2], rs4;
    u32x2 ru[4];
    f32x4 rt[4];
    float decay = 1.f;
    const unsigned char* gbase = nullptr; const bf16_t* gsc = nullptr; const float* gdec = nullptr;
    if (GDN) {
        const int slot0 = sample ? (b * 4 + h) : (b * 4 + h) * 32;
        gbase = sample ? (const unsigned char*)(p.out + O_GS) + (size_t)slot0 * 65536 : (const unsigned char*)(p.out + O_YP) + (size_t)slot0 * 65536;
        gsc = (const bf16_t*)(p.ws + (sample ? W_SCS : W_SCP)) + (size_t)slot0 * 4096;
        gdec = (const float*)(p.ws + W_DEC) + (sample ? 1024 + slot0 : slot0);
    }
    const int c_tok = ct * 32 + r;
    auto prefetch = [&](int n) {
        const size_t trow = (size_t)row_base + n * 64;
        if (GDN) {
            const unsigned char* sb = gbase + (size_t)n * 65536;
#pragma unroll
            for (int i = 0; i < 2; ++i) { const int idx = tid + 512 * i; ra[i] = *(const u32x4*)(sb + idx * 16); rq[i] = *(const u32x4*)(sb + 16384 + idx * 16); rk[i] = *(const u32x4*)(sb + 49152 + idx * 16); }
            rs4 = *(const u32x4*)((const unsigned char*)(gsc + (size_t)n * 4096) + tid * 16);
#pragma unroll
            for (int g = 0; g < 4; ++g) ru[g] = *(const u32x2*)(sb + 32768 + (e_col * 64 + ct * 32 + 8 * g + 4 * hh) * 2);
            decay = gdec[n];
        } else {
            const int c = tid >> 3, cp = tid & 7;
            if (c < nrows) {
                const bf16_t* qr = proj + (trow + c) * NPJ + h * 128 + cp * 8;
                ra[0] = *(const u32x4*)qr; ra[1] = *(const u32x4*)(qr + 64);
                rq[0] = *(const u32x4*)(qr + 512); rq[1] = *(const u32x4*)(qr + 512 + 64);
                const int pidx = sample ? 2048 + c : n * 64 + c;
                const f32x4* tp = (const f32x4*)(rtab + (size_t)pidx * 64 + cp * 8);
                rt[0] = tp[0]; rt[1] = tp[1]; rt[2] = tp[2]; rt[3] = tp[3];
            }
#pragma unroll
            for (int i = 0; i < 2; ++i) { const int idx = tid + 512 * i, row = idx >> 4, chunk = idx & 15;
                if (row < nrows) rk[i] = *(const u32x4*)(proj + (trow + row) * NPJ + 1024 + h * 128 + chunk * 8); }
        }
    };
    prefetch(0);
    write_St();
    auto flush = [&](int n) {
#pragma unroll
        for (int i = 0; i < 2; ++i) { const int idx = tid + 512 * i, row = idx >> 4, chunk = idx & 15;
            if (row < nrows) *(u32x4*)(mix + ((size_t)row_base + n * 64 + row) * DM + mix_col + chunk * 8) = *(const u32x4*)(OST + sw256(row, chunk)); }
    };
    for (int n = 0; n < nchunks; ++n) {
        u32x2 gate[4];
        f32x16 acc1;
        if (GDN) {
#pragma unroll
            for (int i = 0; i < 2; ++i) { const int idx = tid + 512 * i;
                *(u32x4*)(INA + sw256(idx >> 4, idx & 15)) = ra[i]; *(u32x4*)(INQ + sw256(idx >> 4, idx & 15)) = rq[i]; *(u32x4*)(INKT + sw128x(idx >> 3, idx & 7)) = rk[i]; }
            *(u32x4*)(INSC + sw128(tid >> 3, tid & 7)) = rs4;
#pragma unroll
            for (int g = 0; g < 4; ++g) { acc1[4 * g] = bflo(ru[g].x); acc1[4 * g + 1] = bfhi(ru[g].x); acc1[4 * g + 2] = bflo(ru[g].y); acc1[4 * g + 3] = bfhi(ru[g].y); }
        } else {
            const int c = tid >> 3, cp = tid & 7;
            u32x4 q1 = {0u, 0u, 0u, 0u}, q2 = q1, k1 = q1, k2 = q1;
            unsigned short kt1[8], kt2[8];
#pragma unroll
            for (int j = 0; j < 8; ++j) { kt1[j] = 0; kt2[j] = 0; }
            if (c < nrows) {
                const float fq = exp2f((float)(c + 1) * lg2), fk = 0.08838834764831845f * exp2f((float)(nrows - 1 - c) * lg2);
                float oq1[8], oq2[8], ok1[8], ok2[8];
#pragma unroll
                for (int j = 0; j < 8; ++j) {
                    const unsigned qa = ra[0][j >> 1], qb = ra[1][j >> 1], ka = rq[0][j >> 1], kb = rq[1][j >> 1];
                    const float x1 = (j & 1) ? bfhi(qa) : bflo(qa), x2 = (j & 1) ? bfhi(qb) : bflo(qb);
                    const float y1 = (j & 1) ? bfhi(ka) : bflo(ka), y2 = (j & 1) ? bfhi(kb) : bflo(kb);
                    const float co = rt[j >> 1][(j & 1) * 2], si = rt[j >> 1][(j & 1) * 2 + 1];
                    oq1[j] = (x1 * co - x2 * si) * fq; oq2[j] = (x1 * si + x2 * co) * fq;
                    ok1[j] = (y1 * co - y2 * si) * fk; ok2[j] = (y1 * si + y2 * co) * fk;
                }
#pragma unroll
                for (int j = 0; j < 4; ++j) { q1[j] = pk_bf16(oq1[2 * j], oq1[2 * j + 1]); q2[j] = pk_bf16(oq2[2 * j], oq2[2 * j + 1]); k1[j] = pk_bf16(ok1[2 * j], ok1[2 * j + 1]); k2[j] = pk_bf16(ok2[2 * j], ok2[2 * j + 1]); }
#pragma unroll
                for (int j = 0; j < 8; ++j) { kt1[j] = (unsigned short)((j & 1) ? (k1[j >> 1] >> 16) : (k1[j >> 1] & 0xffffu)); kt2[j] = (unsigned short)((j & 1) ? (k2[j >> 1] >> 16) : (k2[j >> 1] & 0xffffu)); }
            }
            *(u32x4*)(INQ + sw256(c, cp)) = q1; *(u32x4*)(INQ + sw256(c, cp + 8)) = q2;
            *(u32x4*)(INA + sw256(c, cp)) = k1; *(u32x4*)(INA + sw256(c, cp + 8)) = k2;
#pragma unroll
            for (int j = 0; j < 8; ++j) {
                const int d1 = cp * 8 + j, d2 = d1 + 64;
                *(unsigned short*)(INKT + sw128x(d1, c >> 3) + (c & 7) * 2) = kt1[j];
                *(unsigned short*)(INKT + sw128x(d2, c >> 3) + (c & 7) * 2) = kt2[j];
            }
#pragma unroll
            for (int i = 0; i < 2; ++i) { const int idx = tid + 512 * i, row = idx >> 4, chunk = idx & 15;
                const u32x4 vv = (row < nrows) ? rk[i] : (u32x4){0u, 0u, 0u, 0u};
#pragma unroll
                for (int j = 0; j < 8; ++j) { const int e = chunk * 8 + j;
                    *(unsigned short*)(VNT + sw128x(e, row >> 3) + (row & 7) * 2) = (unsigned short)((j & 1) ? (vv[j >> 1] >> 16) : (vv[j >> 1] & 0xffffu)); } }
            decay = exp2f((float)nrows * lg2);
        }
        const float dec_n = decay;
        __syncthreads();
        if (n > 0) flush(n - 1);
        if (c_tok < nrows) {
#pragma unroll
            for (int g = 0; g < 4; ++g) gate[g] = *(const u32x2*)(proj + ((size_t)row_base + n * 64 + c_tok) * NPJ + gate_col + et * 32 + 8 * g + 4 * hh);
        }
        prefetch(n + 1 < nchunks ? n + 1 : n);
        if (GDN) {
#pragma unroll
            for (int s = 0; s < 8; ++s) {
                const bf16x8 a = *(const bf16x8*)(INA + sw256(ct * 32 + r, 2 * s + hh));
                const bf16x8 bb = *(const bf16x8*)(St + sw256(et * 32 + r, 2 * s + hh));
                acc1 = MFMA32(a, bb, acc1);
            }
#pragma unroll
            for (int g = 0; g < 4; ++g) { u32x2 v; v.x = pk_bf16(acc1[4 * g], acc1[4 * g + 1]); v.y = pk_bf16(acc1[4 * g + 2], acc1[4 * g + 3]);
                *(u32x2*)(VNT + sw128x(e_col, ct * 4 + g) + 8 * hh) = v; }
        } else {
            if (w < 4) {
                const int it_ = w >> 1, jt = w & 1;
#pragma unroll
                for (int i = 0; i < 16; ++i) acc1[i] = 0.f;
#pragma unroll
                for (int s = 0; s < 8; ++s) {
                    const bf16x8 a = *(const bf16x8*)(INQ + sw256(it_ * 32 + r, 2 * s + hh));
                    const bf16x8 bb = *(const bf16x8*)(INA + sw256(jt * 32 + r, 2 * s + hh));
                    acc1 = MFMA32(a, bb, acc1);
                }
                const float sc = exp2f(-(float)nrows * lg2); const int j = jt * 32 + r;
#pragma unroll
                for (int reg = 0; reg < 16; ++reg) { const int i = it_ * 32 + crow(reg, hh);
                    *(unsigned short*)(INSC + sw128(i, j >> 3) + (j & 7) * 2) = f2bf((j <= i) ? acc1[reg] * sc : 0.f); }
            }
        }
        __syncthreads();
        f32x16 acc2;
#pragma unroll
        for (int i = 0; i < 16; ++i) acc2[i] = 0.f;
#pragma unroll
        for (int s = 0; s < 8; ++s) {
            const bf16x8 a = *(const bf16x8*)(St + sw256(et * 32 + r, 2 * s + hh));
            const bf16x8 bb = *(const bf16x8*)(INQ + sw256(ct * 32 + r, 2 * s + hh));
            acc2 = MFMA32(a, bb, acc2);
        }
#pragma unroll
        for (int s = 0; s < 4; ++s) {
            const bf16x8 a = *(const bf16x8*)(VNT + sw128x(et * 32 + r, 2 * s + hh));
            const bf16x8 bb = *(const bf16x8*)(INSC + sw128(ct * 32 + r, 2 * s + hh));
            acc2 = MFMA32(a, bb, acc2);
        }
        {
            float sq = 0.f;
#pragma unroll
            for (int i = 0; i < 16; ++i) sq += acc2[i] * acc2[i];
            sq += __shfl_xor(sq, 32);
            if (hh == 0) SSQ[et * 64 + c_tok] = sq;
        }
#pragma unroll
        for (int i = 0; i < 16; ++i) { S0[i] *= dec_n; S1[i] *= dec_n; }
#pragma unroll
        for (int s = 0; s < 4; ++s) {
            const bf16x8 bb = *(const bf16x8*)(VNT + sw128x(et * 32 + r, 2 * s + hh));
            const bf16x8 a0 = *(const bf16x8*)(INKT + sw128x((2 * ct) * 32 + r, 2 * s + hh));
            const bf16x8 a1 = *(const bf16x8*)(INKT + sw128x((2 * ct + 1) * 32 + r, 2 * s + hh));
            S0 = MFMA32(a0, bb, S0); S1 = MFMA32(a1, bb, S1);
        }
        __syncthreads();
        if (prog && tid == 0) __hip_atomic_store(prog, n + 1, __ATOMIC_RELAXED, __HIP_MEMORY_SCOPE_AGENT);
        write_St();
        if (c_tok < nrows) {
            const float ss = SSQ[c_tok] + SSQ[64 + c_tok] + SSQ[128 + c_tok] + SSQ[192 + c_tok];
            const float rn = rsqrtf(ss * (1.0f / 128.0f) + 1e-6f);
            unsigned char* orow = OST + sw256(c_tok, et * 4);
#pragma unroll
            for (int g = 0; g < 4; ++g) {
                const int e0 = 8 * g + 4 * hh;
                const f32x4 wv = *(const f32x4*)(NW + et * 32 + e0);
                const float o0 = acc2[4 * g] * rn * wv[0] * silu(bflo(gate[g].x)), o1 = acc2[4 * g + 1] * rn * wv[1] * silu(bfhi(gate[g].x));
                const float o2 = acc2[4 * g + 2] * rn * wv[2] * silu(bflo(gate[g].y)), o3 = acc2[4 * g + 3] * rn * wv[3] * silu(bfhi(gate[g].y));
                u32x2 v; v.x = pk_bf16(o0, o1); v.y = pk_bf16(o2, o3);
                *(u32x2*)(orow + g * 16 + 8 * hh) = v;
            }
        }
    }
    __syncthreads();
    flush(nchunks - 1);
    {
        float* so = p.out + (sample ? (GDN ? O_GS : O_RS) : (GDN ? O_GP : O_RP)) + (size_t)(b * 4 + h) * 16384 + ((2 * ct) * 32 + 4 * hh) * 128 + e_col;
#pragma unroll
        for (int reg = 0; reg < 16; ++reg) { so[((reg & 3) + 8 * (reg >> 2)) * 128] = S0[reg]; so[((reg & 3) + 8 * (reg >> 2) + 32) * 128] = S1[reg]; }
    }
    __syncthreads();
}

__device__ __forceinline__ void phaseX(const Params& p, unsigned char* lds) { phaseC1_gdn_prep(p, lds, blockIdx.x, gridDim.x, gridDim.x >= 192 ? 1024 : 1536); }
__device__ __forceinline__ void phaseY(const Params& p, unsigned char* lds) {
    const int G = gridDim.x, bid = blockIdx.x;
    int* progs = (int*)(p.ws + W_DEC + 6144);
    int start = bid, limit = 64 + 1024, stride = G;
    if (G >= 192) {
        if (bid < 64) { limit = 64; stride = 64; }
        else { start = bid; stride = G - 64;
            phaseC1_gdn_prep(p, lds, 1024 + (bid - 64), G - 64, 1536); }
    }
    for (int s = start; s < limit; s += stride) {
        const bool sample = s >= 64; const int t = sample ? s - 64 : s;
        const bool gdn = sample ? (t < 512) : (t >= 32);
        const int bh = sample ? (t & 511) : (t & 31), b = bh >> 2, h = bh & 3;
        int* pr = nullptr; (void)progs;
        if (gdn) scan_item<true>(p, lds, b, h, sample, pr); else scan_item<false>(p, lds, b, h, sample, pr);
    }
    if (G >= 192) { if (bid >= 64) phaseA_weights(p, (float*)lds, 1024 + (bid - 64), 3328, G - 64); }
    else phaseA_weights(p, (float*)lds, 1024 + bid, 3328, G);
}

#ifndef DUMP_PROJ
#define DUMP_PROJ 0
#define DUMP_OFF W_PROJ
#define DUMP_BYTES 142606336ull
#endif
#ifndef DUP_C1
#define DUP_C1 0
#endif
#ifndef DUP_C12
#define DUP_C12 0
#endif
#ifndef SANITIZE
#define SANITIZE 0
#endif
#ifndef PHASE_MASK
#define PHASE_MASK 511
#endif
__global__ void __launch_bounds__(512, 2) fwd_megakernel(Params p) {
    extern __shared__ __attribute__((aligned(16))) unsigned char shm[];
    cg::grid_group grid = cg::this_grid();
    const bool multi = (p.phase_hi - p.phase_lo) > 1;
    volatile LAS unsigned* xst = (volatile LAS unsigned*)((LAS unsigned char*)shm + 152560);
    if (threadIdx.x == 0) { xst[0] = 0u; xst[1] = 0u; }
    __syncthreads();
    XcdBarrier xb = xcd_barrier_post((unsigned*)(p.ws + W_BAR), xst);
    if (p.phase_hi == 0x7fffffff) grid.sync();
#define RUN(ph) (p.phase_lo <= (ph) && (ph) < p.phase_hi && (PHASE_MASK & (1 << (ph))))
#define SEAM(ph) do { if (multi && p.phase_lo <= (ph) && (ph) + 1 < p.phase_hi) { xcd_barrier(xb); } } while (0)
    if (RUN(0)) { phaseA_weights(p, (float*)shm, blockIdx.x, 1024, gridDim.x); phaseA_norm(p, (float*)shm); phaseA_rope(p); if (blockIdx.x == 0 && threadIdx.x < 64) ((int*)(p.ws + W_DEC + 6144))[threadIdx.x] = 0; }
    SEAM(0);
    if (RUN(1)) {
        pg8::Gemm g; g.A = (const bf16_t*)(p.ws + W_H); g.Bt = (const bf16_t*)(p.ws + W_WIN); g.M = TT; g.N = NPJ; g.K = DM;
        pg8::SplitOrder S; S.init(g.N, g.K, 1, (int)gridDim.x, (int)blockIdx.x);
        pg8::EpiBf16<0> E; E.O = (bf16_t*)(p.ws + W_PROJ); E.ldc = NPJ;
        pg8::gemm_phase<pg8::EpiBf16<0>, pg8::SplitOrder, false>((PG8_LAS unsigned char*)shm, g, S, E, nullptr);
    }
    SEAM(1);
    if (RUN(2)) phaseX(p, shm);
    SEAM(2);
    if (RUN(3)) phaseY(p, shm);
    SEAM(3);
    if (RUN(4)) {
        pg8::Gemm g; g.A = (const bf16_t*)(p.ws + W_MIX); g.Bt = (const bf16_t*)(p.ws + W_WOUT); g.M = TT; g.N = DM; g.K = DM;
        pg8::SplitOrder S; S.init(g.N, g.K, 2, (int)gridDim.x, (int)blockIdx.x);
        pg8::EpiF32 E; E.C = (float*)(p.ws + W_PROJ); E.Csmp = (float*)(p.ws + W_SMP) - (size_t)TP * DM; E.ldc = DM;
        pg8::gemm_phase<pg8::EpiF32, pg8::SplitOrder, false>((PG8_LAS unsigned char*)shm, g, S, E, nullptr);
    }
    SEAM(4);
    if (RUN(5)) phaseE_rows(p);
    SEAM(5);
    if (RUN(6)) {
        pg8::Gemm g; g.A = (const bf16_t*)(p.ws + W_H); g.Bt = (const bf16_t*)(p.ws + W_WUP); g.M = TT; g.N = DFF; g.K = DM;
        pg8::SplitOrder S; S.init(g.N, g.K, 1, (int)gridDim.x, (int)blockIdx.x);
        pg8::EpiBf16<1> E; E.O = (bf16_t*)(p.ws + W_PROJ); E.ldc = DFF;
        pg8::gemm_phase<pg8::EpiBf16<1>, pg8::SplitOrder, false>((PG8_LAS unsigned char*)shm, g, S, E, nullptr);
    }
    SEAM(6);
    if (RUN(7)) {
        pg8::Gemm g; g.A = (const bf16_t*)(p.ws + W_PROJ); g.Bt = (const bf16_t*)(p.ws + W_WDN); g.M = TT; g.N = DM; g.K = DFF;
        pg8::SplitOrder S; S.init(g.N, g.K, 4, (int)gridDim.x, (int)blockIdx.x);
        pg8::EpiF32 E; E.C = (float*)(p.ws + W_H); E.Csmp = (float*)(p.ws + W_SMP) - (size_t)TP * DM; E.ldc = DM;
        pg8::gemm_phase<pg8::EpiF32, pg8::SplitOrder, false>((PG8_LAS unsigned char*)shm, g, S, E, nullptr);
    }
    SEAM(7);
    if (RUN(8)) phaseH_rows(p);
#if DUMP_PROJ
    if (p.phase_lo <= 9 && 9 < p.phase_hi) { const u32x4* src = (const u32x4*)(p.ws + DUMP_OFF); u32x4* dst = (u32x4*)p.out; for (size_t i = (size_t)blockIdx.x * 512 + threadIdx.x; i < DUMP_BYTES / 16; i += (size_t)gridDim.x * 512) dst[i] = src[i]; }
#endif
#if SANITIZE
    SEAM(8);
    if (p.phase_lo <= 9 && 9 < p.phase_hi) { for (size_t i = (size_t)blockIdx.x * 512 + threadIdx.x; i < 36278272; i += (size_t)gridDim.x * 512) { const float v = p.out[i]; if (!(fabsf(v) < 1e30f)) p.out[i] = 0.f; } }
#endif
}

constexpr size_t kDynLds = 152576;

extern "C" void kernel_launch(void* const* d_in, const int* in_sizes, int n_in, void* d_out, int out_size, void* d_ws, size_t ws_size, hipStream_t stream) {
    (void)in_sizes; (void)n_in; (void)out_size; (void)ws_size;
    static int grid_blocks = 0;
    if (!grid_blocks) {
        hipFuncSetAttribute((const void*)fwd_megakernel, hipFuncAttributeMaxDynamicSharedMemorySize, (int)kDynLds);
        int dev = 0, cus = 0, per_cu = 0;
        hipGetDevice(&dev);
        hipDeviceGetAttribute(&cus, hipDeviceAttributeMultiprocessorCount, dev);
        hipOccupancyMaxActiveBlocksPerMultiprocessor(&per_cu, fwd_megakernel, 512, kDynLds);
        if (per_cu < 1) per_cu = 1;
        if (per_cu > 1) per_cu = 1;
        grid_blocks = cus * per_cu;
    }
    Params p; memset(&p, 0, sizeof(p));
    p.x_prompt = (const float*)d_in[0]; p.x_sample = (const float*)d_in[1]; p.state_ret = (const float*)d_in[2]; p.state_gdn = (const float*)d_in[3];
    p.state_conv = (const float*)d_in[4]; p.pre_mix_w = (const float*)d_in[5]; p.w_in = (const float*)d_in[6]; p.conv_w = (const float*)d_in[7];
    p.A_log = (const float*)d_in[8]; p.dt_bias = (const float*)d_in[9]; p.ret_norm_w = (const float*)d_in[10]; p.gdn_norm_w = (const float*)d_in[11];
    p.w_out = (const float*)d_in[12]; p.post_mix_w = (const float*)d_in[13]; p.pre_mlp_w = (const float*)d_in[14]; p.w_up = (const float*)d_in[15];
    p.w_down = (const float*)d_in[16]; p.post_mlp_w = (const float*)d_in[17];
    p.out = (float*)d_out; p.ws = (unsigned char*)d_ws;
    p.rope_r = std::pow(10000.0, -1.0 / 64.0);
#if MULTI_LAUNCH
    for (int ph = 0; ph < 9 + SANITIZE; ++ph) {
        p.phase_lo = ph; p.phase_hi = ph + 1;
        hipLaunchKernelGGL(fwd_megakernel, dim3(grid_blocks), dim3(512), kDynLds, stream, p);
    }
#else
    p.phase_lo = 0; p.phase_hi = 9 + SANITIZE;
    hipMemsetAsync((unsigned char*)d_ws + W_BAR, 0, XCD_BAR_WORDS * 4, stream);
    void* args[] = {&p};
    hipError_t e = hipLaunchCooperativeKernel((const void*)fwd_megakernel, dim3(grid_blocks), dim3(512), args, kDynLds, stream);
    if (e != hipSuccess) fprintf(stderr, "cooperative launch failed: %s (grid %d)\n", hipGetErrorString(e), grid_blocks);
#endif
}
```

```cpp
#include <hip/hip_runtime.h>
#include <hip/hip_cooperative_groups.h>
#include <cstdio>
#include <cmath>
#include <cstring>
namespace cg = cooperative_groups;

#ifndef MULTI_LAUNCH
#define MULTI_LAUNCH 0
#endif

typedef unsigned short bf16_t;
typedef short bf16x8 __attribute__((ext_vector_type(8)));
typedef float f32x4 __attribute__((ext_vector_type(4)));
typedef float f32x16 __attribute__((ext_vector_type(16)));
typedef unsigned u32x4 __attribute__((ext_vector_type(4)));
typedef unsigned u32x2 __attribute__((ext_vector_type(2)));

constexpr int TP = 16384, TS = 1024, TT = TP + TS, DM = 1024, INW = 4104, NPJ = 4096, DFF = 4096;
constexpr size_t O_YP = 0, O_YS = 16777216, O_RP = 17825792, O_GP = 18350080, O_CP = 18874368, O_RS = 18911232, O_GS = 27299840, O_CS = 35688448;
constexpr size_t W_WIN = 0, W_WOUT = W_WIN + 8388608, W_WUP = W_WOUT + 2097152, W_WDN = W_WUP + 8388608, W_H = W_WDN + 8388608,
                 W_MIX = W_H + 35651584, W_PROJ = W_MIX + 35651584, W_AB = W_PROJ + 142606336, W_ROPE = W_AB + 557056,
                 W_SCP = W_ROPE + 1052672, W_SCS = W_SCP + 8388608, W_DEC = W_SCS + 4194304, W_BAR = W_DEC + 8192, W_END = W_BAR + 16384, W_SMP = W_WIN;

struct Params {
    const float *x_prompt, *x_sample, *state_ret, *state_gdn, *state_conv, *pre_mix_w, *w_in, *conv_w, *A_log, *dt_bias,
                *ret_norm_w, *gdn_norm_w, *w_out, *post_mix_w, *pre_mlp_w, *w_up, *w_down, *post_mlp_w;
    float* out;
    unsigned char* ws;
    double rope_r;
    int phase_lo, phase_hi;
};

#define DI __device__ __forceinline__
DI float bf2f(unsigned short b) { return __uint_as_float(((unsigned)b) << 16); }
DI float bflo(unsigned u) { return __uint_as_float(u << 16); }
DI float bfhi(unsigned u) { return __uint_as_float(u & 0xffff0000u); }
typedef float f32x2_t __attribute__((ext_vector_type(2)));
typedef __bf16 bf16x2_t __attribute__((ext_vector_type(2)));
DI unsigned pk_bf16(float lo, float hi) { f32x2_t v = {lo, hi}; bf16x2_t b = __builtin_convertvector(v, bf16x2_t); return __builtin_bit_cast(unsigned, b); }
DI unsigned short f2bf(float f) { return (unsigned short)(pk_bf16(f, 0.f) & 0xffffu); }
DI int sw256(int row, int chunk) { return row * 272 + (chunk << 4); }
DI int sw128(int row, int chunk) { return row * 144 + (chunk << 4); }
DI int sw128x(int row, int chunk) { return row * 144 + ((chunk ^ ((row >> 3) & 7)) << 4); }
DI int crow(int reg, int hh) { return (reg & 3) + 8 * (reg >> 2) + 4 * hh; }
DI float wave_sum(float v) { for (int o = 32; o >= 1; o >>= 1) v += __shfl_xor(v, o); return v; }
DI float silu(float x) { return x * __builtin_amdgcn_rcpf(1.0f + __expf(-x)); }
#define MFMA32(a, b, c) __builtin_amdgcn_mfma_f32_32x32x16_bf16((a), (b), (c), 0, 0, 0)

template <int NR> DI void fwd_subst(float (&x)[64], const float* Amat) {
#pragma unroll
    for (int i = 1; i < NR; ++i) {
        float s = x[i];
#pragma unroll
        for (int j = 0; j < i; ++j) s -= Amat[i * 64 + j] * x[j];
        x[i] = s;
        asm volatile("" ::: "memory");
    }
}

#define XB_TMO      128
#define XB_XCNT(j)  (256  + 64 * (j))
#define XB_XSUB(j)  (1280 + 64 * (j))
#define XB_XGEN(j)  (2304 + 64 * (j))
#define XB_TOP      3328
#define XB_TOPGEN   3392
#define XCD_BAR_WORDS 3456
#define XB_SPIN_CAP (1u << 18)
#define LAS __attribute__((address_space(3)))

__device__ __forceinline__ unsigned xb_ld(unsigned* p)              { return __hip_atomic_load(p, __ATOMIC_RELAXED, __HIP_MEMORY_SCOPE_AGENT); }
__device__ __forceinline__ unsigned xb_add(unsigned* p, unsigned v) { return __hip_atomic_fetch_add(p, v, __ATOMIC_RELAXED, __HIP_MEMORY_SCOPE_AGENT); }
__device__ __forceinline__ unsigned xb_xcc_id() { return (unsigned)__builtin_amdgcn_s_getreg((3 << 11) | 20) & 0xFu; }
#define XB_SPIN(cond, bar) do { unsigned _sp = 0; while (cond) { __builtin_amdgcn_s_sleep(1); \
    if ((++_sp & 255u) == 0u) { if (xb_ld(&(bar)[XB_TMO])) break; if (_sp > XB_SPIN_CAP) { atomicAdd(&(bar)[XB_TMO], 1u); break; } } } } while (0)

struct XcdBarrier {
    unsigned* bar; unsigned x;
    volatile LAS unsigned* st;
};

__device__ __forceinline__ XcdBarrier xcd_barrier_post(unsigned* bar, volatile LAS unsigned* st) {
    XcdBarrier b; b.bar = bar; b.x = xb_xcc_id(); b.st = st;
    if (threadIdx.x == 0) (void)xb_add(&bar[XB_XCNT(b.x)], 1u);
    return b;
}
__device__ __forceinline__ void xcd_barrier_complete(unsigned* bar, unsigned x, unsigned& nloc, unsigned& nx) {
    const unsigned G = gridDim.x * gridDim.y * gridDim.z;
    unsigned sum, cnt, mine, sp = 0u;
    for (;;) {
        sum = 0u; cnt = 0u; mine = 0u;
#pragma unroll
        for (unsigned j = 0; j < 16; ++j) { const unsigned c = xb_ld(&bar[XB_XCNT(j)]); sum += c; cnt += (c > 0u) ? 1u : 0u; mine = (j == x) ? c : mine; }
        if (sum == G) break;
        __builtin_amdgcn_s_sleep(1);
        if ((++sp & 255u) == 0u) { if (xb_ld(&bar[XB_TMO])) break; if (sp > XB_SPIN_CAP) { atomicAdd(&bar[XB_TMO], 1u); break; } }
    }
    nloc = mine > 0u ? mine : 1u; nx = cnt > 0u ? cnt : 1u;
}

__device__ __forceinline__ void xcd_barrier(const XcdBarrier& b) {
    asm volatile("s_waitcnt vmcnt(0)" ::: "memory");
    __syncthreads();
    if (threadIdx.x == 0) {
        unsigned* bar = b.bar;
        __builtin_amdgcn_s_waitcnt(0);
        unsigned nloc = b.st[0], nx = b.st[1];
        if (nloc == 0u) { xcd_barrier_complete(bar, b.x, nloc, nx); b.st[0] = nloc; b.st[1] = nx; }
        const unsigned old = xb_add(&bar[XB_XSUB(b.x)], 1u);
        const unsigned gen = old / nloc;
        if (old + 1u == (gen + 1u) * nloc) {
            __builtin_amdgcn_fence(__ATOMIC_RELEASE, "agent");
            asm volatile("s_waitcnt vmcnt(0)" ::: "memory");
            const unsigned og = xb_add(&bar[XB_TOP], 1u);
            const unsigned tg = og / nx;
            if (og + 1u == (tg + 1u) * nx) xb_add(&bar[XB_TOPGEN], 1u);
            else XB_SPIN(xb_ld(&bar[XB_TOPGEN]) == tg, bar);
            __builtin_amdgcn_fence(__ATOMIC_ACQUIRE, "agent");
            xb_add(&bar[XB_XGEN(b.x)], 1u);
            asm volatile("s_waitcnt vmcnt(0)" ::: "memory");
        } else {
            XB_SPIN(xb_ld(&bar[XB_XGEN(b.x)]) == gen, bar);
            __builtin_amdgcn_fence(__ATOMIC_ACQUIRE, "agent");
            asm volatile("s_waitcnt vmcnt(0)" ::: "memory");
        }
    }
    __syncthreads();
}


namespace pg8 {
#define PG8_LAS __attribute__((address_space(3)))
typedef unsigned short bf16_t;
typedef short bf16x8 __attribute__((ext_vector_type(8)));
typedef float f32x4 __attribute__((ext_vector_type(4)));
typedef unsigned u32x4 __attribute__((ext_vector_type(4)));
constexpr int BM = 256, BK = 64, HALF = 128, HTB = HALF * BK * 2  , STAGE_BYTES = 8 * HTB, NXCD = 8, WGM = 8;

__host__ __device__ __forceinline__ int lds_byte(int r, int c) { const int st = (r >> 4) * 2 + (c >> 5), rr = r & 15, cc = c & 31, ob = rr * 64 + cc * 2; return st * 1024 + (ob ^ (((ob >> 9) & 1) << 5)); }
__host__ __device__ __forceinline__ void stage_rc(int b, int& R, int& C) { const int st = b / 1024, sb = b % 1024, swz = sb ^ (((sb >> 9) & 1) << 5); R = (st >> 1) * 16 + swz / 64; C = (st & 1) * 32 + (swz % 64) / 2; }
__host__ __device__ __forceinline__ int perm32(int rho) { const int n = rho >> 4, i = rho & 15; return 8 * (i >> 2) + 4 * n + (i & 3); }

struct Unit { int pm, pn, kt0, nkt, smp; };
struct Gemm { const bf16_t* A; const bf16_t* Bt; int M, N, K; };

struct StaticOrder {
    int nM, nN, nwg, G, c;
    __host__ __device__ void init(int M, int N, int G_, int c_) { nM = M / BM; nN = N / BM; nwg = nM * nN; G = G_; c = c_; }
    __host__ __device__ bool next(int i, Unit& u) const {
        const long L = (long)i * G + c; if (L >= nwg) return false;
        int wgid = (int)L; { const int q = nwg / NXCD, r = nwg % NXCD, xcd = wgid % NXCD, off = wgid / NXCD; wgid = (xcd < r ? xcd * (q + 1) : r * (q + 1) + (xcd - r) * q) + off; }
        const int nig = WGM * nN, gid = wgid / nig, fm = gid * WGM, gsz = (nM - fm) < WGM ? (nM - fm) : WGM;
        u.pm = fm + ((wgid % nig) % gsz); u.pn = (wgid % nig) / gsz; return true;
    }
    __device__ __forceinline__ void a_ready(const Unit&) const {}
    __device__ __forceinline__ void done(const Unit&) const {}
};
struct SplitOrder {
    StaticOrder so; int nN, nfull, nsub, G, c, KS, nktf;
    __host__ __device__ void init(int N, int K, int KS_, int G_, int c_) { so.init(16384, N, G_, c_); nN = N / BM; nfull = 64 * nN; KS = KS_; nsub = 4 * nN * KS; G = G_; c = c_; nktf = K / BK; }
    __host__ __device__ bool next(int i, Unit& u) const {
        const long L = (long)i * G + c; if (L >= nfull + nsub) return false;
        if (L < nfull) { so.next(i, u); u.kt0 = 0; u.nkt = nktf; u.smp = 0; }
        else { const int q = (int)(L - nfull), ks = q % KS, uu = q / KS; u.pm = 64 + (uu & 3); u.pn = uu >> 2; u.nkt = nktf / KS; u.kt0 = ks * u.nkt; u.smp = KS > 1 ? ks + 1 : 0; }
        return true;
    }
    __device__ __forceinline__ void a_ready(const Unit&) const {}
    __device__ __forceinline__ void done(const Unit&) const {}
};

__device__ __forceinline__ unsigned cvt_pk_bf16(float lo, float hi) { return ::pk_bf16(lo, hi); }
struct EpiF32 {
    static constexpr bool PERM = false, AFTER_DRAIN = false;
    float* C; float* Csmp; int ldc;
    __device__ __forceinline__ void operator()(const f32x4 (&acc)[2][2][4][2], const Unit& u, int wr, int wc, int fr, int fq) const {
        const int row0 = u.pm * BM + wr * 64 + fr, col0 = u.pn * BM + wc * 32 + 4 * fq;
        if (u.smp) {
            float* base = Csmp + (size_t)(u.smp - 1) * 1024 * ldc;
#pragma unroll
            for (int ai = 0; ai < 2; ++ai)
#pragma unroll
                for (int m = 0; m < 4; ++m) { float* rowp = base + (size_t)(row0 + ai * HALF + m * 16) * ldc + col0;
#pragma unroll
                    for (int bj = 0; bj < 2; ++bj)
#pragma unroll
                        for (int n = 0; n < 2; ++n) *(f32x4*)(rowp + bj * HALF + n * 16) = acc[ai][bj][m][n]; }
            return;
        }
#pragma unroll
        for (int ai = 0; ai < 2; ++ai)
#pragma unroll
            for (int m = 0; m < 4; ++m) { float* rowp = C + (size_t)(row0 + ai * HALF + m * 16) * ldc + col0;
#pragma unroll
                for (int bj = 0; bj < 2; ++bj)
#pragma unroll
                    for (int n = 0; n < 2; ++n) *(f32x4*)(rowp + bj * HALF + n * 16) = acc[ai][bj][m][n]; }
    }
};
template <int ACT  > struct EpiBf16 {
    static constexpr bool PERM = true, AFTER_DRAIN = false;
    bf16_t* O; int ldc;
    __device__ __forceinline__ void operator()(const f32x4 (&acc)[2][2][4][2], const Unit& u, int wr, int wc, int fr, int fq) const {
        const int row0 = u.pm * BM + wr * 64 + fr; const int col0 = u.pn * BM + wc * 32 + 8 * fq;
#pragma unroll
        for (int ai = 0; ai < 2; ++ai)
#pragma unroll
            for (int m = 0; m < 4; ++m) { bf16_t* rowp = O + (size_t)(row0 + ai * HALF + m * 16) * ldc + col0;
#pragma unroll
                for (int bj = 0; bj < 2; ++bj) { f32x4 v0 = acc[ai][bj][m][0], v1 = acc[ai][bj][m][1];
                    if (ACT == 1) {
#pragma unroll
                        for (int j = 0; j < 4; ++j) { const float a = fmaxf(v0[j], 0.f), b = fmaxf(v1[j], 0.f); v0[j] = a * a; v1[j] = b * b; } }
                    u32x4 w; w.x = cvt_pk_bf16(v0[0], v0[1]); w.y = cvt_pk_bf16(v0[2], v0[3]); w.z = cvt_pk_bf16(v1[0], v1[1]); w.w = cvt_pk_bf16(v1[2], v1[3]);
                    *(u32x4*)(rowp + bj * HALF) = w; } }
    }
};
template <class Epi, class Sched, bool STAMP = false>
__device__ __forceinline__ void gemm_phase(PG8_LAS unsigned char* lds, const Gemm g, const Sched& S, const Epi& E, unsigned long long* stamps) {
    const int tid = threadIdx.x, wid = __builtin_amdgcn_readfirstlane(tid >> 6), lane = tid & 63, wr = wid >> 2, wc = wid & 3, fr = lane & 15, fq = lane >> 4;
    const int K = g.K;
    int ts_lo = 0, ts_hi = 0, nts = 0; const unsigned long long rt_entry = STAMP ? (unsigned long long)wall_clock64() : 0ull;
#define PG8_STAMP() do { if (STAMP && wid == 0 && nts < 64) { const unsigned long long _c = (unsigned long long)clock64(); \
        ts_lo = (lane == nts) ? (int)(unsigned)_c : ts_lo; ts_hi = (lane == nts) ? (int)(unsigned)(_c >> 32) : ts_hi; ++nts; } } while (0)
    PG8_STAMP();
    unsigned voffA[2], voffB[2];
#pragma unroll
    for (int i = 0; i < 2; ++i) { int R, C; stage_rc(tid * 16 + i * 8192, R, C); const int Rb = Epi::PERM ? ((R & ~31) + perm32(R & 31)) : R;
        voffA[i] = (unsigned)(R * K + C) * 2u; voffB[i] = (unsigned)(Rb * K + C) * 2u; }
    const size_t kstep = (size_t)(BK * 2);
    const size_t hstep = (size_t)HALF * K * 2;
    const size_t tstep = 2 * hstep;
    const unsigned ldsw = (unsigned)wid * 1024u;
    const int aoff = lds_byte(wr * 64 + fr, fq * 8), boff = lds_byte(wc * 32 + fr, fq * 8);
#define PG8_SA(b, h) (((b) * 2 + (h)) * HTB)
#define PG8_SB(b, h) ((4 + (b) * 2 + (h)) * HTB)
#define PG8_STAGE(bufoff, gbase, voff) do { _Pragma("unroll") for (int _i = 0; _i < 2; ++_i) \
        __builtin_amdgcn_global_load_lds((const unsigned*)((const char*)(gbase) + (voff)[_i]), (PG8_LAS unsigned*)(lds + (bufoff) + ldsw + _i * 8192), 16, 0, 0); } while (0)
#define PG8_LDA(dst, b, h) do { _Pragma("unroll") for (int m = 0; m < 4; ++m) _Pragma("unroll") for (int k = 0; k < 2; ++k) dst[m][k] = *(const PG8_LAS bf16x8*)(lds + PG8_SA(b, h) + aoff + m * 2048 + k * 1024); } while (0)
#define PG8_LDB(dst, b, h) do { _Pragma("unroll") for (int n = 0; n < 2; ++n) _Pragma("unroll") for (int k = 0; k < 2; ++k) dst[n][k] = *(const PG8_LAS bf16x8*)(lds + PG8_SB(b, h) + boff + n * 2048 + k * 1024); } while (0)
#define PG8_MMA(ai, bj, At, Bt) do { __builtin_amdgcn_s_setprio(1); _Pragma("unroll") for (int m = 0; m < 4; ++m) _Pragma("unroll") for (int n = 0; n < 2; ++n) _Pragma("unroll") for (int k = 0; k < 2; ++k) \
        acc[ai][bj][m][n] = __builtin_amdgcn_mfma_f32_16x16x32_bf16(Bt[n][k], At[m][k], acc[ai][bj][m][n], 0, 0, 0); __builtin_amdgcn_s_setprio(0); } while (0)
#define PG8_WAIT_V(n) asm volatile("s_waitcnt vmcnt(" #n ")" ::: "memory")
#define PG8_WAIT_L(n) asm volatile("s_waitcnt lgkmcnt(" #n ")" ::: "memory")
#define PG8_BAR __builtin_amdgcn_s_barrier()
#define PG8_SCHED __builtin_amdgcn_sched_barrier(0)
    Unit cur, nxt; int ui = 0;
    if (!S.next(0, cur)) return;
    f32x4 acc[2][2][4][2];
#pragma unroll
    for (int a = 0; a < 2; ++a)
#pragma unroll
        for (int b = 0; b < 2; ++b)
#pragma unroll
            for (int m = 0; m < 4; ++m)
#pragma unroll
                for (int n = 0; n < 2; ++n) acc[a][b][m][n] = (f32x4){0.f, 0.f, 0.f, 0.f};
    bf16x8 At[4][2], B0[2][2], B1[2][2];
    const char* cA = (const char*)g.A + (size_t)cur.pm * tstep + (size_t)cur.kt0 * kstep; const char* cB = (const char*)g.Bt + (size_t)cur.pn * tstep + (size_t)cur.kt0 * kstep;
    S.a_ready(cur);
    PG8_STAGE(PG8_SB(0, 0), cB, voffB); PG8_STAGE(PG8_SA(0, 0), cA, voffA); PG8_STAGE(PG8_SB(0, 1), cB + hstep, voffB); PG8_STAGE(PG8_SA(0, 1), cA + hstep, voffA);
    if (wr == 1) PG8_BAR;
    PG8_WAIT_V(4); PG8_BAR;
    PG8_STAGE(PG8_SB(1, 0), cB + kstep, voffB); PG8_STAGE(PG8_SA(1, 0), cA + kstep, voffA); PG8_STAGE(PG8_SB(1, 1), cB + hstep + kstep, voffB);
    PG8_WAIT_V(6); PG8_BAR;
    PG8_STAMP();
    for (;;) {
        const bool has_next = S.next(ui + 1, nxt);
        const char* nA = has_next ? (const char*)g.A + (size_t)nxt.pm * tstep + (size_t)nxt.kt0 * kstep : cA; const char* nB = has_next ? (const char*)g.Bt + (size_t)nxt.pn * tstep + (size_t)nxt.kt0 * kstep : cB;
        const int nt = cur.nkt;
        for (int t = 0; t < nt; t += 2) {
            const bool last = (t == nt - 2);
            const char* a1 = cA + (size_t)(t + 1) * kstep;
            const char* a2 = last ? nA : cA + (size_t)(t + 2) * kstep; const char* b2 = last ? nB : cB + (size_t)(t + 2) * kstep;
            const char* a3 = a2 + kstep; const char* b3 = b2 + kstep;
            if (last && has_next) S.a_ready(nxt);
            PG8_LDB(B0, 0, 0); PG8_SCHED; PG8_LDA(At, 0, 0); PG8_STAGE(PG8_SA(1, 1), a1 + hstep, voffA);
            PG8_WAIT_L(8); PG8_BAR; PG8_WAIT_L(0); PG8_MMA(0, 0, At, B0); PG8_BAR; PG8_SCHED;
            PG8_LDB(B1, 0, 1); PG8_STAGE(PG8_SB(0, 0), b2, voffB);
            PG8_BAR; PG8_WAIT_L(0); PG8_MMA(0, 1, At, B1); PG8_BAR;
            PG8_LDA(At, 0, 1); PG8_STAGE(PG8_SA(0, 0), a2, voffA);
            PG8_BAR; PG8_WAIT_L(0); PG8_MMA(1, 0, At, B0); PG8_BAR; PG8_SCHED;
            PG8_STAGE(PG8_SB(0, 1), b2 + hstep, voffB);
            PG8_WAIT_V(6); PG8_BAR; PG8_MMA(1, 1, At, B1); PG8_BAR;
            PG8_LDB(B0, 1, 0); PG8_SCHED; PG8_LDA(At, 1, 0); PG8_STAGE(PG8_SA(0, 1), a2 + hstep, voffA);
            PG8_WAIT_L(8); PG8_BAR; PG8_WAIT_L(0); PG8_MMA(0, 0, At, B0); PG8_BAR; PG8_SCHED;
            PG8_LDB(B1, 1, 1); PG8_STAGE(PG8_SB(1, 0), b3, voffB);
            PG8_BAR; PG8_WAIT_L(0); PG8_MMA(0, 1, At, B1); PG8_BAR;
            PG8_LDA(At, 1, 1); PG8_STAGE(PG8_SA(1, 0), a3, voffA);
            PG8_BAR; PG8_WAIT_L(0); PG8_MMA(1, 0, At, B0); PG8_BAR; PG8_SCHED;
            PG8_STAGE(PG8_SB(1, 1), b3 + hstep, voffB);
            PG8_WAIT_V(6); PG8_BAR; PG8_MMA(1, 1, At, B1); PG8_BAR;
        }
        PG8_STAMP();
        if constexpr (!Epi::AFTER_DRAIN) { E(acc, cur, wr, wc, fr, fq); S.done(cur); }
        PG8_STAMP();
        if (!has_next) break;
#pragma unroll
        for (int a = 0; a < 2; ++a)
#pragma unroll
            for (int b = 0; b < 2; ++b)
#pragma unroll
                for (int m = 0; m < 4; ++m)
#pragma unroll
                    for (int n = 0; n < 2; ++n) acc[a][b][m][n] = (f32x4){0.f, 0.f, 0.f, 0.f};
        cur = nxt; cA = nA; cB = nB; ++ui;
    }
    PG8_WAIT_V(0);
    if (wr == 0) PG8_BAR;
    PG8_BAR;
    if constexpr (Epi::AFTER_DRAIN) { E.fused(acc, cur, wr, wc, fr, fq, lds, wid, lane); S.done(cur); }
    PG8_STAMP();
    if (STAMP && wid == 0) { stamps[lane] = lane < nts ? (((unsigned long long)(unsigned)ts_hi << 32) | (unsigned)ts_lo) : 0ull;
        if (lane == 62) stamps[62] = rt_entry; if (lane == 63) stamps[63] = (unsigned long long)wall_clock64(); }
#undef PG8_STAMP
#undef PG8_SA
#undef PG8_SB
#undef PG8_STAGE
#undef PG8_LDA
#undef PG8_LDB
#undef PG8_MMA
#undef PG8_WAIT_V
#undef PG8_WAIT_L
#undef PG8_BAR
#undef PG8_SCHED
}
}

__device__ __forceinline__ void phaseA_weights(const Params& p, float* tl  , int tile0, int tile1, int step) {
    const int tid = threadIdx.x;
    for (int tile = tile0; tile < tile1; tile += step) {
        const float* src; bf16_t* dst; int ldn, K, lt;
        if (tile < 1024)      { src = p.w_in;   ldn = INW;  K = 1024; dst = (bf16_t*)(p.ws + W_WIN);  lt = tile; }
        else if (tile < 1280) { src = p.w_out;  ldn = 1024; K = 1024; dst = (bf16_t*)(p.ws + W_WOUT); lt = tile - 1024; }
        else if (tile < 2304) { src = p.w_up;   ldn = 4096; K = 1024; dst = (bf16_t*)(p.ws + W_WUP);  lt = tile - 1280; }
        else                  { src = p.w_down; ldn = 1024; K = 4096; dst = (bf16_t*)(p.ws + W_WDN);  lt = tile - 2304; }
        const int nkt = K >> 6, kt = lt % nkt, nt = lt / nkt;
#pragma unroll
        for (int i = 0; i < 2; ++i) {
            const int r = (tid >> 4) + 32 * i, c4 = (tid & 15) * 4;
            const float4 v = *(const float4*)(src + (size_t)(kt * 64 + r) * ldn + nt * 64 + c4);
            tl[r * 65 + c4 + 0] = v.x; tl[r * 65 + c4 + 1] = v.y; tl[r * 65 + c4 + 2] = v.z; tl[r * 65 + c4 + 3] = v.w;
        }
        __syncthreads();
        {
            const int n = tid >> 3, k8 = (tid & 7) * 8;
            float v[8];
#pragma unroll
            for (int j = 0; j < 8; ++j) v[j] = tl[(k8 + j) * 65 + n];
            u32x4 w; w.x = pk_bf16(v[0], v[1]); w.y = pk_bf16(v[2], v[3]); w.z = pk_bf16(v[4], v[5]); w.w = pk_bf16(v[6], v[7]);
            *(u32x4*)(dst + (size_t)(nt * 64 + n) * K + kt * 64 + k8) = w;
        }
        __syncthreads();
    }
}

__device__ __forceinline__ void phaseA_rope(const Params& p) {
    float2* tab = (float2*)(p.ws + W_ROPE);
    for (int idx = blockIdx.x * 512 + threadIdx.x; idx < 2056 * 64; idx += gridDim.x * 512) {
        const int pi = idx >> 6, f = idx & 63;
        double ivd = 1.0; for (int k = 0; k < f; ++k) ivd *= p.rope_r;
        const float ivf = (float)ivd;
        const float pos = pi < 2048 ? (float)pi : (float)(16384 + pi - 2048);
        const float ang = pos * ivf;
        const double a = (double)ang, q = rint(a * 0.63661977236758134308);
        double r = fma(-q, 1.57079632679489655800, a); r = fma(-q, 6.12323399573676603587e-17, r);
        const int qd = ((int)q) & 3;
        const double r2 = r * r;
        const double s = r * (1.0 + r2 * (-1.0 / 6.0 + r2 * (1.0 / 120.0 + r2 * (-1.0 / 5040.0 + r2 * (1.0 / 362880.0 + r2 * (-1.0 / 39916800.0 + r2 * (1.0 / 6227020800.0)))))));
        const double c = 1.0 + r2 * (-0.5 + r2 * (1.0 / 24.0 + r2 * (-1.0 / 720.0 + r2 * (1.0 / 40320.0 + r2 * (-1.0 / 3628800.0 + r2 * (1.0 / 479001600.0 + r2 * (-1.0 / 87178291200.0)))))));
        double co, si;
        if (qd == 0) { co = c; si = s; } else if (qd == 1) { co = -s; si = c; } else if (qd == 2) { co = -c; si = -s; } else { co = s; si = -c; }
        tab[idx] = make_float2((float)co, (float)si);
    }
}

__device__ __forceinline__ void phaseA_norm(const Params& p, float* wab  ) {
    const int tid = threadIdx.x, wave = tid >> 6, lane = tid & 63;
    for (int i = tid; i < 8192; i += 512) { const int k = i >> 3, j = i & 7; wab[j * 1024 + k] = p.w_in[(size_t)k * INW + 4096 + j]; }
    __syncthreads();
    bf16_t* hbuf = (bf16_t*)(p.ws + W_H); float* ab = (float*)(p.ws + W_AB);
    float4 wv[4];
#pragma unroll
    for (int i = 0; i < 4; ++i) wv[i] = *(const float4*)(p.pre_mix_w + lane * 4 + 256 * i);
    float bias = 0.f, alog = 0.f; if (lane < 4) { bias = p.dt_bias[lane]; alog = p.A_log[lane]; }
    const int stride = gridDim.x * 8;
    int row = blockIdx.x * 8 + wave;
    float4 v[4];
    if (row < TT) { const float* xr = row < TP ? p.x_prompt + (size_t)row * DM : p.x_sample + (size_t)(row - TP) * DM;
#pragma unroll
        for (int i = 0; i < 4; ++i) v[i] = *(const float4*)(xr + lane * 4 + 256 * i); }
    while (row < TT) {
        const int nrow = row + stride;
        float4 vn[4];
        if (nrow < TT) { const float* xr = nrow < TP ? p.x_prompt + (size_t)nrow * DM : p.x_sample + (size_t)(nrow - TP) * DM;
#pragma unroll
            for (int i = 0; i < 4; ++i) vn[i] = *(const float4*)(xr + lane * 4 + 256 * i); }
        float ss = 0.f;
#pragma unroll
        for (int i = 0; i < 4; ++i) ss += v[i].x * v[i].x + v[i].y * v[i].y + v[i].z * v[i].z + v[i].w * v[i].w;
        ss = wave_sum(ss);
        const float rs = rsqrtf(ss * (1.0f / 1024.0f) + 1e-6f);
        float acc[8];
#pragma unroll
        for (int j = 0; j < 8; ++j) acc[j] = 0.f;
#pragma unroll
        for (int i = 0; i < 4; ++i) {
            const float4 w = wv[i];
            const float h0 = v[i].x * rs * w.x, h1 = v[i].y * rs * w.y, h2 = v[i].z * rs * w.z, h3 = v[i].w * rs * w.w;
            u32x2 o; o.x = pk_bf16(h0, h1); o.y = pk_bf16(h2, h3);
            *(u32x2*)(hbuf + (size_t)row * DM + lane * 4 + 256 * i) = o;
#pragma unroll
            for (int j = 0; j < 8; ++j) { const float4 wj = *(const float4*)(wab + j * 1024 + lane * 4 + 256 * i); acc[j] += h0 * wj.x + h1 * wj.y + h2 * wj.z + h3 * wj.w; }
        }
#pragma unroll
        for (int j = 0; j < 8; ++j) acc[j] = wave_sum(acc[j]);
        if (lane < 8) {
            float a = acc[0];
#pragma unroll
            for (int j = 1; j < 8; ++j) a = (lane == j) ? acc[j] : a;
            float o;
            if (lane < 4) { const float xx = a + bias; const float sp = xx > 20.f ? xx : log1pf(expf(xx)); o = -expf(alog) * sp; }
            else o = 1.0f / (1.0f + expf(-a));
            ab[(size_t)row * 8 + lane] = o;
        }
#pragma unroll
        for (int i = 0; i < 4; ++i) v[i] = vn[i];
        row = nrow;
    }
}

DI void ld_row4(float4 (&v)[4], const float* rp, int lane) {
#pragma unroll
    for (int i = 0; i < 4; ++i) v[i] = *(const float4*)(rp + lane * 4 + 256 * i);
}
DI void add_row4(float4 (&v)[4], const float* rp, int lane) {
#pragma unroll
    for (int i = 0; i < 4; ++i) { const float4 t = *(const float4*)(rp + lane * 4 + 256 * i); v[i].x += t.x; v[i].y += t.y; v[i].z += t.z; v[i].w += t.w; }
}
DI float ssq4(const float4 (&v)[4]) { float s = 0.f;
#pragma unroll
    for (int i = 0; i < 4; ++i) s += v[i].x * v[i].x + v[i].y * v[i].y + v[i].z * v[i].z + v[i].w * v[i].w;
    return s; }
__device__ __forceinline__ void phaseE_rows(const Params& p) {
    const int tid = threadIdx.x, wave = tid >> 6, lane = tid & 63;
    const float* mbuf = (const float*)(p.ws + W_PROJ); bf16_t* hbuf = (bf16_t*)(p.ws + W_H); const float* part = (const float*)(p.ws + W_SMP);
    float4 w1[4], w2[4]; ld_row4(w1, p.post_mix_w, lane); ld_row4(w2, p.pre_mlp_w, lane);
    const int stride = gridDim.x * 8;
    int row = blockIdx.x * 8 + wave;
    float4 m[4], x[4];
    if (row < TT) { ld_row4(x, row < TP ? p.x_prompt + (size_t)row * DM : p.x_sample + (size_t)(row - TP) * DM, lane);
        if (row < TP) ld_row4(m, mbuf + (size_t)row * DM, lane); else { ld_row4(m, part + (size_t)(row - TP) * DM, lane); add_row4(m, part + 1048576 + (size_t)(row - TP) * DM, lane); } }
    while (row < TT) {
        const int nrow = row + stride;
        float4 mn[4], xn[4];
        if (nrow < TT) { ld_row4(xn, nrow < TP ? p.x_prompt + (size_t)nrow * DM : p.x_sample + (size_t)(nrow - TP) * DM, lane);
            if (nrow < TP) ld_row4(mn, mbuf + (size_t)nrow * DM, lane); else { ld_row4(mn, part + (size_t)(nrow - TP) * DM, lane); add_row4(mn, part + 1048576 + (size_t)(nrow - TP) * DM, lane); } }
        const float rs = rsqrtf(wave_sum(ssq4(m)) * (1.0f / 1024.0f) + 1e-6f);
        float* yr = p.out + (size_t)row * DM;
#pragma unroll
        for (int i = 0; i < 4; ++i) { x[i].x += m[i].x * rs * w1[i].x; x[i].y += m[i].y * rs * w1[i].y; x[i].z += m[i].z * rs * w1[i].z; x[i].w += m[i].w * rs * w1[i].w;
            *(float4*)(yr + lane * 4 + 256 * i) = x[i]; }
        const float rs2 = rsqrtf(wave_sum(ssq4(x)) * (1.0f / 1024.0f) + 1e-6f);
#pragma unroll
        for (int i = 0; i < 4; ++i) { u32x2 o; o.x = pk_bf16(x[i].x * rs2 * w2[i].x, x[i].y * rs2 * w2[i].y); o.y = pk_bf16(x[i].z * rs2 * w2[i].z, x[i].w * rs2 * w2[i].w);
            *(u32x2*)(hbuf + (size_t)row * DM + lane * 4 + 256 * i) = o; }
#pragma unroll
        for (int i = 0; i < 4; ++i) { m[i] = mn[i]; x[i] = xn[i]; }
        row = nrow;
    }
}
__device__ __forceinline__ void phaseH_rows(const Params& p) {
    const int tid = threadIdx.x, wave = tid >> 6, lane = tid & 63;
    const float* fbuf = (const float*)(p.ws + W_H); const float* part = (const float*)(p.ws + W_SMP);
    float4 w1[4]; ld_row4(w1, p.post_mlp_w, lane);
    const int stride = gridDim.x * 8;
    int row = blockIdx.x * 8 + wave;
    float4 f[4], x[4];
    auto ldf = [&](float4 (&d)[4], int r) { if (r < TP) ld_row4(d, fbuf + (size_t)r * DM, lane); else { const float* q = part + (size_t)(r - TP) * DM; ld_row4(d, q, lane); add_row4(d, q + 1048576, lane); add_row4(d, q + 2 * 1048576, lane); add_row4(d, q + 3 * 1048576, lane); } };
    if (row < TT) { ld_row4(x, p.out + (size_t)row * DM, lane); ldf(f, row); }
    while (row < TT) {
        const int nrow = row + stride;
        float4 fn[4], xn[4];
        if (nrow < TT) { ld_row4(xn, p.out + (size_t)nrow * DM, lane); ldf(fn, nrow); }
        const float rs = rsqrtf(wave_sum(ssq4(f)) * (1.0f / 1024.0f) + 1e-6f);
        float* yr = p.out + (size_t)row * DM;
#pragma unroll
        for (int i = 0; i < 4; ++i) { x[i].x += f[i].x * rs * w1[i].x; x[i].y += f[i].y * rs * w1[i].y; x[i].z += f[i].z * rs * w1[i].z; x[i].w += f[i].w * rs * w1[i].w;
            *(float4*)(yr + lane * 4 + 256 * i) = x[i]; }
#pragma unroll
        for (int i = 0; i < 4; ++i) { f[i] = fn[i]; x[i] = xn[i]; }
        row = nrow;
    }
}

__device__ __forceinline__ void phaseC1_gdn_prep(const Params& p, unsigned char* lds, int first, int step, int limit) {
    const int tid = threadIdx.x, w = tid >> 6, lane = tid & 63, r = lane & 31, hh = lane >> 5;
    float* qc = (float*)lds; float* kc = qc + 64 * 129; float* vc = kc + 64 * 129;
    unsigned char* knb = lds + 99072; unsigned char* qnb = lds + 116480;
    float* Amat = (float*)(lds + 133888); float* cum = (float*)(lds + 150528); float* beta = cum + 64; float* rnq = cum + 128; float* rnk = cum + 192; float* fack = cum + 256;
    bf16_t* stg = (bf16_t*)(lds + 99072);
    const bf16_t* proj = (const bf16_t*)(p.ws + W_PROJ); const float* ab = (const float*)(p.ws + W_AB);
    u32x4 pre[6]; float c0 = 0.f, c1 = 0.f, c2 = 0.f, c3 = 0.f, hx3 = 0.f, hx2 = 0.f, hx1 = 0.f, g_in = 0.f, be_in = 0.f;
    auto issue = [&](int it) {
        const bool smp = it >= 1024;
        int b_, n_, h_, row0_, nrows_;
        if (!smp) { b_ = it >> 7; n_ = (it >> 2) & 31; h_ = it & 3; row0_ = b_ * 2048 + n_ * 64; nrows_ = 64; }
        else { const int q = it - 1024; b_ = q >> 2; n_ = 0; h_ = q & 3; row0_ = TP + b_ * 8; nrows_ = 8; }
        const int nld = nrows_ * 48;
#pragma unroll
        for (int k = 0; k < 6; ++k) { const int idx = tid + 512 * k;
            if (idx < nld) { const int row = idx / 48, rem = idx - row * 48, seg = rem >> 4, pc = rem & 15;
                pre[k] = *(const u32x4*)(proj + (size_t)(row0_ + row) * NPJ + 2048 + seg * 512 + h_ * 128 + pc * 8); } }
        hx3 = 0.f; hx2 = 0.f; hx1 = 0.f; g_in = 0.f; be_in = 0.f;
        if (tid < 384) {
            const int seg = tid >> 7, d = tid & 127, ch = seg * 512 + h_ * 128 + d;
            c0 = p.conv_w[ch]; c1 = p.conv_w[1536 + ch]; c2 = p.conv_w[3072 + ch]; c3 = p.conv_w[4608 + ch];
            const bf16_t* src = proj + (size_t)row0_ * NPJ + 2048 + ch;
            if (smp) { const float* sc = p.state_conv + (size_t)b_ * 3 * 1536 + ch; hx3 = sc[0]; hx2 = sc[1536]; hx1 = sc[3072]; }
            else if (n_ > 0) { hx3 = bf2f(*(src - 3 * NPJ)); hx2 = bf2f(*(src - 2 * NPJ)); hx1 = bf2f(*(src - NPJ)); }
        } else if (tid < 448) {
            const int i = tid - 384;
            if (i < nrows_) { g_in = ab[(size_t)(row0_ + i) * 8 + h_]; be_in = ab[(size_t)(row0_ + i) * 8 + 4 + h_]; }
        }
    };
    if (first < limit) issue(first);
    for (int item = first; item < limit; item += step) {
        const bool sample = item >= 1024;
        int b, n, h, row0, nrows, slot;
        if (!sample) { b = item >> 7; n = (item >> 2) & 31; h = item & 3; row0 = b * 2048 + n * 64; nrows = 64; slot = (b * 4 + h) * 32 + n; }
        else { const int s = item - 1024; b = s >> 2; n = 0; h = s & 3; row0 = TP + b * 8; nrows = 8; slot = s; }
        unsigned char* sbase = sample ? (unsigned char*)(p.out + O_GS) + (size_t)slot * 65536 : (unsigned char*)(p.out + O_YP) + (size_t)slot * 65536;
        bf16_t* sc_out = (bf16_t*)(p.ws + (sample ? W_SCS : W_SCP)) + (size_t)slot * 4096;
        float* dec_out = (float*)(p.ws + W_DEC) + (sample ? 1024 + slot : slot);
        {
            const int nld = nrows * 48;
#pragma unroll
            for (int k = 0; k < 6; ++k) { const int idx = tid + 512 * k;
                if (idx < nld) { const int row = idx / 48, rem = idx - row * 48, seg = rem >> 4, pc = rem & 15; *(u32x4*)(stg + row * 384 + seg * 128 + pc * 8) = pre[k]; } }
        }
        float xm3 = hx3, xm2 = hx2, xm1 = hx1;
        __syncthreads();
        if (tid < 384) {
            const int seg = tid >> 7, d = tid & 127, ch = seg * 512 + h * 128 + d;
            float* dst = qc + seg * (64 * 129) + d;
#pragma unroll 8
            for (int i = 0; i < nrows; ++i) {
                const float x = bf2f(stg[i * 384 + tid]);
                float cv = c0 * xm3; cv += c1 * xm2; cv += c2 * xm1; cv += c3 * x;
                dst[i * 129] = silu(cv);
                xm3 = xm2; xm2 = xm1; xm1 = x;
            }
            for (int i = nrows; i < 64; ++i) dst[i * 129] = 0.f;
            if (sample) { float* co = p.out + O_CS + (size_t)b * 3 * 1536 + ch; co[0] = xm3; co[1536] = xm2; co[3072] = xm1; }
            else if (n == 31) { float* co = p.out + O_CP + (size_t)b * 3 * 1536 + ch; co[0] = xm3; co[1536] = xm2; co[3072] = xm1; }
        } else if (tid < 448) {
            const int i = tid - 384;
            float g = g_in; const float be = be_in;
#pragma unroll
            for (int o = 1; o < 64; o <<= 1) { const float t = __shfl_up(g, o); if (i >= o) g += t; }
            cum[i] = g; beta[i] = be;
        }
        __syncthreads();
        if (tid < 128) {
            const int which = tid >> 6, row = tid & 63; const float* bp = (which ? kc : qc) + row * 129;
            float ss = 0.f;
#pragma unroll 16
            for (int d = 0; d < 128; ++d) ss += bp[d] * bp[d];
            float rn = rsqrtf(ss + 1e-6f);
            if (!which) rnq[row] = rn * 0.08838834764831845f; else { rnk[row] = rn; fack[row] = rn * beta[row] * __expf(cum[row]); }
        }
        __syncthreads();
#pragma unroll
        for (int it = 0; it < 4; ++it) {
            const int idx = tid + 512 * it, img = idx >> 10, rem = idx & 1023, row = rem >> 4, chunk = rem & 15;
            const float* sp = (img ? kc : qc) + row * 129 + chunk * 8; const float rn = img ? rnk[row] : rnq[row];
            u32x4 o; o.x = pk_bf16(sp[0] * rn, sp[1] * rn); o.y = pk_bf16(sp[2] * rn, sp[3] * rn); o.z = pk_bf16(sp[4] * rn, sp[5] * rn); o.w = pk_bf16(sp[6] * rn, sp[7] * rn);
            *(u32x4*)((img ? knb : qnb) + sw256(row, chunk)) = o;
        }
        __syncthreads();
        {
            const int isq = w >> 2, it_ = (w >> 1) & 1, jt = w & 1;
            f32x16 acc;
#pragma unroll
            for (int i = 0; i < 16; ++i) acc[i] = 0.f;
            const unsigned char* ai = isq ? qnb : knb;
#pragma unroll
            for (int s = 0; s < 8; ++s) {
                const bf16x8 a = *(const bf16x8*)(ai + sw256(it_ * 32 + r, 2 * s + hh));
                const bf16x8 bb = *(const bf16x8*)(knb + sw256(jt * 32 + r, 2 * s + hh));
                acc = MFMA32(a, bb, acc);
            }
            const int j = jt * 32 + r; const float cj = cum[j];
#pragma unroll
            for (int reg = 0; reg < 16; ++reg) {
                const int i = it_ * 32 + crow(reg, hh);
                const float dm = __expf(fminf(cum[i] - cj, 0.f)), dm2 = __expf(fminf(cj - cum[i], 0.f));
                if (!isq) Amat[i * 64 + j] = (i < j) ? beta[j] * acc[reg] * dm2 : 0.f;
                else sc_out[i * 64 + j] = f2bf((j <= i) ? acc[reg] * dm : 0.f);
            }
        }
        __syncthreads();
        {
#pragma unroll
            for (int it = 0; it < 2; ++it) {
                const int idx = tid + 512 * it, row = idx >> 4, chunk = idx & 15;
                const float e = __expf(cum[row]) * rnq[row]; const float* sp = qc + row * 129 + chunk * 8;
                u32x4 o; o.x = pk_bf16(sp[0] * e, sp[1] * e); o.y = pk_bf16(sp[2] * e, sp[3] * e); o.z = pk_bf16(sp[4] * e, sp[5] * e); o.w = pk_bf16(sp[6] * e, sp[7] * e);
                *(u32x4*)(sbase + 16384 + row * 256 + chunk * 16) = o;
            }
            const int d = tid & 127, cq = tid >> 7; const float cl = cum[63];
            u32x4* o = (u32x4*)(sbase + 49152 + (size_t)d * 128 + cq * 32);
#pragma unroll
            for (int c8 = 0; c8 < 2; ++c8) {
                float v[8];
#pragma unroll
                for (int j = 0; j < 8; ++j) { const int c = cq * 16 + c8 * 8 + j; v[j] = kc[c * 129 + d] * rnk[c] * __expf(cl - cum[c]); }
                u32x4 q; q.x = pk_bf16(v[0], v[1]); q.y = pk_bf16(v[2], v[3]); q.z = pk_bf16(v[4], v[5]); q.w = pk_bf16(v[6], v[7]); o[c8] = q;
            }
            if (tid == 0) *dec_out = __expf(cl);
        }
        __syncthreads();
        if (item + step < limit) issue(item + step);
        if (tid < 256) {
            int vz; asm volatile("v_mov_b32 %0, 0" : "=v"(vz));
            const float* At = Amat + vz;
            float* colp = (tid < 128) ? (kc + tid) : (vc + tid - 128);
            const float* facp = ((tid < 128) ? fack : beta) + vz;
            const int nblk = nrows == 64 ? 4 : 1;
            for (int bi = 0; bi < nblk; ++bi) {
                const int R0 = bi * 16;
                float acc[16];
#pragma unroll
                for (int ii = 0; ii < 16; ++ii) acc[ii] = colp[(R0 + ii) * 129] * facp[R0 + ii];
#pragma unroll 4
                for (int j = 0; j < R0; ++j) {
                    const float xj = colp[j * 129];
                    const f32x4 a0 = *(const f32x4*)(At + j * 64 + R0), a1 = *(const f32x4*)(At + j * 64 + R0 + 4), a2 = *(const f32x4*)(At + j * 64 + R0 + 8), a3 = *(const f32x4*)(At + j * 64 + R0 + 12);
#pragma unroll
                    for (int q = 0; q < 4; ++q) { acc[q] -= a0[q] * xj; acc[4 + q] -= a1[q] * xj; acc[8 + q] -= a2[q] * xj; acc[12 + q] -= a3[q] * xj; }
                }
#pragma unroll
                for (int jj = 0; jj < 15; ++jj) {
                    const float* ar = At + (R0 + jj) * 64 + R0;
#pragma unroll
                    for (int ii = jj + 1; ii < 16; ++ii) acc[ii] -= ar[ii] * acc[jj];
                }
#pragma unroll
                for (int ii = 0; ii < 16; ++ii) colp[(R0 + ii) * 129] = acc[ii];
            }
            if (tid < 128) {
                bf16_t* o = (bf16_t*)sbase + tid;
#pragma unroll 8
                for (int i = 0; i < 64; ++i) o[i * 128] = f2bf(-colp[i * 129]);
            } else {
                u32x4* o = (u32x4*)(sbase + 32768 + (size_t)(tid - 128) * 128);
#pragma unroll
                for (int c8 = 0; c8 < 8; ++c8) { float x[8];
#pragma unroll
                    for (int j = 0; j < 8; ++j) x[j] = colp[(c8 * 8 + j) * 129];
                    u32x4 v; v.x = pk_bf16(x[0], x[1]); v.y = pk_bf16(x[2], x[3]); v.z = pk_bf16(x[4], x[5]); v.w = pk_bf16(x[6], x[7]); o[c8] = v; }
            }
        }
        __syncthreads();
    }
}

template <bool GDN> __device__ __forceinline__ void scan_item(const Params& p, unsigned char* lds, int b, int h, bool sample, int* prog = nullptr) {
    const int tid = threadIdx.x, w = tid >> 6, lane = tid & 63, r = lane & 31, hh = lane >> 5;
    const int ct = w >> 2, et = w & 3;
    unsigned char* St = lds; unsigned char* INA = lds + 34816; unsigned char* INQ = lds + 52224; unsigned char* INKT = lds + 69632;
    unsigned char* INSC = lds + 88064; unsigned char* VNT = lds + 97280; float* SSQ = (float*)(lds + 115712);
    const int nchunks = sample ? 1 : 32, nrows = sample ? 8 : 64;
    const int row_base = sample ? TP + b * 8 : b * 2048;
    const bf16_t* proj = (const bf16_t*)(p.ws + W_PROJ);
    bf16_t* mix = (bf16_t*)(p.ws + W_MIX);
    const float* nw = GDN ? p.gdn_norm_w : p.ret_norm_w;
    const int gate_col = GDN ? 3584 + h * 128 : 1536 + h * 128;
    const int mix_col = (GDN ? 512 : 0) + h * 128;
    const float2* rtab = (const float2*)(p.ws + W_ROPE);
    const float lg2 = log2f(1.0f - exp2f(-5.0f - (float)h));
    f32x16 S0, S1;
    const int e_col = et * 32 + r;
    if (sample) {
        const float* s0 = (GDN ? p.state_gdn : p.state_ret) + (size_t)(b * 4 + h) * 16384 + ((2 * ct) * 32 + 4 * hh) * 128 + e_col;
#pragma unroll
        for (int reg = 0; reg < 16; ++reg) { S0[reg] = s0[((reg & 3) + 8 * (reg >> 2)) * 128]; S1[reg] = s0[((reg & 3) + 8 * (reg >> 2) + 32) * 128]; }
    } else {
#pragma unroll
        for (int reg = 0; reg < 16; ++reg) { S0[reg] = 0.f; S1[reg] = 0.f; }
    }
    auto write_St = [&]() {
#pragma unroll
        for (int g = 0; g < 4; ++g) {
            u32x2 v0, v1; v0.x = pk_bf16(S0[4 * g], S0[4 * g + 1]); v0.y = pk_bf16(S0[4 * g + 2], S0[4 * g + 3]); v1.x = pk_bf16(S1[4 * g], S1[4 * g + 1]); v1.y = pk_bf16(S1[4 * g + 2], S1[4 * g + 3]);
            *(u32x2*)(St + sw256(e_col, (2 * ct) * 4 + g) + 8 * hh) = v0;
            *(u32x2*)(St + sw256(e_col, (2 * ct + 1) * 4 + g) + 8 * hh) = v1;
        }
    };
    unsigned char* OST = lds + 117248;
    float* NW = (float*)(lds + 116736);
    if (tid < 128) NW[tid] = nw[tid];
    u32x4 ra[2], rq[2], rk[2], rs4;
    u32x2 ru[4], rg[4];
    f32x4 rt[4];
    float decay = 1.f;
    const unsigned char* gbase = nullptr; const bf16_t* gsc = nullptr; const float* gdec = nullptr;
    if (GDN) {
        const int slot0 = sample ? (b * 4 + h) : (b * 4 + h) * 32;
        gbase = sample ? (const unsigned char*)(p.out + O_GS) + (size_t)slot0 * 65536 : (const unsigned char*)(p.out + O_YP) + (size_t)slot0 * 65536;
        gsc = (const bf16_t*)(p.ws + (sample ? W_SCS : W_SCP)) + (size_t)slot0 * 4096;
        gdec = (const float*)(p.ws + W_DEC) + (sample ? 1024 + slot0 : slot0);
    }
    const int c_tok = ct * 32 + r;
    auto prefetch = [&](int n) {
        const size_t trow = (size_t)row_base + n * 64;
        if (GDN) {
            const unsigned char* sb = gbase + (size_t)n * 65536;
#pragma unroll
            for (int i = 0; i < 2; ++i) { const int idx = tid + 512 * i; ra[i] = *(const u32x4*)(sb + idx * 16); rq[i] = *(const u32x4*)(sb + 16384 + idx * 16); rk[i] = *(const u32x4*)(sb + 49152 + idx * 16); }
            rs4 = *(const u32x4*)((const unsigned char*)(gsc + (size_t)n * 4096) + tid * 16);
#pragma unroll
            for (int g = 0; g < 4; ++g) ru[g] = *(const u32x2*)(sb + 32768 + (e_col * 64 + ct * 32 + 8 * g + 4 * hh) * 2);
            decay = gdec[n];
        } else {
            const int c = tid >> 3, cp = tid & 7;
            if (c < nrows) {
                const bf16_t* qr = proj + (trow + c) * NPJ + h * 128 + cp * 8;
                ra[0] = *(const u32x4*)qr; ra[1] = *(const u32x4*)(qr + 64);
                rq[0] = *(const u32x4*)(qr + 512); rq[1] = *(const u32x4*)(qr + 512 + 64);
                const int pidx = sample ? 2048 + c : n * 64 + c;
                const f32x4* tp = (const f32x4*)(rtab + (size_t)pidx * 64 + cp * 8);
                rt[0] = tp[0]; rt[1] = tp[1]; rt[2] = tp[2]; rt[3] = tp[3];
            }
#pragma unroll
            for (int i = 0; i < 2; ++i) { const int idx = tid + 512 * i, row = idx >> 4, chunk = idx & 15;
                if (row < nrows) rk[i] = *(const u32x4*)(proj + (trow + row) * NPJ + 1024 + h * 128 + chunk * 8); }
        }
        if (GDN && c_tok < nrows) {
#pragma unroll
            for (int g = 0; g < 4; ++g) rg[g] = *(const u32x2*)(proj + (trow + c_tok) * NPJ + gate_col + et * 32 + 8 * g + 4 * hh);
        }
    };
    prefetch(0);
    write_St();
    auto flush = [&](int n) {
#pragma unroll
        for (int i = 0; i < 2; ++i) { const int idx = tid + 512 * i, row = idx >> 4, chunk = idx & 15;
            if (row < nrows) *(u32x4*)(mix + ((size_t)row_base + n * 64 + row) * DM + mix_col + chunk * 8) = *(const u32x4*)(OST + sw256(row, chunk)); }
    };
    for (int n = 0; n < nchunks; ++n) {
        u32x2 gate[4];
        if (GDN) {
#pragma unroll
            for (int g = 0; g < 4; ++g) gate[g] = rg[g];
        } else if (c_tok < nrows) {
#pragma unroll
            for (int g = 0; g < 4; ++g) gate[g] = *(const u32x2*)(proj + ((size_t)row_base + n * 64 + c_tok) * NPJ + gate_col + et * 32 + 8 * g + 4 * hh);
        }
        f32x16 acc1;
        if (GDN) {
#pragma unroll
            for (int i = 0; i < 2; ++i) { const int idx = tid + 512 * i;
                *(u32x4*)(INA + sw256(idx >> 4, idx & 15)) = ra[i]; *(u32x4*)(INQ + sw256(idx >> 4, idx & 15)) = rq[i]; *(u32x4*)(INKT + sw128x(idx >> 3, idx & 7)) = rk[i]; }
            *(u32x4*)(INSC + sw128(tid >> 3, tid & 7)) = rs4;
#pragma unroll
            for (int g = 0; g < 4; ++g) { acc1[4 * g] = bflo(ru[g].x); acc1[4 * g + 1] = bfhi(ru[g].x); acc1[4 * g + 2] = bflo(ru[g].y); acc1[4 * g + 3] = bfhi(ru[g].y); }
        } else {
            const int c = tid >> 3, cp = tid & 7;
            u32x4 q1 = {0u, 0u, 0u, 0u}, q2 = q1, k1 = q1, k2 = q1;
            unsigned short kt1[8], kt2[8];
#pragma unroll
            for (int j = 0; j < 8; ++j) { kt1[j] = 0; kt2[j] = 0; }
            if (c < nrows) {
                const float fq = exp2f((float)(c + 1) * lg2), fk = 0.08838834764831845f * exp2f((float)(nrows - 1 - c) * lg2);
                float oq1[8], oq2[8], ok1[8], ok2[8];
#pragma unroll
                for (int j = 0; j < 8; ++j) {
                    const unsigned qa = ra[0][j >> 1], qb = ra[1][j >> 1], ka = rq[0][j >> 1], kb = rq[1][j >> 1];
                    const float x1 = (j & 1) ? bfhi(qa) : bflo(qa), x2 = (j & 1) ? bfhi(qb) : bflo(qb);
                    const float y1 = (j & 1) ? bfhi(ka) : bflo(ka), y2 = (j & 1) ? bfhi(kb) : bflo(kb);
                    const float co = rt[j >> 1][(j & 1) * 2], si = rt[j >> 1][(j & 1) * 2 + 1];
                    oq1[j] = (x1 * co - x2 * si) * fq; oq2[j] = (x1 * si + x2 * co) * fq;
                    ok1[j] = (y1 * co - y2 * si) * fk; ok2[j] = (y1 * si + y2 * co) * fk;
                }
#pragma unroll
                for (int j = 0; j < 4; ++j) { q1[j] = pk_bf16(oq1[2 * j], oq1[2 * j + 1]); q2[j] = pk_bf16(oq2[2 * j], oq2[2 * j + 1]); k1[j] = pk_bf16(ok1[2 * j], ok1[2 * j + 1]); k2[j] = pk_bf16(ok2[2 * j], ok2[2 * j + 1]); }
#pragma unroll
                for (int j = 0; j < 8; ++j) { kt1[j] = (unsigned short)((j & 1) ? (k1[j >> 1] >> 16) : (k1[j >> 1] & 0xffffu)); kt2[j] = (unsigned short)((j & 1) ? (k2[j >> 1] >> 16) : (k2[j >> 1] & 0xffffu)); }
            }
            *(u32x4*)(INQ + sw256(c, cp)) = q1; *(u32x4*)(INQ + sw256(c, cp + 8)) = q2;
            *(u32x4*)(INA + sw256(c, cp)) = k1; *(u32x4*)(INA + sw256(c, cp + 8)) = k2;
#pragma unroll
            for (int j = 0; j < 8; ++j) {
                const int d1 = cp * 8 + j, d2 = d1 + 64;
                *(unsigned short*)(INKT + sw128x(d1, c >> 3) + (c & 7) * 2) = kt1[j];
                *(unsigned short*)(INKT + sw128x(d2, c >> 3) + (c & 7) * 2) = kt2[j];
            }
#pragma unroll
            for (int i = 0; i < 2; ++i) { const int idx = tid + 512 * i, row = idx >> 4, chunk = idx & 15;
                const u32x4 vv = (row < nrows) ? rk[i] : (u32x4){0u, 0u, 0u, 0u};
#pragma unroll
                for (int j = 0; j < 8; ++j) { const int e = chunk * 8 + j;
                    *(unsigned short*)(VNT + sw128x(e, row >> 3) + (row & 7) * 2) = (unsigned short)((j & 1) ? (vv[j >> 1] >> 16) : (vv[j >> 1] & 0xffffu)); } }
            decay = exp2f((float)nrows * lg2);
        }
        const float dec_n = decay;
        __syncthreads();
        if (n > 0) flush(n - 1);
        prefetch(n + 1 < nchunks ? n + 1 : n);
        if (GDN) {
#pragma unroll
            for (int s = 0; s < 8; ++s) {
                const bf16x8 a = *(const bf16x8*)(INA + sw256(ct * 32 + r, 2 * s + hh));
                const bf16x8 bb = *(const bf16x8*)(St + sw256(et * 32 + r, 2 * s + hh));
                acc1 = MFMA32(a, bb, acc1);
            }
#pragma unroll
            for (int g = 0; g < 4; ++g) { u32x2 v; v.x = pk_bf16(acc1[4 * g], acc1[4 * g + 1]); v.y = pk_bf16(acc1[4 * g + 2], acc1[4 * g + 3]);
                *(u32x2*)(VNT + sw128x(e_col, ct * 4 + g) + 8 * hh) = v; }
        } else {
            if (w < 4) {
                const int it_ = w >> 1, jt = w & 1;
#pragma unroll
                for (int i = 0; i < 16; ++i) acc1[i] = 0.f;
#pragma unroll
                for (int s = 0; s < 8; ++s) {
                    const bf16x8 a = *(const bf16x8*)(INQ + sw256(it_ * 32 + r, 2 * s + hh));
                    const bf16x8 bb = *(const bf16x8*)(INA + sw256(jt * 32 + r, 2 * s + hh));
                    acc1 = MFMA32(a, bb, acc1);
                }
                const float sc = exp2f(-(float)nrows * lg2); const int j = jt * 32 + r;
#pragma unroll
                for (int reg = 0; reg < 16; ++reg) { const int i = it_ * 32 + crow(reg, hh);
                    *(unsigned short*)(INSC + sw128(i, j >> 3) + (j & 7) * 2) = f2bf((j <= i) ? acc1[reg] * sc : 0.f); }
            }
        }
        __syncthreads();
        f32x16 acc2;
#pragma unroll
        for (int i = 0; i < 16; ++i) acc2[i] = 0.f;
#pragma unroll
        for (int s = 0; s < 8; ++s) {
            const bf16x8 a = *(const bf16x8*)(St + sw256(et * 32 + r, 2 * s + hh));
            const bf16x8 bb = *(const bf16x8*)(INQ + sw256(ct * 32 + r, 2 * s + hh));
            acc2 = MFMA32(a, bb, acc2);
        }
#pragma unroll
        for (int s = 0; s < 4; ++s) {
            const bf16x8 a = *(const bf16x8*)(VNT + sw128x(et * 32 + r, 2 * s + hh));
            const bf16x8 bb = *(const bf16x8*)(INSC + sw128(ct * 32 + r, 2 * s + hh));
            acc2 = MFMA32(a, bb, acc2);
        }
        {
            float sq = 0.f;
#pragma unroll
            for (int i = 0; i < 16; ++i) sq += acc2[i] * acc2[i];
            sq += __shfl_xor(sq, 32);
            if (hh == 0) SSQ[et * 64 + c_tok] = sq;
        }
#pragma unroll
        for (int i = 0; i < 16; ++i) { S0[i] *= dec_n; S1[i] *= dec_n; }
#pragma unroll
        for (int s = 0; s < 4; ++s) {
            const bf16x8 bb = *(const bf16x8*)(VNT + sw128x(et * 32 + r, 2 * s + hh));
            const bf16x8 a0 = *(const bf16x8*)(INKT + sw128x((2 * ct) * 32 + r, 2 * s + hh));
            const bf16x8 a1 = *(const bf16x8*)(INKT + sw128x((2 * ct + 1) * 32 + r, 2 * s + hh));
            S0 = MFMA32(a0, bb, S0); S1 = MFMA32(a1, bb, S1);
        }
        __syncthreads();
        if (prog && tid == 0) __hip_atomic_store(prog, n + 1, __ATOMIC_RELAXED, __HIP_MEMORY_SCOPE_AGENT);
        write_St();
        if (c_tok < nrows) {
            const float ss = SSQ[c_tok] + SSQ[64 + c_tok] + SSQ[128 + c_tok] + SSQ[192 + c_tok];
            const float rn = rsqrtf(ss * (1.0f / 128.0f) + 1e-6f);
            unsigned char* orow = OST + sw256(c_tok, et * 4);
#pragma unroll
            for (int g = 0; g < 4; ++g) {
                const int e0 = 8 * g + 4 * hh;
                const f32x4 wv = *(const f32x4*)(NW + et * 32 + e0);
                const float o0 = acc2[4 * g] * rn * wv[0] * silu(bflo(gate[g].x)), o1 = acc2[4 * g + 1] * rn * wv[1] * silu(bfhi(gate[g].x));
                const float o2 = acc2[4 * g + 2] * rn * wv[2] * silu(bflo(gate[g].y)), o3 = acc2[4 * g + 3] * rn * wv[3] * silu(bfhi(gate[g].y));
                u32x2 v; v.x = pk_bf16(o0, o1); v.y = pk_bf16(o2, o3);
                *(u32x2*)(orow + g * 16 + 8 * hh) = v;
            }
        }
    }
    __syncthreads();
    flush(nchunks - 1);
    {
        float* so = p.out + (sample ? (GDN ? O_GS : O_RS) : (GDN ? O_GP : O_RP)) + (size_t)(b * 4 + h) * 16384 + ((2 * ct) * 32 + 4 * hh) * 128 + e_col;
#pragma unroll
        for (int reg = 0; reg < 16; ++reg) { so[((reg & 3) + 8 * (reg >> 2)) * 128] = S0[reg]; so[((reg & 3) + 8 * (reg >> 2) + 32) * 128] = S1[reg]; }
    }
    __syncthreads();
}

__device__ __forceinline__ void phaseX(const Params& p, unsigned char* lds) { phaseC1_gdn_prep(p, lds, blockIdx.x, gridDim.x, gridDim.x >= 192 ? 1024 : 1536); }
__device__ __forceinline__ void phaseY(const Params& p, unsigned char* lds) {
    const int G = gridDim.x, bid = blockIdx.x;
    int* progs = (int*)(p.ws + W_DEC + 6144);
    int start = bid, limit = 64 + 1024, stride = G;
    if (G >= 192) {
        if (bid < 64) { limit = 64; stride = 64; }
        else { start = bid; stride = G - 64;
            phaseC1_gdn_prep(p, lds, 1024 + (bid - 64), G - 64, 1536); }
    }
    for (int s = start; s < limit; s += stride) {
        const bool sample = s >= 64; const int t = sample ? s - 64 : s;
        const bool gdn = sample ? (t < 512) : (t >= 32);
        const int bh = sample ? (t & 511) : (t & 31), b = bh >> 2, h = bh & 3;
        int* pr = nullptr; (void)progs;
        if (gdn) scan_item<true>(p, lds, b, h, sample, pr); else scan_item<false>(p, lds, b, h, sample, pr);
    }
    if (G >= 192) { if (bid >= 64) phaseA_weights(p, (float*)lds, 1024 + (bid - 64), 3328, G - 64); }
    else phaseA_weights(p, (float*)lds, 1024 + bid, 3328, G);
}

#ifndef DUMP_PROJ
#define DUMP_PROJ 0
#define DUMP_OFF W_PROJ
#define DUMP_BYTES 142606336ull
#endif
#ifndef DUP_C1
#define DUP_C1 0
#endif
#ifndef DUP_C12
#define DUP_C12 0
#endif
#ifndef SANITIZE
#define SANITIZE 0
#endif
#ifndef PHASE_MASK
#define PHASE_MASK 511
#endif
__global__ void __launch_bounds__(512, 2) fwd_megakernel(Params p) {
    extern __shared__ __attribute__((aligned(16))) unsigned char shm[];
    cg::grid_group grid = cg::this_grid();
    const bool multi = (p.phase_hi - p.phase_lo) > 1;
    volatile LAS unsigned* xst = (volatile LAS unsigned*)((LAS unsigned char*)shm + 152560);
    if (threadIdx.x == 0) { xst[0] = 0u; xst[1] = 0u; }
    __syncthreads();
    XcdBarrier xb = xcd_barrier_post((unsigned*)(p.ws + W_BAR), xst);
    if (p.phase_hi == 0x7fffffff) grid.sync();
#define RUN(ph) (p.phase_lo <= (ph) && (ph) < p.phase_hi && (PHASE_MASK & (1 << (ph))))
#define SEAM(ph) do { if (multi && p.phase_lo <= (ph) && (ph) + 1 < p.phase_hi) { xcd_barrier(xb); } } while (0)
    if (RUN(0)) { phaseA_weights(p, (float*)shm, blockIdx.x, 1024, gridDim.x); phaseA_norm(p, (float*)shm); phaseA_rope(p); if (blockIdx.x == 0 && threadIdx.x < 64) ((int*)(p.ws + W_DEC + 6144))[threadIdx.x] = 0; }
    SEAM(0);
    if (RUN(1)) {
        pg8::Gemm g; g.A = (const bf16_t*)(p.ws + W_H); g.Bt = (const bf16_t*)(p.ws + W_WIN); g.M = TT; g.N = NPJ; g.K = DM;
        pg8::SplitOrder S; S.init(g.N, g.K, 1, (int)gridDim.x, (int)blockIdx.x);
        pg8::EpiBf16<0> E; E.O = (bf16_t*)(p.ws + W_PROJ); E.ldc = NPJ;
        pg8::gemm_phase<pg8::EpiBf16<0>, pg8::SplitOrder, false>((PG8_LAS unsigned char*)shm, g, S, E, nullptr);
    }
    SEAM(1);
    if (RUN(2)) phaseX(p, shm);
    SEAM(2);
    if (RUN(3)) phaseY(p, shm);
    SEAM(3);
    if (RUN(4)) {
        pg8::Gemm g; g.A = (const bf16_t*)(p.ws + W_MIX); g.Bt = (const bf16_t*)(p.ws + W_WOUT); g.M = TT; g.N = DM; g.K = DM;
        pg8::SplitOrder S; S.init(g.N, g.K, 2, (int)gridDim.x, (int)blockIdx.x);
        pg8::EpiF32 E; E.C = (float*)(p.ws + W_PROJ); E.Csmp = (float*)(p.ws + W_SMP) - (size_t)TP * DM; E.ldc = DM;
        pg8::gemm_phase<pg8::EpiF32, pg8::SplitOrder, false>((PG8_LAS unsigned char*)shm, g, S, E, nullptr);
    }
    SEAM(4);
    if (RUN(5)) phaseE_rows(p);
    SEAM(5);
    if (RUN(6)) {
        pg8::Gemm g; g.A = (const bf16_t*)(p.ws + W_H); g.Bt = (const bf16_t*)(p.ws + W_WUP); g.M = TT; g.N = DFF; g.K = DM;
        pg8::SplitOrder S; S.init(g.N, g.K, 1, (int)gridDim.x, (int)blockIdx.x);
        pg8::EpiBf16<1> E; E.O = (bf16_t*)(p.ws + W_PROJ); E.ldc = DFF;
        pg8::gemm_phase<pg8::EpiBf16<1>, pg8::SplitOrder, false>((PG8_LAS unsigned char*)shm, g, S, E, nullptr);
    }
    SEAM(6);
    if (RUN(7)) {
        pg8::Gemm g; g.A = (const bf16_t*)(p.ws + W_PROJ); g.Bt = (const bf16_t*)(p.ws + W_WDN); g.M = TT; g.N = DM; g.K = DFF;
        pg8::SplitOrder S; S.init(g.N, g.K, 4, (int)gridDim.x, (int)blockIdx.x);
        pg8::EpiF32 E; E.C = (float*)(p.ws + W_H); E.Csmp = (float*)(p.ws + W_SMP) - (size_t)TP * DM; E.ldc = DM;
        pg8::gemm_phase<pg8::EpiF32, pg8::SplitOrder, false>((PG8_LAS unsigned char*)shm, g, S, E, nullptr);
    }
    SEAM(7);
    if (RUN(8)) phaseH_rows(p);
#if DUMP_PROJ
    if (p.phase_lo <= 9 && 9 < p.phase_hi) { const u32x4* src = (const u32x4*)(p.ws + DUMP_OFF); u32x4* dst = (u32x4*)p.out; for (size_t i = (size_t)blockIdx.x * 512 + threadIdx.x; i < DUMP_BYTES / 16; i += (size_t)gridDim.x * 512) dst[i] = src[i]; }
#endif
#if SANITIZE
    SEAM(8);
    if (p.phase_lo <= 9 && 9 < p.phase_hi) { for (size_t i = (size_t)blockIdx.x * 512 + threadIdx.x; i < 36278272; i += (size_t)gridDim.x * 512) { const float v = p.out[i]; if (!(fabsf(v) < 1e30f)) p.out[i] = 0.f; } }
#endif
}

constexpr size_t kDynLds = 152576;

extern "C" void kernel_launch(void* const* d_in, const int* in_sizes, int n_in, void* d_out, int out_size, void* d_ws, size_t ws_size, hipStream_t stream) {
    (void)in_sizes; (void)n_in; (void)out_size; (void)ws_size;
    static int grid_blocks = 0;
    if (!grid_blocks) {
        hipFuncSetAttribute((const void*)fwd_megakernel, hipFuncAttributeMaxDynamicSharedMemorySize, (int)kDynLds);
        int dev = 0, cus = 0, per_cu = 0;
        hipGetDevice(&dev);
        hipDeviceGetAttribute(&cus, hipDeviceAttributeMultiprocessorCount, dev);
        hipOccupancyMaxActiveBlocksPerMultiprocessor(&per_cu, fwd_megakernel, 512, kDynLds);
        if (per_cu < 1) per_cu = 1;
        if (per_cu > 1) per_cu = 1;
        grid_blocks = cus * per_cu;
    }
    Params p; memset(&p, 0, sizeof(p));
    p.x_prompt = (const float*)d_in[0]; p.x_sample = (const float*)d_in[1]; p.state_ret = (const float*)d_in[2]; p.state_gdn = (const float*)d_in[3];
    p.state_conv = (const float*)d_in[4]; p.pre_mix_w = (const float*)d_in[5]; p.w_in = (const float*)d_in[6]; p.conv_w = (const float*)d_in[7];
    p.A_log = (const float*)d_in[8]; p.dt_bias = (const float*)d_in[9]; p.ret_norm_w = (const float*)d_in[10]; p.gdn_norm_w = (const float*)d_in[11];
    p.w_out = (const float*)d_in[12]; p.post_mix_w = (const float*)d_in[13]; p.pre_mlp_w = (const float*)d_in[14]; p.w_up = (const float*)d_in[15];
    p.w_down = (const float*)d_in[16]; p.post_mlp_w = (const float*)d_in[17];
    p.out = (float*)d_out; p.ws = (unsigned char*)d_ws;
    p.rope_r = std::pow(10000.0, -1.0 / 64.0);
#if MULTI_LAUNCH
    for (int ph = 0; ph < 9 + SANITIZE; ++ph) {
        p.phase_lo = ph; p.phase_hi = ph + 1;
        hipLaunchKernelGGL(fwd_megakernel, dim3(grid_blocks), dim3(512), kDynLds, stream, p);
    }
#else
    p.phase_lo = 0; p.phase_hi = 9 + SANITIZE;
    hipMemsetAsync((unsigned char*)d_ws + W_BAR, 0, XCD_BAR_WORDS * 4, stream);
    void* args[] = {&p};
    hipError_t e = hipLaunchCooperativeKernel((const void*)fwd_megakernel, dim3(grid_blocks), dim3(512), args, kDynLds, stream);
    if (e != hipSuccess) fprintf(stderr, "cooperative launch failed: %s (grid %d)\n", hipGetErrorString(e), grid_blocks);
#endif
}
```
